# Optimizing an MI355X kernel written in HIP

```python
import math
import jax, jax.numpy as jnp
from jax import lax
import numpy as np

D_MODEL = 1024
BATCH = 16
SEQ = 2048
DEPTH = 4

CTX_LEN = 256
GRID_W = 64

D_HY = 384
D_S5 = 384
D_ML = 384
N_BRANCH = 3

SHORT_CONV = 3

HY_ORDER = 2
HY_EMB = 33
HY_BANDS = (HY_EMB - 1) // 2
HY_FILTER_HIDDEN = 64
HY_DECAY_TARGET = 1e-2
HY_FAST_DECAY_PCT = 0.3
HY_SLOW_DECAY_PCT = 1.5
HY_MIN_DECAY = math.log(HY_DECAY_TARGET) / HY_SLOW_DECAY_PCT
HY_MAX_DECAY = math.log(HY_DECAY_TARGET) / HY_FAST_DECAY_PCT

S5_GROUP = 16
S5_GROUPS = D_S5 // S5_GROUP
S5_STATE = 64
S5_DT_MIN = 1e-3
S5_DT_MAX = 1e-1

ML_HEADS = 4
ML_HEAD_DIM = D_ML // ML_HEADS
ML_CHUNK = 64
NEG = -1e30

N_EXPERTS = 32
TOP_K = 4
D_FF_EXPERT = 512
SWIGLU_LIMIT = 7.0
SWIGLU_ALPHA = 1.702
MOE_BLOCK = 256

NORM_EPS = 1e-6

COL_SIZES = (D_S5, 2 * D_ML, D_ML, 4 * ML_HEADS, (1 + HY_ORDER) * D_HY, D_ML, N_BRANCH * D_MODEL)
REC_COLS = D_S5 + 3 * D_ML + 4 * ML_HEADS
N_IN = REC_COLS + (1 + HY_ORDER) * D_HY + D_ML + N_BRANCH * D_MODEL

kernel_name = 'hybrid_hyena_s5_mlstm_moe_prefix_dit'


def rmsnorm(x, g):
    xf = x.astype(jnp.float32)
    y = xf * lax.rsqrt(jnp.mean(xf * xf, axis=-1, keepdims=True) + NORM_EPS)
    return (y * g.astype(jnp.float32)).astype(x.dtype)


def modulate(h, shift, scale):
    return h * (1 + scale) + shift


def split_cols(p, sizes):
    out, start = [], 0
    for s in sizes:
        out.append(p[..., start:start + s])
        start += s
    return out


def short_conv(u, w, b, grid):
    bsz, _, ch = u.shape
    n_rows, row_len = grid
    pad = SHORT_CONV // 2
    r = jnp.pad(u.reshape(bsz, n_rows, row_len, ch), ((0, 0), (0, 0), (pad, pad), (0, 0)))
    y = b + r[:, :, 0:row_len] * w[0]
    for j in range(1, SHORT_CONV):
        y = y + r[:, :, j:j + row_len] * w[j]
    return y.reshape(bsz, n_rows * row_len, ch)


def hyena_filters(seq_len, w1, b1, w2, b2, w3, b3, sin_freq):
    t = jnp.linspace(0.0, 1.0, seq_len, dtype=jnp.float32)[:, None]
    w = 2.0 * math.pi * jnp.arange(seq_len, dtype=jnp.float32)[:, None] / seq_len
    f = jnp.linspace(1e-4, HY_BANDS - 1, HY_BANDS, dtype=jnp.float32)[None, :]
    z = jnp.concatenate([t, jnp.cos(f * w), -jnp.sin(f * w)], axis=-1)
    hdn = jnp.sin(sin_freq[0] * (z @ w1 + b1))
    hdn = jnp.sin(sin_freq[1] * (hdn @ w2 + b2))
    hf = (hdn @ w3 + b3).astype(jnp.float32).reshape(seq_len, HY_ORDER, 2, D_HY)
    deltas = jnp.abs(jnp.linspace(HY_MIN_DECAY, HY_MAX_DECAY, D_HY, dtype=jnp.float32))
    decay = jnp.exp(-t * deltas)
    return hf * decay[:, None, None, :]


def bidir_fftconv(u, h_fwd, h_bwd, skip):
    seq_len = u.shape[1]
    n_fft = 2 * seq_len
    k = jnp.concatenate([h_fwd, jnp.zeros_like(h_fwd[:1]), h_bwd[:0:-1]], axis=0)
    k = k / jnp.sum(jnp.abs(k), axis=0, keepdims=True)
    uf = u.astype(jnp.float32)
    spec = jnp.fft.rfft(uf, n=n_fft, axis=1) * jnp.fft.rfft(k, n=n_fft, axis=0)[None]
    y = jnp.fft.irfft(spec, n=n_fft, axis=1)[:, :seq_len]
    return (y + uf * skip.astype(jnp.float32)).astype(u.dtype)


def hyena_mixer(u, conv_w, conv_b, filter_params, bias, grid):
    filt = hyena_filters(u.shape[1], *filter_params)
    parts = jnp.split(short_conv(u, conv_w, conv_b, grid), 1 + HY_ORDER, axis=-1)
    z = parts[0]
    for o in range(HY_ORDER):
        z = parts[1 + o] * bidir_fftconv(z, filt[:, o, 0], filt[:, o, 1], bias[o])
    return z


def s5_discretize(lam_re, lam_im, log_dt, b_mat):
    lam = lax.complex(lam_re.astype(jnp.float32), lam_im.astype(jnp.float32))
    dt = jnp.exp(log_dt.astype(jnp.float32))[:, None]
    lam_bar = jnp.exp(lam * dt)
    b_bar = ((lam_bar - 1.0) / lam)[..., None] * b_mat
    return lam_bar, b_bar


def linear_scan(bu, lam_bar, x0):
    bu = bu.at[:, 0].add(lam_bar * x0)
    a = jnp.broadcast_to(lam_bar, (1, bu.shape[1]) + lam_bar.shape)

    def combine(left, right):
        return (left[0] * right[0], right[0] * left[1] + right[1])

    _, xs = lax.associative_scan(combine, (a, bu), axis=1)
    return xs


def s5_mixer(u_l, u_c, lam_re, lam_im, log_dt, b_re, b_im, c_re, c_im, d_skip, glu_w, need_ctx):
    bsz, seq_len, _ = u_l.shape
    ctx_len = u_c.shape[1]
    ul = u_l.astype(jnp.float32).reshape(bsz, seq_len, S5_GROUPS, S5_GROUP)
    uc = u_c.astype(jnp.float32).reshape(bsz, ctx_len, S5_GROUPS, S5_GROUP)
    b_mat = lax.complex(b_re.astype(jnp.float32), b_im.astype(jnp.float32))
    c_mat = lax.complex(c_re.astype(jnp.float32), c_im.astype(jnp.float32))
    dsk = d_skip.astype(jnp.float32).reshape(S5_GROUPS, S5_GROUP)
    x0 = jnp.zeros((bsz, S5_GROUPS, S5_STATE), jnp.complex64)
    y_l = dsk * ul
    y_c = dsk * uc if need_ctx else None
    for d in range(2):
        flip = (lambda t: jnp.flip(t, axis=1)) if d == 1 else (lambda t: t)
        lam_bar, b_bar = s5_discretize(lam_re[d], lam_im[d], log_dt[d], b_mat)
        xs_c = linear_scan(flip(jnp.einsum('blgn,gpn->blgp', uc.astype(jnp.complex64), b_bar)), lam_bar, x0)
        xs_l = flip(linear_scan(flip(jnp.einsum('blgn,gpn->blgp', ul.astype(jnp.complex64), b_bar)),
                                lam_bar, xs_c[:, -1]))
        y_l = y_l + jnp.real(jnp.einsum('blgp,gnp->blgn', xs_l, c_mat))
        if need_ctx:
            y_c = y_c + jnp.real(jnp.einsum('blgp,gnp->blgn', flip(xs_c), c_mat))

    def half_glu(y, dtype):
        g = jax.nn.gelu(y.reshape(bsz, -1, D_S5))
        return (g * jax.nn.sigmoid(g @ glu_w)).astype(dtype)

    return half_glu(y_l, u_l.dtype), (half_glu(y_c, u_c.dtype) if need_ctx else None)


def mlstm_chunkwise(q, k, v, log_i, log_f, state0, with_output):
    bsz, nh, seq_len, dh = q.shape
    nc = seq_len // ML_CHUNK
    blk = lambda t: t.reshape(bsz, nh, nc, ML_CHUNK, *t.shape[3:])
    qc, kc, vc, ic, fc = blk(q), blk(k), blk(v), blk(log_i), blk(log_f)
    b = jnp.cumsum(fc, axis=-1)
    b_end = b[..., -1]
    g = b_end[..., None] - b + ic

    def chunk_step(carry, inp):
        c_mem, n_mem, m_mem = carry
        k_t, v_t, g_t, be = inp
        m_new = jnp.maximum(be + m_mem, jnp.max(g_t, axis=-1))
        decay = jnp.exp(be + m_mem - m_new)
        w = jnp.exp(g_t - m_new[..., None])
        c_new = decay[..., None, None] * c_mem + jnp.einsum('bhs,bhsd,bhse->bhde', w, v_t, k_t)
        n_new = decay[..., None] * n_mem + jnp.einsum('bhs,bhse->bhe', w, k_t)
        return (c_new, n_new, m_new), (c_mem, n_mem, m_mem)

    to_scan = lambda t: jnp.moveaxis(t, 2, 0)
    final, (c_prev, n_prev, m_prev) = lax.scan(
        chunk_step, state0, (to_scan(kc), to_scan(vc), to_scan(g), to_scan(b_end)))
    if not with_output:
        return None, final
    c_prev = jnp.moveaxis(c_prev, 0, 2)
    n_prev = jnp.moveaxis(n_prev, 0, 2)
    m_prev = jnp.moveaxis(m_prev, 0, 2)
    lower = jnp.tril(jnp.ones((ML_CHUNK, ML_CHUNK), dtype=bool))
    a = b + m_prev[..., None]
    dmat = jnp.where(lower, b[..., :, None] - b[..., None, :] + ic[..., None, :], NEG)
    m_out = jnp.maximum(a, jnp.max(dmat, axis=-1))
    wmat = jnp.exp(dmat - m_out[..., None])
    wa = jnp.exp(a - m_out)
    s = jnp.einsum('bhctd,bhcsd->bhcts', qc, kc) * wmat
    num = jnp.einsum('bhcts,bhcsd->bhctd', s, vc) + wa[..., None] * jnp.einsum('bhcde,bhcte->bhctd', c_prev, qc)
    den = jnp.sum(s, axis=-1) + wa * jnp.einsum('bhce,bhcte->bhct', n_prev, qc)
    h = num / jnp.maximum(jnp.abs(den), jnp.exp(-m_out))[..., None]
    return h.reshape(bsz, nh, seq_len, dh), final


def mlstm_heads(qk, v, gates, gate_b, conv_w, conv_b, grid):
    bsz, seq_len, _ = v.shape
    qk = jax.nn.silu(short_conv(qk, conv_w, conv_b, grid)).astype(jnp.float32)
    q, k = jnp.split(qk, 2, axis=-1)
    to_heads = lambda t: t.reshape(bsz, seq_len, ML_HEADS, ML_HEAD_DIM).transpose(0, 2, 1, 3)
    g = (gates + gate_b).astype(jnp.float32).reshape(bsz, seq_len, 4, ML_HEADS).transpose(2, 0, 3, 1)
    return to_heads(q), to_heads(k) * ML_HEAD_DIM ** -0.5, to_heads(v.astype(jnp.float32)), g


def mlstm_head_out(h, o, norm_g):
    bsz, _, seq_len, _ = h.shape
    h = h.transpose(0, 2, 1, 3)
    h = h * lax.rsqrt(jnp.mean(h * h, axis=-1, keepdims=True) + NORM_EPS)
    h = h.reshape(bsz, seq_len, D_ML) * norm_g.astype(jnp.float32)
    return (h * jax.nn.sigmoid(o.astype(jnp.float32))).astype(o.dtype)


def mlstm_mixer(qk_l, v_l, gt_l, o_l, qk_c, v_c, gt_c, o_c, gate_b, conv_w, conv_b, norm_g,
                lat_grid, ctx_grid, need_ctx):
    ql, kl, vl, gl = mlstm_heads(qk_l, v_l, gt_l, gate_b, conv_w, conv_b, lat_grid)
    qc, kc, vc, gc = mlstm_heads(qk_c, v_c, gt_c, gate_b, conv_w, conv_b, ctx_grid)
    bsz = ql.shape[0]
    state0 = (jnp.zeros((bsz, ML_HEADS, ML_HEAD_DIM, ML_HEAD_DIM), jnp.float32),
              jnp.zeros((bsz, ML_HEADS, ML_HEAD_DIM), jnp.float32),
              jnp.full((bsz, ML_HEADS), NEG, jnp.float32))
    h_l = jnp.zeros_like(ql)
    h_c = jnp.zeros_like(qc) if need_ctx else None
    for d in range(2):
        flip = (lambda t: jnp.flip(t, axis=2)) if d == 1 else (lambda t: t)
        hc_d, state_c = mlstm_chunkwise(flip(qc), flip(kc), flip(vc), flip(gc[2 * d]),
                                        flip(jax.nn.log_sigmoid(gc[2 * d + 1])), state0, need_ctx)
        hl_d, _ = mlstm_chunkwise(flip(ql), flip(kl), flip(vl), flip(gl[2 * d]),
                                  flip(jax.nn.log_sigmoid(gl[2 * d + 1])), state_c, True)
        h_l = h_l + flip(hl_d)
        if need_ctx:
            h_c = h_c + flip(hc_d)
    out_l = mlstm_head_out(h_l, o_l, norm_g)
    out_c = mlstm_head_out(h_c, o_c, norm_g) if need_ctx else None
    return out_l, out_c


def gated_merge(hy, s5, ml, mg, w_br_hy, w_br_s5, w_br_ml, w_out):
    g_hy, g_s5, g_ml = jnp.split(jax.nn.sigmoid(mg), N_BRANCH, axis=-1)
    y = g_hy * (hy @ w_br_hy) + g_s5 * (s5 @ w_br_s5) + g_ml * (ml @ w_br_ml)
    return y @ w_out


def token_mixer(h_l, h_c, lat_grid, ctx_grid, need_ctx, w_in, hy_conv_w, hy_conv_b, hy_filter_params, hy_bias,
                s5_params, ml_conv_w, ml_conv_b, ml_gate_b, ml_norm_g, w_br_hy, w_br_s5, w_br_ml, w_out):
    s5_l, qk_l, v_l, gt_l, hy_l, o_l, mg_l = split_cols(h_l @ w_in, COL_SIZES)
    if need_ctx:
        s5_c, qk_c, v_c, gt_c, hy_c, o_c, mg_c = split_cols(h_c @ w_in, COL_SIZES)
    else:
        s5_c, qk_c, v_c, gt_c = split_cols(h_c @ w_in[:, :REC_COLS], COL_SIZES[:4])
        hy_c = o_c = mg_c = None
    hy_out_l = hyena_mixer(hy_l, hy_conv_w, hy_conv_b, hy_filter_params, hy_bias, lat_grid)
    s5_out_l, s5_out_c = s5_mixer(s5_l, s5_c, *s5_params, need_ctx)
    ml_out_l, ml_out_c = mlstm_mixer(qk_l, v_l, gt_l, o_l, qk_c, v_c, gt_c, o_c, ml_gate_b, ml_conv_w,
                                     ml_conv_b, ml_norm_g, lat_grid, ctx_grid, need_ctx)
    y_l = gated_merge(hy_out_l, s5_out_l, ml_out_l, mg_l, w_br_hy, w_br_s5, w_br_ml, w_out)
    if not need_ctx:
        return y_l, None
    hy_out_c = hyena_mixer(hy_c, hy_conv_w, hy_conv_b, hy_filter_params, hy_bias, ctx_grid)
    y_c = gated_merge(hy_out_c, s5_out_c, ml_out_c, mg_c, w_br_hy, w_br_s5, w_br_ml, w_out)
    return y_l, y_c


def moe(h, router_w, router_b, w1, b1, w2, b2):
    bsz, seq_len, d = h.shape
    t = h.reshape(-1, d)
    n_tok = t.shape[0]
    logits = (t @ router_w + router_b).astype(jnp.float32)
    top_val, top_idx = lax.top_k(logits, TOP_K)
    weights = jax.nn.softmax(top_val, axis=-1).astype(h.dtype)
    flat_e = top_idx.reshape(-1)
    n_assign = flat_e.shape[0]
    n_blocks = -(-n_assign // MOE_BLOCK) + N_EXPERTS
    n_slots = n_blocks * MOE_BLOCK
    order = jnp.argsort(flat_e, stable=True)
    e_sorted = flat_e[order]
    counts = jnp.bincount(flat_e, length=N_EXPERTS).astype(jnp.int32)
    padded = (counts + MOE_BLOCK - 1) // MOE_BLOCK * MOE_BLOCK
    end_pad = jnp.cumsum(padded)
    start_pad = end_pad - padded
    start = jnp.cumsum(counts) - counts
    dest = start_pad[e_sorted] + jnp.arange(n_assign, dtype=jnp.int32) - start[e_sorted]
    slot_tok = jnp.full((n_slots,), n_tok, jnp.int32).at[dest].set((order // TOP_K).astype(jnp.int32))
    slot_w = jnp.zeros((n_slots,), h.dtype).at[dest].set(weights.reshape(-1)[order])
    block_start = jnp.arange(n_blocks, dtype=jnp.int32) * MOE_BLOCK
    block_e = jnp.minimum(jnp.searchsorted(end_pad, block_start, side='right'), N_EXPERTS - 1).astype(jnp.int32)
    t_pad = jnp.concatenate([t, jnp.zeros((1, d), t.dtype)], axis=0)

    def block_ffn(blk):
        e, tok, wt = blk
        hid = t_pad[tok] @ w1[e] + b1[e]
        x_glu = jnp.minimum(hid[:, 0::2], SWIGLU_LIMIT)
        x_lin = jnp.clip(hid[:, 1::2], -SWIGLU_LIMIT, SWIGLU_LIMIT)
        act = x_glu * jax.nn.sigmoid(SWIGLU_ALPHA * x_glu) * (x_lin + 1)
        return (act @ w2[e] + b2[e]) * wt[:, None]

    out = lax.map(block_ffn, (block_e, slot_tok.reshape(n_blocks, MOE_BLOCK),
                              slot_w.reshape(n_blocks, MOE_BLOCK)))
    y = jnp.zeros((n_tok + 1, d), h.dtype).at[slot_tok].add(out.reshape(n_slots, d))
    return y[:n_tok].reshape(bsz, seq_len, d)


def setup_inputs(seed: int = 0) -> dict:
    key = jax.random.key(seed)
    ks = iter(jax.random.split(key, 64))
    nrm = lambda shape, scale: scale * jax.random.normal(next(ks), shape, jnp.float32)
    D, NL, H = D_MODEL, DEPTH, HY_FILTER_HIDDEN
    G, P, N = S5_GROUPS, S5_STATE, S5_GROUP
    i_part = nrm((NL, 2, 1, ML_HEADS), 0.1)
    f_part = jnp.linspace(3.0, 6.0, ML_HEADS, dtype=jnp.float32) + nrm((NL, 2, 1, ML_HEADS), 0.1)
    return {
        'x': nrm((BATCH, SEQ, D), 1.0),
        'c': nrm((BATCH, D), 1.0),
        'ctx': nrm((BATCH, CTX_LEN, D), 1.0),
        'c_ctx': nrm((D,), 1.0),
        'ada_w': nrm((NL, D, 6 * D), 0.5 * D ** -0.5),
        'ada_b': nrm((NL, 6 * D), 0.02),
        'norm1_g': 1.0 + nrm((NL, D), 0.02),
        'norm2_g': 1.0 + nrm((NL, D), 0.02),
        'final_norm_g': 1.0 + nrm((D,), 0.02),
        'w_in': nrm((NL, D, N_IN), D ** -0.5),
        'hy_conv_w': nrm((NL, SHORT_CONV, (1 + HY_ORDER) * D_HY), SHORT_CONV ** -0.5),
        'hy_conv_b': nrm((NL, (1 + HY_ORDER) * D_HY), 0.02),
        'hy_f_w1': nrm((NL, HY_EMB, H), HY_EMB ** -0.5),
        'hy_f_b1': nrm((NL, H), 0.02),
        'hy_f_w2': nrm((NL, H, H), H ** -0.5),
        'hy_f_b2': nrm((NL, H), 0.02),
        'hy_f_w3': nrm((NL, H, HY_ORDER * 2 * D_HY), H ** -0.5),
        'hy_f_b3': nrm((NL, HY_ORDER * 2 * D_HY), 0.02),
        'hy_sin_freq': 1.0 + nrm((NL, 2, H), 0.02),
        'hy_bias': nrm((NL, HY_ORDER, D_HY), 1.0),
        's5_lam_re': -0.5 + nrm((NL, 2, G, P), 0.01),
        's5_lam_im': math.pi * jnp.arange(P, dtype=jnp.float32) + nrm((NL, 2, G, P), 0.01),
        's5_log_dt': jax.random.uniform(next(ks), (NL, 2, G), jnp.float32,
                                        math.log(S5_DT_MIN), math.log(S5_DT_MAX)),
        's5_b_re': nrm((NL, G, P, N), (2 * N) ** -0.5),
        's5_b_im': nrm((NL, G, P, N), (2 * N) ** -0.5),
        's5_c_re': nrm((NL, G, N, P), P ** -0.5),
        's5_c_im': nrm((NL, G, N, P), P ** -0.5),
        's5_d': nrm((NL, D_S5), 0.5),
        's5_glu_w': nrm((NL, D_S5, D_S5), D_S5 ** -0.5),
        'ml_conv_w': nrm((NL, SHORT_CONV, 2 * D_ML), SHORT_CONV ** -0.5),
        'ml_conv_b': nrm((NL, 2 * D_ML), 0.02),
        'ml_gate_b': jnp.concatenate([i_part, f_part], axis=2).reshape(NL, 4 * ML_HEADS),
        'ml_norm_g': 1.0 + nrm((NL, D_ML), 0.02),
        'w_br_hy': nrm((NL, D_HY, D), D_HY ** -0.5),
        'w_br_s5': nrm((NL, D_S5, D), D_S5 ** -0.5),
        'w_br_ml': nrm((NL, D_ML, D), D_ML ** -0.5),
        'w_out': nrm((NL, D, D), D ** -0.5),
        'moe_router_w': nrm((NL, D, N_EXPERTS), D ** -0.5),
        'moe_router_b': nrm((NL, N_EXPERTS), 0.01),
        'moe_w1': nrm((NL, N_EXPERTS, D, 2 * D_FF_EXPERT), D ** -0.5),
        'moe_b1': nrm((NL, N_EXPERTS, 2 * D_FF_EXPERT), 0.02),
        'moe_w2': nrm((NL, N_EXPERTS, D_FF_EXPERT, D), D_FF_EXPERT ** -0.5),
        'moe_b2': nrm((NL, N_EXPERTS, D), 0.02),
    }


def reference(x, c, ctx, c_ctx, ada_w, ada_b, norm1_g, norm2_g, final_norm_g, w_in,
              hy_conv_w, hy_conv_b, hy_f_w1, hy_f_b1, hy_f_w2, hy_f_b2, hy_f_w3, hy_f_b3, hy_sin_freq, hy_bias,
              s5_lam_re, s5_lam_im, s5_log_dt, s5_b_re, s5_b_im, s5_c_re, s5_c_im, s5_d, s5_glu_w,
              ml_conv_w, ml_conv_b, ml_gate_b, ml_norm_g,
              w_br_hy, w_br_s5, w_br_ml, w_out,
              moe_router_w, moe_router_b, moe_w1, moe_b1, moe_w2, moe_b2):
    seq_len = x.shape[1]
    ctx_len = ctx.shape[1]
    rows = seq_len // GRID_W
    lat_grid = (rows, GRID_W)
    ctx_grid = (1, ctx_len)
    silu_c = jax.nn.silu(c.astype(jnp.float32))
    silu_cc = jax.nn.silu(c_ctx.astype(jnp.float32))[None]
    for l in range(DEPTH):
        need_ctx = l < DEPTH - 1
        mod_l = (silu_c @ ada_w[l] + ada_b[l]).astype(x.dtype)[:, None, :]
        mod_c = (silu_cc @ ada_w[l] + ada_b[l]).astype(ctx.dtype)[:, None, :]
        sh1_l, sc1_l, g1_l, sh2_l, sc2_l, g2_l = jnp.split(mod_l, 6, axis=-1)
        sh1_c, sc1_c, g1_c, sh2_c, sc2_c, g2_c = jnp.split(mod_c, 6, axis=-1)
        h_l = modulate(rmsnorm(x, norm1_g[l]), sh1_l, sc1_l)
        h_c = modulate(rmsnorm(ctx, norm1_g[l]), sh1_c, sc1_c)
        y_l, y_c = token_mixer(
            h_l, h_c, lat_grid, ctx_grid, need_ctx, w_in[l], hy_conv_w[l], hy_conv_b[l],
            (hy_f_w1[l], hy_f_b1[l], hy_f_w2[l], hy_f_b2[l], hy_f_w3[l], hy_f_b3[l], hy_sin_freq[l]), hy_bias[l],
            (s5_lam_re[l], s5_lam_im[l], s5_log_dt[l], s5_b_re[l], s5_b_im[l], s5_c_re[l], s5_c_im[l],
             s5_d[l], s5_glu_w[l]),
            ml_conv_w[l], ml_conv_b[l], ml_gate_b[l], ml_norm_g[l],
            w_br_hy[l], w_br_s5[l], w_br_ml[l], w_out[l])
        x = x + g1_l * y_l
        h2_l = modulate(rmsnorm(x, norm2_g[l]), sh2_l, sc2_l)
        moe_args = (moe_router_w[l], moe_router_b[l], moe_w1[l], moe_b1[l], moe_w2[l], moe_b2[l])
        if need_ctx:
            ctx = ctx + g1_c * y_c
            h2_c = modulate(rmsnorm(ctx, norm2_g[l]), sh2_c, sc2_c)
            f = moe(jnp.concatenate([h2_c, h2_l], axis=1), *moe_args)
            ctx = ctx + g2_c * f[:, :ctx_len]
            x = x + g2_l * f[:, ctx_len:]
        else:
            x = x + g2_l * moe(h2_l, *moe_args)
    return rmsnorm(x, final_norm_g)
```

```cpp
#ifdef HOST_TEST
#include <cmath>
#include <cstdio>
#include <cstdlib>
#include <cstring>
#include <cstdint>
#define HD inline
#else
#include <hip/hip_runtime.h>
#include <cstdio>
#include <cstdint>
#include <cstring>
#define HD __host__ __device__ __forceinline__
#endif

#ifndef CFG_BATCH
#define CFG_BATCH 16
#endif
#ifndef CFG_SEQ
#define CFG_SEQ 2048
#endif
#ifndef CFG_CTX
#define CFG_CTX 256
#endif
#ifndef CFG_DEPTH
#define CFG_DEPTH 4
#endif

#ifndef REP_MASK
#define REP_MASK 0u
#endif
typedef unsigned short bf16;
constexpr int D = 1024, NB = CFG_BATCH, SEQ = CFG_SEQ, CTXL = CFG_CTX, DEPTH = CFG_DEPTH, GRIDW = 64;
constexpr int NTL = NB * SEQ, NTC = NB * CTXL, NT = NTL + NTC, NMOD = NB + 1;
constexpr int DH = 384, NPOS = SEQ + CTXL;
constexpr int NP = 6400;
constexpr int PC_S5 = 0, PC_Q = 384, PC_K = 768, PC_V = 1152, PC_HY = 1536, PC_O = 2688, PC_MG = 3072, PC_GT = 6144;
constexpr int NIN = 6160;
constexpr int S5G = 24, S5P = 64, S5N = 16;
constexpr int MLH = 4, MLD = 96;
constexpr int NE = 32, TOPK = 4, FF = 512;
constexpr int NSLOT = ((NT * TOPK + 255) / 256 + NE) * 256;
constexpr float EPS = 1e-6f;

HD int win_src_col(int n) { return n < 1536 ? n : (n < 6144 ? n + 16 : (n < 6160 ? n - 6144 + 1536 : -1)); }
HD int w1_src_col(int n) { const int pn = n >> 8, bj = (n >> 7) & 1, wc = (n >> 5) & 3, nn = (n >> 4) & 1, fq = (n >> 2) & 3, i = n & 3; return 2 * (128 * pn + 32 * wc + 8 * fq + 4 * bj + i) + nn; }

enum { I_X, I_C, I_CTX, I_CCTX, I_ADAW, I_ADAB, I_N1G, I_N2G, I_FNG, I_WIN, I_HYCW, I_HYCB, I_HW1, I_HB1, I_HW2, I_HB2, I_HW3, I_HB3, I_HSF, I_HBIAS,
       I_LRE, I_LIM, I_LDT, I_BRE, I_BIM, I_CRE, I_CIM, I_S5D, I_GLU, I_MLCW, I_MLCB, I_MLGB, I_MLNG, I_WBHY, I_WBS5, I_WBML, I_WOUT,
       I_RW, I_RB, I_W1, I_B1, I_W2, I_B2, N_INPUTS };

constexpr size_t al256(size_t x) { return (x + 255) & ~(size_t)255; }
constexpr size_t WS_CTL = 0, CTL_BYTES = 1u << 20;
constexpr int CW_CNT = 64;
constexpr int CW_W1MX = 131072;
constexpr int CW_WMX = 65536;
constexpr int CW_GLU = 8192;
constexpr int CW_BAR = 4096;
constexpr size_t WS_MOD = CTL_BYTES;
constexpr size_t WS_SILU = WS_MOD + al256((size_t)DEPTH * NMOD * 6144 * 4);
constexpr size_t WS_HD2 = WS_SILU + al256((size_t)NMOD * D * 4);
constexpr size_t WS_HF = WS_HD2 + al256((size_t)DEPTH * NPOS * 64 * 4);
constexpr size_t WS_NRM = WS_HF + al256((size_t)DEPTH * NPOS * 1536 * 4);
constexpr size_t WS_WIN = WS_NRM + al256((size_t)DEPTH * 2 * 2 * DH * 4);
constexpr size_t WS_WBR = WS_WIN + al256((size_t)DEPTH * NP * D * 2);
constexpr size_t WS_WOUT = WS_WBR + al256((size_t)DEPTH * 3 * D * DH * 2);
constexpr size_t WS_GLU = WS_WOUT + al256((size_t)DEPTH * D * D * 2);
constexpr size_t WS_W1T = WS_GLU + al256((size_t)DEPTH * 512 * DH * 2);
constexpr size_t WS_W2T = WS_W1T + al256((size_t)NE * D * D * 2);
constexpr size_t WS_X = WS_W2T + al256((size_t)NE * D * FF * 2);
constexpr size_t WS_H = WS_X + al256((size_t)NT * D * 4);
constexpr size_t WS_HY = WS_H + al256((size_t)NT * D * 2);
constexpr size_t WS_S5O = WS_HY + al256((size_t)NT * DH * 2);
constexpr size_t WS_MLO = WS_S5O + al256((size_t)NT * DH * 2);
constexpr size_t WS_ASGE = WS_MLO + al256((size_t)NT * DH * 2);
constexpr size_t WS_ASGP = WS_ASGE + al256((size_t)NT * 4 * 4);
constexpr size_t WS_ASGS = WS_ASGP + al256((size_t)NT * 4 * 4);
constexpr size_t WS_ASGW = WS_ASGS + al256((size_t)NT * 4 * 4);
constexpr size_t WS_TAB = WS_ASGW + al256((size_t)NT * 4 * 4);
constexpr size_t WS_SLTOK = WS_TAB + al256(4096 * 4);
constexpr size_t WS_RA = WS_SLTOK + al256((size_t)NSLOT * 4);
constexpr size_t WS_P = WS_RA;
constexpr size_t WS_RB = WS_P + al256((size_t)NT * NP * 2);
constexpr size_t WS_HYC = WS_RB;
constexpr size_t WS_Z1 = WS_HYC + al256((size_t)NT * 1152 * 2);
constexpr size_t WS_QKC = WS_Z1 + al256((size_t)NT * DH * 4);
constexpr size_t WS_GI = WS_QKC + al256((size_t)NT * 768 * 4);
constexpr size_t WS_GF = WS_GI + al256((size_t)2 * NT * 4 * 4);
constexpr size_t WS_CF = WS_GF + al256((size_t)2 * NT * 4 * 4);
constexpr size_t WS_HFB = WS_CF + al256((size_t)2 * NT * 4 * 4);
constexpr size_t WS_YS5 = WS_HFB + al256((size_t)2 * NT * DH * 4);
constexpr size_t WS_G = WS_YS5 + al256((size_t)NT * DH * 4);
constexpr size_t WS_XS = WS_G + al256((size_t)NT * DH * 2);
constexpr size_t WS_YF = WS_XS;
constexpr size_t WS_YB = WS_YF + al256((size_t)NT * D * 4);
constexpr size_t WS_END1 = WS_XS + al256((size_t)NT * S5G * S5P * 8);
constexpr size_t WS_AS = WS_RA;
constexpr size_t WS_ACT = WS_AS + al256((size_t)NSLOT * D * 2);
constexpr size_t WS_OUTS = WS_ACT + al256((size_t)NSLOT * FF * 2);
constexpr size_t WS_OUTSC = WS_OUTS + al256((size_t)NSLOT * D);
constexpr size_t WS_END2 = WS_OUTS + al256((size_t)NSLOT * D * 2);
constexpr size_t WS_END12 = WS_END1 > WS_END2 ? WS_END1 : WS_END2;
constexpr int RKP0 = 2 * SEQ + 24, RKP1 = 2 * CTXL + 24;
constexpr size_t WS_RK0 = WS_END12;
constexpr size_t WS_RK1 = WS_RK0 + al256((size_t)DEPTH * 2 * DH * 2 * RKP0 * 2);
constexpr size_t WS_S5TAB = WS_RK1 + al256((size_t)DEPTH * 2 * DH * 2 * RKP1 * 2);
constexpr size_t WS_KD = WS_S5TAB + al256((size_t)DEPTH * 2 * S5G * S5P * 16);
constexpr size_t WS_BT1 = WS_KD + al256((size_t)DEPTH * S5G * 2 * 32 * 256 * 4);
constexpr size_t WS_BT2 = WS_BT1 + al256((size_t)DEPTH * S5G * 768 * 512 * 2);
constexpr size_t WS_WRH = WS_BT2 + al256((size_t)DEPTH * S5G * 512 * 256 * 2);
constexpr size_t WS_WRL = WS_WRH + al256((size_t)DEPTH * NE * D * 2);
constexpr size_t WS_MODP = WS_WRL + al256((size_t)DEPTH * NE * D * 2);
constexpr size_t WS_HD1 = WS_MODP + al256((size_t)16 * DEPTH * NMOD * 6144 * 4);
constexpr size_t WS_POWT = WS_HD1 + al256((size_t)DEPTH * NPOS * 64 * 4);
constexpr int RKT_LAT = SEQ / 64, RKT_CTX = CTXL / 64;
constexpr size_t WS_NRMP = WS_POWT + al256((size_t)DEPTH * 2 * S5G * S5P * 33 * 8);
constexpr size_t WS_ZT = WS_NRMP + al256((size_t)DEPTH * 2 * 2 * DH * 64 * 4);
constexpr size_t WS_HS = WS_ZT + al256((size_t)NPOS * 33 * 4);
constexpr size_t WS_WSC = WS_HS + al256((size_t)NT * 4);
constexpr size_t WS_W1S = WS_WSC + al256((size_t)DEPTH * NP * 4);
constexpr size_t WS_SLS = WS_W1S + al256((size_t)DEPTH * NE * 1024 * 4);
constexpr size_t WS_END = WS_SLS + al256((size_t)NSLOT * 4);
constexpr int S5T = 32, S5R = NT / S5T, S5RP = ((S5R + 255) / 256) * 256;
constexpr size_t WS_SLOC = WS_YB + al256((size_t)NT * D * 2);
constexpr size_t WS_XIN = WS_SLOC + al256((size_t)S5G * S5RP * 256 * 4);
static_assert(WS_XIN + (size_t)S5G * S5RP * 256 * 2 <= WS_END1, "S5 chunk buffers inside the old XS region");
constexpr size_t WS_VT = WS_HYC, WS_X1T = WS_VT + (size_t)DH * NB * NPOS * 2, WS_X2T = WS_X1T + (size_t)DH * NB * NPOS * 2;
constexpr size_t WS_Z1T = WS_Z1, WS_HYT = WS_Z1T + (size_t)DH * NB * NPOS * 2;
static_assert(WS_X2T + (size_t)DH * NB * NPOS * 2 <= WS_Z1 && WS_HYT + (size_t)DH * NB * NPOS * 2 <= WS_QKC, "hyena channel-major buffers");
static_assert(WS_YB + (size_t)NT * D * 2 <= WS_END1, "YF/YB inside XS");

struct Ctx {
    const float* in[N_INPUTS];
    float* out;
    unsigned char* ws;
    int ph_lo, ph_hi;
};
template <class T> HD T* wsp(const Ctx& c, size_t off) { return (T*)(c.ws + off); }

HD unsigned f2bf_bits(float f) { unsigned u; __builtin_memcpy(&u, &f, 4); return (u + 0x7fffu + ((u >> 16) & 1u)) >> 16; }
HD bf16 f2bf(float f) { return (bf16)f2bf_bits(f); }
HD float bf2f(bf16 b) { unsigned u = ((unsigned)b) << 16; float f; __builtin_memcpy(&f, &u, 4); return f; }
HD float sigm(float x) { return 1.0f / (1.0f + expf(-x)); }
HD float siluf(float x) { return x * sigm(x); }
HD float logsig(float x) { return x >= 0.f ? -log1pf(expf(-x)) : x - log1pf(expf(x)); }
HD float gelu_t(float x) { return 0.5f * x * (1.0f + tanhf(0.7978845608028654f * (x + 0.044715f * x * x * x))); }
HD void tokinfo(int r, int& b, int& t, int& L, int& base, int& mb) {
    if (r < NTL) { b = r / SEQ; t = r % SEQ; L = SEQ; base = b * SEQ; mb = b; }
    else { const int q = r - NTL; b = q / CTXL; t = q % CTXL; L = CTXL; base = NTL + b * CTXL; mb = NB; }
}
HD bool has_prev(int r) { if (r < NTL) return (r % GRIDW) != 0; return ((r - NTL) % CTXL) != 0; }
HD bool has_next(int r) { if (r < NTL) return (r % GRIDW) != GRIDW - 1; return ((r - NTL) % CTXL) != CTXL - 1; }
HD int seq_tok(int d, int b, int tau) {
    if (tau < CTXL) return NTL + b * CTXL + (d ? CTXL - 1 - tau : tau);
    const int t = tau - CTXL; return b * SEQ + (d ? SEQ - 1 - t : t);
}
HD int tok_tau(int d, int r) {
    if (r < NTL) { const int t = r % SEQ; return CTXL + (d ? SEQ - 1 - t : t); }
    const int t = (r - NTL) % CTXL; return d ? CTXL - 1 - t : t;
}

#define GS_LOOP(it, n) for (long it = gtid; it < (long)(n); it += gstride)

HD void ph_pre0(const Ctx& c, long gtid, long gstride) {
    float* SL = wsp<float>(c, WS_SILU);
    GS_LOOP(i, NMOD * D) { const int mb = (int)(i / D), k = (int)(i % D); const float v = mb < NB ? c.in[I_C][mb * D + k] : c.in[I_CCTX][k]; SL[i] = siluf(v); }
}
HD void ph_wmax(const Ctx& c, long gtid, long gstride) {
    float* WSC = wsp<float>(c, WS_WSC);
    GS_LOOP(it, DEPTH * NP) { const int n = (int)(it % NP), l = (int)(it / NP), sc = win_src_col(n); float mx = 0.f;
        if (sc >= 0) { const float* w = c.in[I_WIN] + (size_t)l * D * NIN + sc;
            for (int k0 = 0; k0 < D; k0 += 16) { float v[16];
#pragma unroll
                for (int u = 0; u < 16; ++u) v[u] = w[(size_t)(k0 + u) * NIN];
#pragma unroll
                for (int u = 0; u < 16; ++u) mx = fmaxf(mx, fabsf(v[u])); } }
        WSC[it] = mx > 0.f ? mx * (1.0f / 127.0f) : 1.0f; }
}
HD void ph_w1max(const Ctx& c, long gtid, long gstride) {
    float* W1S = wsp<float>(c, WS_W1S);
    GS_LOOP(it, DEPTH * NE * 1024) { const int n = (int)(it % 1024); const long le = it / 1024; const float* w = c.in[I_W1] + (size_t)le * D * 1024 + n; float mx = 0.f;
        for (int k0 = 0; k0 < D; k0 += 16) { float v[16];
#pragma unroll
            for (int u = 0; u < 16; ++u) v[u] = w[(size_t)(k0 + u) * 1024];
#pragma unroll
            for (int u = 0; u < 16; ++u) mx = fmaxf(mx, fabsf(v[u])); }
        W1S[it] = mx > 0.f ? mx * (1.0f / 127.0f) : 1.0f; }
}
HD void ph_modp(const Ctx& c, long gtid, long gstride) {
    const float* SL = wsp<float>(c, WS_SILU); float* MP = wsp<float>(c, WS_MODP);
    GS_LOOP(it, 8 * DEPTH * 6144) { const int col = (int)(it % 6144), l = (int)((it / 6144) % DEPTH), ks = (int)(it / (6144 * DEPTH));
        float acc[NMOD];
#pragma unroll
        for (int m = 0; m < NMOD; ++m) acc[m] = 0.f;
        const float* w = c.in[I_ADAW] + ((size_t)l * D + ks * 128) * 6144 + col;
        for (int k = 0; k < 128; ++k) { const float wv = w[(size_t)k * 6144];
#pragma unroll
            for (int m = 0; m < NMOD; ++m) acc[m] += SL[m * D + ks * 128 + k] * wv; }
#pragma unroll
        for (int m = 0; m < NMOD; ++m) MP[(((size_t)ks * DEPTH + l) * NMOD + m) * 6144 + col] = acc[m]; }
}
HD void ph_modf(const Ctx& c, long gtid, long gstride) {
    const float* MP = wsp<float>(c, WS_MODP); float* MOD = wsp<float>(c, WS_MOD);
    GS_LOOP(it, DEPTH * NMOD * 6144) { const int col = (int)(it % 6144), l = (int)(it / ((long)NMOD * 6144)); float v = c.in[I_ADAB][l * 6144 + col];
#pragma unroll
        for (int ks = 0; ks < 16; ++ks) v += MP[(size_t)ks * DEPTH * NMOD * 6144 + it];
        MOD[it] = v; }
}
HD void ph_zt(const Ctx& c, long gtid, long gstride) {
    float* ZT = wsp<float>(c, WS_ZT);
    GS_LOOP(it, NPOS * 33) { const int e = (int)(it % 33), pidx = (int)(it / 33); const int L = pidx < SEQ ? SEQ : CTXL, t = pidx < SEQ ? pidx : pidx - SEQ;
        const float w = 6.283185307179586f * (float)t / (float)L; float v;
        if (e == 0) v = (float)t / (float)(L - 1);
        else { const int j = (e - 1) & 15; const float f = 1e-4f + (float)j * ((15.0f - 1e-4f) / 15.0f); v = e <= 16 ? cosf(f * w) : -sinf(f * w); }
        ZT[it] = v; }
}
HD void ph_hd1(const Ctx& c, long gtid, long gstride) {
    float* HD1 = wsp<float>(c, WS_HD1); const float* ZT = wsp<float>(c, WS_ZT);
    GS_LOOP(it, (long)DEPTH * NPOS * 64) { const int k = (int)(it % 64); const long q = it / 64; const int pidx = (int)(q % NPOS), l = (int)(q / NPOS);
        const float* w1 = c.in[I_HW1] + (size_t)l * 33 * 64 + k; const float* z = ZT + pidx * 33; float a1 = c.in[I_HB1][l * 64 + k];
#pragma unroll
        for (int e = 0; e < 33; ++e) a1 += z[e] * w1[e * 64];
        HD1[it] = sinf(c.in[I_HSF][l * 128 + k] * a1); }
}
HD void ph_hd2(const Ctx& c, long gtid, long gstride) {
    const float* HD1 = wsp<float>(c, WS_HD1); float* HD2 = wsp<float>(c, WS_HD2);
    GS_LOOP(it, (long)DEPTH * NPOS * 64) { const int i = (int)(it % 64); const long q = it / 64; const int l = (int)(q / NPOS);
        const float* h = HD1 + q * 64; const float* w2 = c.in[I_HW2] + (size_t)l * 64 * 64 + i; float a2 = c.in[I_HB2][l * 64 + i];
        float wv[64];
#pragma unroll
        for (int k = 0; k < 64; ++k) wv[k] = w2[k * 64];
#pragma unroll
        for (int k = 0; k < 64; ++k) a2 += h[k] * wv[k];
        HD2[it] = sinf(c.in[I_HSF][l * 128 + 64 + i] * a2); }
}
HD void ph_hyf2(const Ctx& c, long gtid, long gstride) {
    const float* HD2 = wsp<float>(c, WS_HD2); float* HF = wsp<float>(c, WS_HF);
    static_assert(NPOS % 4 == 0, "four positions per item");
    GS_LOOP(it, (long)DEPTH * (NPOS / 4) * 1536) { const int j = (int)(it % 1536); const long q4 = it / 1536; const int p4 = (int)(q4 % (NPOS / 4)), l = (int)(q4 / (NPOS / 4));
        const float* w3 = c.in[I_HW3] + (size_t)l * 64 * 1536 + j; float w[64];
#pragma unroll
        for (int i = 0; i < 64; ++i) w[i] = w3[(size_t)i * 1536];
        const float b3 = c.in[I_HB3][l * 1536 + j]; const int ch = j % DH;
        const float dmin = -3.0701134573253940f, dmax = -15.350567286626973f;
        const float delta = fabsf(dmin + (float)ch * ((dmax - dmin) / 383.0f));
#pragma unroll
        for (int u = 0; u < 4; ++u) { const int pidx = p4 * 4 + u; const int L = pidx < SEQ ? SEQ : CTXL, t = pidx < SEQ ? pidx : pidx - SEQ;
            const float* h = HD2 + ((size_t)l * NPOS + pidx) * 64; float a = b3;
#pragma unroll
            for (int i = 0; i < 64; ++i) a += h[i] * w[i];
            HF[((size_t)l * NPOS + pidx) * 1536 + j] = a * expf(-((float)t / (float)(L - 1)) * delta); } }
}
HD float hy_tap(const float* HFl, int pb, int o, int ch, int lag) {
    return lag >= 0 ? HFl[(size_t)(pb + lag) * 1536 + o * 768 + ch] : HFl[(size_t)(pb - lag) * 1536 + o * 768 + DH + ch];
}
HD void ph_s5tab(const Ctx& c, long gtid, long gstride) {
    float* TAB = wsp<float>(c, WS_S5TAB);
    GS_LOOP(it, DEPTH * 2 * S5G * S5P) { const int p = (int)(it % S5P), g = (int)((it / S5P) % S5G), d = (int)((it / (S5P * S5G)) % 2), l = (int)(it / (S5P * S5G * 2));
        const size_t li = ((size_t)(l * 2 + d) * S5G + g) * S5P + p;
        const float lre = c.in[I_LRE][li], lim = c.in[I_LIM][li], dt = expf(c.in[I_LDT][(l * 2 + d) * S5G + g]);
        const float mag = expf(lre * dt), lbr = mag * cosf(lim * dt), lbi = mag * sinf(lim * dt);
        const float nr = lbr - 1.0f, ni = lbi, den = lre * lre + lim * lim;
        TAB[it * 4 + 0] = lre * dt; TAB[it * 4 + 1] = lim * dt; TAB[it * 4 + 2] = (nr * lre + ni * lim) / den; TAB[it * 4 + 3] = (ni * lre - nr * lim) / den; }
}
HD void s5_pow(const float* tab, float e, float& pr, float& pi) { const float mg = expf(e * tab[0]); pr = mg * cosf(e * tab[1]); pi = mg * sinf(e * tab[1]); }
HD void ph_s5pow(const Ctx& c, long gtid, long gstride) {
    const float* TAB = wsp<float>(c, WS_S5TAB); float* PW = wsp<float>(c, WS_POWT);
    GS_LOOP(it, (long)DEPTH * 2 * S5G * S5P * 33) { const int e = (int)(it % 33); const long q = it / 33; float pr, pi; s5_pow(TAB + q * 4, (float)e, pr, pi); PW[it * 2] = pr; PW[it * 2 + 1] = pi; }
}
HD void ph_s5gen1(const Ctx& c, long gtid, long gstride) {
    const float* TAB = wsp<float>(c, WS_S5TAB); float* KD = wsp<float>(c, WS_KD);
    GS_LOOP(it, DEPTH * S5G * 2 * 256) { const int m = (int)(it % 16), n = (int)((it / 16) % 16), d = (int)((it / 256) % 2), g = (int)((it / 512) % S5G), l = (int)(it / (512 * S5G));
        float acc[S5T];
#pragma unroll
        for (int j = 0; j < S5T; ++j) acc[j] = 0.f;
        for (int p0 = 0; p0 < S5P; p0 += 8) { float t0[8], t1[8], t2[8], t3[8], brv[8], biv[8], crv[8], civ[8];
#pragma unroll
            for (int u = 0; u < 8; ++u) { const int p = p0 + u; const float* tb = TAB + ((((size_t)l * 2 + d) * S5G + g) * S5P + p) * 4; t0[u] = tb[0]; t1[u] = tb[1]; t2[u] = tb[2]; t3[u] = tb[3];
                const size_t bi = (((size_t)l * S5G + g) * S5P + p) * S5N + m, ci = (((size_t)l * S5G + g) * S5N + n) * S5P + p;
                brv[u] = c.in[I_BRE][bi]; biv[u] = c.in[I_BIM][bi]; crv[u] = c.in[I_CRE][ci]; civ[u] = c.in[I_CIM][ci]; }
#pragma unroll
            for (int u = 0; u < 8; ++u) { const float bbr = t2[u] * brv[u] - t3[u] * biv[u], bbi = t2[u] * biv[u] + t3[u] * brv[u];
                float zr = crv[u] * bbr - civ[u] * bbi, zi = crv[u] * bbi + civ[u] * bbr;
                const float mg = expf(t0[u]), lbr = mg * cosf(t1[u]), lbi = mg * sinf(t1[u]);
#pragma unroll
                for (int j = 0; j < S5T; ++j) { acc[j] += zr; const float t = zr * lbr - zi * lbi; zi = zr * lbi + zi * lbr; zr = t; } } }
#pragma unroll
        for (int j = 0; j < S5T; ++j) KD[((((size_t)l * S5G + g) * 2 + d) * S5T + j) * 256 + n * 16 + m] = acc[j]; }
}
HD void ph_s5gen2(const Ctx& c, long gtid, long gstride) {
    const float* TAB = wsp<float>(c, WS_S5TAB); const float* KD = wsp<float>(c, WS_KD); bf16* BT1 = wsp<bf16>(c, WS_BT1); bf16* BT2 = wsp<bf16>(c, WS_BT2); const float* PW = wsp<float>(c, WS_POWT);
    GS_LOOP(it16, (long)DEPTH * S5G * 768 * 32) { const long it = it16 * 16; const int s = (int)(it16 % 32), n1 = (int)((it16 / 32) % 768); const long lg = it16 / (32 * 768); const int g = (int)(lg % S5G), l = (int)(lg / S5G);
        float v[16];
        if (n1 < 512) { const int t = n1 / 16, n = n1 % 16; const float* kd = KD + (((size_t)l * S5G + g) * 2) * S5T * 256 + n * 16;
            if (t != s) { const float* q = kd + (size_t)(t > s ? t - s : S5T + s - t) * 256;
#pragma unroll
                for (int u = 0; u < 16; ++u) v[u] = q[u]; }
            else { const float* q = kd + (size_t)S5T * 256; const float dd = c.in[I_S5D][l * DH + g * S5N + n];
#pragma unroll
                for (int u = 0; u < 16; ++u) v[u] = kd[u] + q[u] + (n == u ? dd : 0.f); } }
        else { const int idx = n1 - 512, d = idx / 128, p = (idx % 128) / 2, cc = idx % 2; const float* tb = TAB + ((((size_t)l * 2 + d) * S5G + g) * S5P + p) * 4;
            const size_t bi = (((size_t)l * S5G + g) * S5P + p) * S5N; const float t2 = tb[2], t3 = tb[3];
            const float* pw = PW + (((((size_t)l * 2 + d) * S5G + g) * S5P + p) * 33 + (d == 0 ? S5T - 1 - s : s)) * 2; const float pr = pw[0], pi = pw[1];
            float br[16], bim[16];
#pragma unroll
            for (int u = 0; u < 16; ++u) { br[u] = c.in[I_BRE][bi + u]; bim[u] = c.in[I_BIM][bi + u]; }
#pragma unroll
            for (int u = 0; u < 16; ++u) { const float bbr = t2 * br[u] - t3 * bim[u], bbi = t2 * bim[u] + t3 * br[u]; v[u] = cc == 0 ? pr * bbr - pi * bbi : pr * bbi + pi * bbr; } }
#pragma unroll
        for (int u = 0; u < 16; ++u) BT1[it + u] = f2bf(v[u]); }
    GS_LOOP(it16, (long)DEPTH * S5G * 512 * 16) { const long it = it16 * 16; const int k16 = (int)(it16 % 16), n2 = (int)((it16 / 16) % 512); const long lg = it16 / (16 * 512); const int g = (int)(lg % S5G), l = (int)(lg / S5G);
        const int t = n2 / 16, n = n2 % 16, d = k16 / 8, p0 = (k16 % 8) * 8; float cr[8], cim[8], pr[8], pi[8];
        const size_t ci = (((size_t)l * S5G + g) * S5N + n) * S5P + p0;
#pragma unroll
        for (int u = 0; u < 8; ++u) { cr[u] = c.in[I_CRE][ci + u]; cim[u] = c.in[I_CIM][ci + u];
            const float* pw = PW + (((((size_t)l * 2 + d) * S5G + g) * S5P + p0 + u) * 33 + (d == 0 ? t + 1 : S5T - t)) * 2; pr[u] = pw[0]; pi[u] = pw[1]; }
#pragma unroll
        for (int u = 0; u < 8; ++u) { BT2[it + 2 * u] = f2bf(cr[u] * pr[u] - cim[u] * pi[u]); BT2[it + 2 * u + 1] = f2bf(-(cr[u] * pi[u] + cim[u] * pr[u])); } }
}
HD int s5_row(int d, int b, int step) {
    constexpr int NCC = CTXL / S5T, NCL = SEQ / S5T;
    if (step < NCC) return NTL / S5T + b * NCC + (d ? NCC - 1 - step : step);
    const int i = step - NCC; return b * NCL + (d ? NCL - 1 - i : i);
}
HD void ph_s5cscan(const Ctx& c, int l, long gtid, long gstride) {
    const float* TAB = wsp<float>(c, WS_S5TAB); const float* SL = wsp<float>(c, WS_SLOC); bf16* XI = wsp<bf16>(c, WS_XIN);
    GS_LOOP(it, NB * S5G * 2 * S5P) { const int p = (int)(it % S5P), d = (int)((it / S5P) % 2), g = (int)((it / (2 * S5P)) % S5G), b = (int)(it / (2 * S5P * S5G));
        const float* tb = TAB + ((((size_t)l * 2 + d) * S5G + g) * S5P + p) * 4; float lr, li; s5_pow(tb, (float)S5T, lr, li);
        float xr = 0.f, xi = 0.f;
        for (int st0 = 0; st0 < NPOS / S5T; st0 += 8) { float sr[8], si[8]; size_t o[8];
#pragma unroll
            for (int k = 0; k < 8; ++k) { o[k] = ((size_t)g * S5RP + s5_row(d, b, st0 + k)) * 256 + d * 128 + 2 * p; sr[k] = SL[o[k]]; si[k] = SL[o[k] + 1]; }
#pragma unroll
            for (int k = 0; k < 8; ++k) { XI[o[k]] = f2bf(xr); XI[o[k] + 1] = f2bf(xi); const float t = lr * xr - li * xi + sr[k]; xi = lr * xi + li * xr + si[k]; xr = t; } } }
}
HD void ph_wr(const Ctx& c, long gtid, long gstride) {
    bf16* WH = wsp<bf16>(c, WS_WRH); bf16* WL = wsp<bf16>(c, WS_WRL);
    GS_LOOP(it, DEPTH * NE * D) { const int k = (int)(it % D), e = (int)((it / D) % NE), l = (int)(it / (D * NE)); const float w = c.in[I_RW][((size_t)l * D + k) * NE + e];
        const bf16 hi = f2bf(w); WH[it] = hi; WL[it] = f2bf(w - bf2f(hi)); }
}
HD void ph_norm1(const Ctx& c, int l, long gtid, long gstride) {
    const float* X = wsp<float>(c, WS_X); bf16* H = wsp<bf16>(c, WS_H); const float* MOD = wsp<float>(c, WS_MOD);
    GS_LOOP(r, NT) { int b, t, L, base, mb; tokinfo((int)r, b, t, L, base, mb);
        const float* x = X + (size_t)r * D; float ss = 0.f;
        for (int k = 0; k < D; ++k) ss += x[k] * x[k];
        const float rs = 1.0f / sqrtf(ss / D + EPS);
        const float* g = c.in[I_N1G] + l * D; const float* sh = MOD + ((size_t)l * NMOD + mb) * 6144; const float* sc = sh + D;
        for (int k = 0; k < D; ++k) H[(size_t)r * D + k] = f2bf(x[k] * rs * g[k] * (1.0f + sc[k]) + sh[k]); }
}
HD float conv3(const bf16* P, int r, int col, const float* w, const float* b, int wpitch, int j) {
    float y = b[j] + bf2f(P[(size_t)r * NP + col]) * w[wpitch + j];
    if (has_prev(r)) y += bf2f(P[(size_t)(r - 1) * NP + col]) * w[j];
    if (has_next(r)) y += bf2f(P[(size_t)(r + 1) * NP + col]) * w[2 * wpitch + j];
    return y;
}
HD void ph_s5scan(const Ctx& c, int l, int d, long gtid, long gstride) {
    const bf16* P = wsp<bf16>(c, WS_P); float* XS = wsp<float>(c, WS_XS);
    GS_LOOP(it, NB * S5G * S5P) { const int p = (int)(it % S5P), g = (int)((it / S5P) % S5G), b = (int)(it / (S5P * S5G));
        const size_t li = ((size_t)(l * 2 + d) * S5G + g) * S5P + p;
        const float lre = c.in[I_LRE][li], lim = c.in[I_LIM][li], dt = expf(c.in[I_LDT][(l * 2 + d) * S5G + g]);
        const float mag = expf(lre * dt), lbr = mag * cosf(lim * dt), lbi = mag * sinf(lim * dt);
        const float nr = lbr - 1.0f, ni = lbi, den = lre * lre + lim * lim;
        const float rr = (nr * lre + ni * lim) / den, ri = (ni * lre - nr * lim) / den;
        float bbr[S5N], bbi[S5N];
#pragma unroll
        for (int n = 0; n < S5N; ++n) { const size_t bi = (((size_t)l * S5G + g) * S5P + p) * S5N + n; const float br = c.in[I_BRE][bi], bim = c.in[I_BIM][bi];
            bbr[n] = rr * br - ri * bim; bbi[n] = rr * bim + ri * br; }
        float xr = 0.f, xi = 0.f;
        for (int tau = 0; tau < NPOS; ++tau) { const int r = seq_tok(d, b, tau); const bf16* u = P + (size_t)r * NP + PC_S5 + g * S5N;
            float ur = 0.f, ui = 0.f;
#pragma unroll
            for (int n = 0; n < S5N; ++n) { const float uv = bf2f(u[n]); ur += bbr[n] * uv; ui += bbi[n] * uv; }
            const float nxr = lbr * xr - lbi * xi + ur, nxi = lbr * xi + lbi * xr + ui; xr = nxr; xi = nxi;
            float* o = XS + (((size_t)r * S5G + g) * S5P + p) * 2; o[0] = xr; o[1] = xi; } }
}
HD void ph_mixA(const Ctx& c, int l, long gtid, long gstride) {
    const bf16* P = wsp<bf16>(c, WS_P);
}
HD void ph_s5proj(const Ctx& c, int l, int d, long gtid, long gstride) {
    const bf16* P = wsp<bf16>(c, WS_P); const float* XS = wsp<float>(c, WS_XS); float* YS = wsp<float>(c, WS_YS5); bf16* G = wsp<bf16>(c, WS_G);
    GS_LOOP(it, (long)NT * DH) { const int n = (int)(it % S5N), g = (int)((it / S5N) % S5G), r = (int)(it / DH);
        const float* cr = c.in[I_CRE] + (((size_t)l * S5G + g) * S5N + n) * S5P; const float* ci = c.in[I_CIM] + (((size_t)l * S5G + g) * S5N + n) * S5P;
        const float* xs = XS + ((size_t)r * S5G + g) * S5P * 2; float a = 0.f;
        for (int p = 0; p < S5P; ++p) a += xs[2 * p] * cr[p] - xs[2 * p + 1] * ci[p];
        if (d == 0) YS[it] = c.in[I_S5D][l * DH + g * S5N + n] * bf2f(P[(size_t)r * NP + PC_S5 + g * S5N + n]) + a;
        else G[it] = f2bf(gelu_t(YS[it] + a)); }
}
HD void ph_mixB(const Ctx& c, int l, long gtid, long gstride) {
}
HD void ph_mixC(const Ctx& c, int l, long gtid, long gstride) {
}
HD void ph_mixD(const Ctx& c, int l, long gtid, long gstride) {
    const bf16* P = wsp<bf16>(c, WS_P); const float* HFB = wsp<float>(c, WS_HFB); bf16* MLO = wsp<bf16>(c, WS_MLO);
    GS_LOOP(it, (long)NT * MLH) { const int h = (int)(it % MLH), r = (int)(it / MLH);
        const float* a = HFB + (size_t)r * DH + h * MLD; const float* bq = HFB + ((size_t)NT + r) * DH + h * MLD; float ss = 0.f;
        for (int e = 0; e < MLD; ++e) { const float v = a[e] + bq[e]; ss += v * v; }
        const float rs = 1.0f / sqrtf(ss / MLD + EPS);
        for (int e = 0; e < MLD; ++e) { const float v = (a[e] + bq[e]) * rs * c.in[I_MLNG][l * DH + h * MLD + e];
            MLO[(size_t)r * DH + h * MLD + e] = f2bf(v * sigm(bf2f(P[(size_t)r * NP + PC_O + h * MLD + e]))); } }
}
#ifdef HOST_TEST
HD int atomic_inc(unsigned* p) { return (int)((*p)++); }
#else
__device__ __forceinline__ int atomic_inc(unsigned* p) { return (int)__hip_atomic_fetch_add(p, 1u, __ATOMIC_RELAXED, __HIP_MEMORY_SCOPE_AGENT); }
#endif
HD void ph_route(const Ctx& c, int l, long gtid, long gstride) {
    const float* X = wsp<float>(c, WS_X); bf16* H = wsp<bf16>(c, WS_H); const float* MOD = wsp<float>(c, WS_MOD);
    int* AE = wsp<int>(c, WS_ASGE); int* AP = wsp<int>(c, WS_ASGP); float* AW = wsp<float>(c, WS_ASGW); unsigned* CNT = wsp<unsigned>(c, WS_CTL) + CW_CNT + l * NE;
    GS_LOOP(r, NT) { int b, t, L, base, mb; tokinfo((int)r, b, t, L, base, mb);
        const float* x = X + (size_t)r * D; float ss = 0.f;
        for (int k = 0; k < D; ++k) ss += x[k] * x[k];
        const float rs = 1.0f / sqrtf(ss / D + EPS);
        const float* g = c.in[I_N2G] + l * D; const float* sh = MOD + ((size_t)l * NMOD + mb) * 6144 + 3 * D; const float* sc = sh + D;
        const float* rw = c.in[I_RW] + (size_t)l * D * NE;
        float lg[NE];
#pragma unroll
        for (int e = 0; e < NE; ++e) lg[e] = c.in[I_RB][l * NE + e];
        for (int k = 0; k < D; ++k) { const float hv = x[k] * rs * g[k] * (1.0f + sc[k]) + sh[k]; H[(size_t)r * D + k] = f2bf(hv);
#pragma unroll
            for (int e = 0; e < NE; ++e) lg[e] += hv * rw[k * NE + e]; }
        int sel[TOPK]; float sv[TOPK]; unsigned taken = 0u;
#pragma unroll
        for (int kk = 0; kk < TOPK; ++kk) { float best = -3.0e38f; int bi = 0;
#pragma unroll
            for (int e = 0; e < NE; ++e) { if (!((taken >> e) & 1u) && lg[e] > best) { best = lg[e]; bi = e; } }
            sel[kk] = bi; sv[kk] = best; taken |= 1u << bi; }
        float es[TOPK], sum = 0.f;
#pragma unroll
        for (int kk = 0; kk < TOPK; ++kk) { es[kk] = expf(sv[kk] - sv[0]); sum += es[kk]; }
#pragma unroll
        for (int kk = 0; kk < TOPK; ++kk) { AE[r * TOPK + kk] = sel[kk]; AW[r * TOPK + kk] = es[kk] / sum; AP[r * TOPK + kk] = atomic_inc(CNT + sel[kk]); } }
}
HD void ph_offs(const Ctx& c, int l, long gtid, long gstride) {
    if (gtid != 0) return;
    const unsigned* CNT = wsp<unsigned>(c, WS_CTL) + CW_CNT + l * NE; int* TAB = wsp<int>(c, WS_TAB); int run = 0;
    for (int e = 0; e < NE; ++e) { TAB[e] = run * 256; const int nb = ((int)CNT[e] + 255) / 256; for (int j = 0; j < nb; ++j) TAB[64 + run + j] = e; run += nb; }
    TAB[32] = run;
}
HD void ph_dispatch(const Ctx& c, int l, long gtid, long gstride) {
    const int* AE = wsp<int>(c, WS_ASGE); const int* AP = wsp<int>(c, WS_ASGP); int* AS_ = wsp<int>(c, WS_ASGS); const int* TAB = wsp<int>(c, WS_TAB);
    const uint4* H = wsp<uint4>(c, WS_H); uint4* A = wsp<uint4>(c, WS_AS);
    GS_LOOP(it, (long)NT * TOPK * 128) { const int ch = (int)(it % 128); const long a = it / 128; const int r = (int)(a / TOPK);
        const int slot = TAB[AE[a]] + AP[a]; A[(size_t)slot * 128 + ch] = H[(size_t)r * 128 + ch]; if (ch == 0) AS_[a] = slot; }
}
HD void ph_combine(const Ctx& c, int l, long gtid, long gstride) {
    const int* AS_ = wsp<int>(c, WS_ASGS); const float* AW = wsp<float>(c, WS_ASGW); const bf16* O = wsp<bf16>(c, WS_OUTS); float* X = wsp<float>(c, WS_X); const float* MOD = wsp<float>(c, WS_MOD);
    GS_LOOP(it, (long)NT * D) { const int col = (int)(it % D), r = (int)(it / D); int b, t, L, base, mb; tokinfo(r, b, t, L, base, mb); float f = 0.f;
#pragma unroll
        for (int kk = 0; kk < TOPK; ++kk) f += AW[r * TOPK + kk] * bf2f(O[(size_t)AS_[r * TOPK + kk] * D + col]);
        X[it] += MOD[((size_t)l * NMOD + mb) * 6144 + 5 * D + col] * f; }
}
HD void ph_final(const Ctx& c, long gtid, long gstride) {
    const float* X = wsp<float>(c, WS_X);
    GS_LOOP(r, NTL) { const float* x = X + (size_t)r * D; float ss = 0.f;
        for (int k = 0; k < D; ++k) ss += x[k] * x[k];
        const float rs = 1.0f / sqrtf(ss / D + EPS);
        for (int k = 0; k < D; ++k) c.out[(size_t)r * D + k] = x[k] * rs * c.in[I_FNG][k]; }
}

constexpr int NPRO = 5, NLP = 12, NPHASE = NPRO + DEPTH * NLP + 1;

#ifndef HOST_TEST
#define LAS __attribute__((address_space(3)))
#define GAS __attribute__((address_space(1)))
typedef unsigned v4u __attribute__((ext_vector_type(4)));
typedef unsigned v2u __attribute__((ext_vector_type(2)));
#define LDS_WAIT() asm volatile("s_waitcnt lgkmcnt(0)" ::: "memory")

namespace pg8 {
#define PG8_LAS __attribute__((address_space(3)))
typedef unsigned short bf16_t;
typedef short bf16x8 __attribute__((ext_vector_type(8)));
typedef float f32x4 __attribute__((ext_vector_type(4)));
typedef unsigned u32x4 __attribute__((ext_vector_type(4)));
constexpr int BM = 256, BK = 64, HALF = 128, HTB = HALF * BK * 2, STAGE_BYTES = 8 * HTB, NXCD = 8, WGM = 8;
__host__ __device__ __forceinline__ int lds_byte(int r, int c) { const int st = (r >> 4) * 2 + (c >> 5), rr = r & 15, cc = c & 31, ob = rr * 64 + cc * 2; return st * 1024 + (ob ^ (((ob >> 9) & 1) << 5)); }
__host__ __device__ __forceinline__ void stage_rc(int b, int& R, int& C) { const int st = b / 1024, sb = b % 1024, swz = sb ^ (((sb >> 9) & 1) << 5); R = (st >> 1) * 16 + swz / 64; C = (st & 1) * 32 + (swz % 64) / 2; }
__host__ __device__ __forceinline__ int perm32(int rho) { const int n = rho >> 4, i = rho & 15; return 8 * (i >> 2) + 4 * n + (i & 3); }

struct Unit { int pm, pn, pb, e; };
struct Gemm { const bf16_t* A; const bf16_t* Bt; int M, N, K; unsigned a_row, a_kstep, a_sub, a_grp; int a_mode; const int* a_gather; };
__host__ __device__ __forceinline__ Gemm make_gemm(const bf16_t* A, const bf16_t* Bt, int M, int N, int K) { Gemm g; g.A = A; g.Bt = Bt; g.M = M; g.N = N; g.K = K; g.a_row = (unsigned)K * 2u; g.a_kstep = BK * 2; g.a_sub = 0; g.a_grp = 0; g.a_mode = 0; g.a_gather = nullptr; return g; }

struct StaticOrder {
    static constexpr bool GATHER = false;
    int nM, nN, nwg, G, c;
    __host__ __device__ void init(int M, int N, int G_, int c_) { nM = M / BM; nN = N / BM; nwg = nM * nN; G = G_; c = c_; }
    __host__ __device__ bool next(int i, Unit& u) const {
        const long L = (long)i * G + c; if (L >= nwg) return false;
        int wgid = (int)L; { const int q = nwg / NXCD, r = nwg % NXCD, xcd = wgid % NXCD, off = wgid / NXCD; wgid = (xcd < r ? xcd * (q + 1) : r * (q + 1) + (xcd - r) * q) + off; }
        const int nig = WGM * nN, gid = wgid / nig, fm = gid * WGM, gsz = (nM - fm) < WGM ? (nM - fm) : WGM;
        u.pm = fm + ((wgid % nig) % gsz); u.pn = (wgid % nig) / gsz; u.pb = u.pn; u.e = 0; return true;
    }
    __device__ __forceinline__ void a_ready(const Unit&) const {}
    __device__ __forceinline__ void done(const Unit&) const {}
};
template <bool GATH> struct MoeOrderT {
    static constexpr bool GATHER = GATH;
    const PG8_LAS int* tab; int nN, G, c;
    __device__ bool next(int i, Unit& u) const {
        const int nblk = tab[0]; int blk, pn;
        if ((G & 7) == 0) { const int x = c & 7, j = c >> 3, uu = i * (G >> 3) + j; blk = (uu / nN) * 8 + x; pn = uu % nN; }
        else { const long L = (long)i * G + c; blk = (int)(L / nN); pn = (int)(L % nN); }
        if (blk >= nblk) return false;
        u.pm = blk; u.pn = pn; u.e = tab[32 + blk]; u.pb = u.e * nN + pn; return true;
    }
    __device__ __forceinline__ void a_ready(const Unit&) const {}
    __device__ __forceinline__ void done(const Unit&) const {}
};

struct S5Order {
    static constexpr bool GATHER = false;
    int nN, G, c;
    __device__ bool next(int i, Unit& u) const {
        constexpr int nM = S5RP / BM; const long L = (long)i * G + c; if (L >= (long)S5G * nM * nN) return false;
        u.pn = (int)(L % nN); u.pm = (int)((L / nN) % nM); u.e = (int)(L / (nN * nM)); u.pb = u.e * nN + u.pn; return true;
    }
    __device__ __forceinline__ void a_ready(const Unit&) const {}
    __device__ __forceinline__ void done(const Unit&) const {}
};
typedef int i32x4 __attribute__((ext_vector_type(4)));
template <class Epi, class Sched, bool ALIGN_EPI = false, bool SP2 = false, bool I8 = false>
__device__ __forceinline__ void gemm_phase(PG8_LAS unsigned char* lds, const Gemm g, const Sched& S, const Epi& E, int tid_in) {
    int tid = tid_in; asm volatile("" : "+v"(tid));
    const int wid = __builtin_amdgcn_readfirstlane(tid >> 6), lane = tid & 63, wr = wid >> 2, wc = wid & 3, fr = lane & 15, fq = lane >> 4;
    const int K = g.K, nt = K / BK;
    unsigned voffA[2], voffB[2];
#pragma unroll
    for (int i = 0; i < 2; ++i) { int R, C; stage_rc(tid * 16 + i * 8192, R, C); const int Rb = Epi::PERM ? ((R & ~31) + perm32(R & 31)) : R;
        voffA[i] = (unsigned)R * g.a_row + (g.a_mode ? (unsigned)(C >> 4) * g.a_sub + (unsigned)(C & 15) * 2u : (unsigned)C * 2u); voffB[i] = (unsigned)(Rb * K + C) * 2u; }
    const size_t kstep = (size_t)(BK * 2), kstepA = g.a_kstep;
    const size_t hstep = (size_t)HALF * K * 2, hstepA = (size_t)HALF * g.a_row;
    const size_t tstep = 2 * hstep, tstepA = 2 * hstepA;
    const unsigned ldsw = (unsigned)wid * 1024u;
    const int aoff = lds_byte(wr * 64 + fr, fq * 8), boff = lds_byte(wc * 32 + fr, fq * 8);
#define PG8_SA(b, h) (((b) * 2 + (h)) * HTB)
#define PG8_SB(b, h) ((4 + (b) * 2 + (h)) * HTB)
#define PG8_STAGE(bufoff, gbase, voff) do { _Pragma("unroll") for (int _i = 0; _i < 2; ++_i) \
        __builtin_amdgcn_global_load_lds((const unsigned*)((const char*)(gbase) + (voff)[_i]), (PG8_LAS unsigned*)(lds + (bufoff) + ldsw + _i * 8192), 16, 0, 0); } while (0)
#define PG8_LDA(dst, b, h) do { _Pragma("unroll") for (int m = 0; m < 4; ++m) _Pragma("unroll") for (int k = 0; k < 2; ++k) dst[m][k] = *(const PG8_LAS bf16x8*)(lds + PG8_SA(b, h) + aoff + m * 2048 + k * 1024); } while (0)
#define PG8_LDB(dst, b, h) do { _Pragma("unroll") for (int n = 0; n < 2; ++n) _Pragma("unroll") for (int k = 0; k < 2; ++k) dst[n][k] = *(const PG8_LAS bf16x8*)(lds + PG8_SB(b, h) + boff + n * 2048 + k * 1024); } while (0)
#define PG8_MMA(ai, bj, At, Bt) do { __builtin_amdgcn_s_setprio(1); _Pragma("unroll") for (int m = 0; m < 4; ++m) _Pragma("unroll") for (int n = 0; n < 2; ++n) _Pragma("unroll") for (int k = 0; k < 2; ++k) \
        { if constexpr (I8) acc[ai][bj][m][n] = __builtin_bit_cast(f32x4, __builtin_amdgcn_mfma_i32_16x16x64_i8(__builtin_bit_cast(i32x4, Bt[n][k]), __builtin_bit_cast(i32x4, At[m][k]), __builtin_bit_cast(i32x4, acc[ai][bj][m][n]), 0, 0, 0)); \
          else acc[ai][bj][m][n] = __builtin_amdgcn_mfma_f32_16x16x32_bf16(Bt[n][k], At[m][k], acc[ai][bj][m][n], 0, 0, 0); } __builtin_amdgcn_s_setprio(0); } while (0)
#define PG8_WAIT_V(n) asm volatile("s_waitcnt vmcnt(" #n ")" ::: "memory")
#define PG8_WAIT_L(n) asm volatile("s_waitcnt lgkmcnt(" #n ")" ::: "memory")
#define PG8_BAR __builtin_amdgcn_s_barrier()
#define PG8_SCHED __builtin_amdgcn_sched_barrier(0)
    Unit cur, nxt; int ui = 0;
    if (!S.next(0, cur)) return;
    f32x4 acc[2][2][4][2];
#pragma unroll
    for (int a = 0; a < 2; ++a)
#pragma unroll
        for (int b = 0; b < 2; ++b)
#pragma unroll
            for (int m = 0; m < 4; ++m)
#pragma unroll
                for (int n = 0; n < 2; ++n) acc[a][b][m][n] = (f32x4){0.f, 0.f, 0.f, 0.f};
    bf16x8 At[4][2], B0[2][2], B1[2][2];
    const char* cA = Sched::GATHER ? (const char*)g.A : (const char*)g.A + (size_t)cur.pm * tstepA + (size_t)cur.e * g.a_grp; const char* cB = (const char*)g.Bt + (size_t)cur.pb * tstep;
    int Rg[2], Cg[2]; unsigned vg0[2] = {0u, 0u}, vg1[2] = {0u, 0u}, vn0[2] = {0u, 0u}, vn1[2] = {0u, 0u};
    if constexpr (Sched::GATHER) {
#pragma unroll
        for (int i = 0; i < 2; ++i) { stage_rc(tid * 16 + i * 8192, Rg[i], Cg[i]);
            vg0[i] = (unsigned)g.a_gather[cur.pm * BM + Rg[i]] * g.a_row + (unsigned)Cg[i] * 2u; vg1[i] = (unsigned)g.a_gather[cur.pm * BM + HALF + Rg[i]] * g.a_row + (unsigned)Cg[i] * 2u; } }
#define PG8_STAGE_A(bufoff, gbase, half, nx) do { if constexpr (Sched::GATHER) { _Pragma("unroll") for (int _i = 0; _i < 2; ++_i) { const unsigned _v = (nx) ? ((half) ? vn1[_i] : vn0[_i]) : ((half) ? vg1[_i] : vg0[_i]); \
        __builtin_amdgcn_global_load_lds((const unsigned*)((const char*)(gbase) + _v), (PG8_LAS unsigned*)(lds + (bufoff) + ldsw + _i * 8192), 16, 0, 0); } } \
        else { PG8_STAGE(bufoff, (gbase) + ((half) ? hstepA : 0), voffA); } } while (0)
    S.a_ready(cur);
    if constexpr (SP2) {
        PG8_STAGE(PG8_SB(0, 0), cB, voffB); PG8_STAGE(PG8_SB(0, 1), cB + hstep, voffB); PG8_STAGE_A(PG8_SA(0, 0), cA, 0, false); PG8_STAGE_A(PG8_SA(0, 1), cA, 1, false);
        if (wr == 1) PG8_BAR;
        PG8_WAIT_V(2); PG8_BAR;
        PG8_STAGE(PG8_SB(1, 0), cB + kstep, voffB); PG8_STAGE_A(PG8_SA(1, 0), cA + kstepA, 0, false); PG8_STAGE(PG8_SB(1, 1), cB + hstep + kstep, voffB);
        PG8_WAIT_V(6); PG8_BAR;
    } else {
        PG8_STAGE(PG8_SB(0, 0), cB, voffB); PG8_STAGE_A(PG8_SA(0, 0), cA, 0, false); PG8_STAGE(PG8_SB(0, 1), cB + hstep, voffB); PG8_STAGE_A(PG8_SA(0, 1), cA, 1, false);
        if (wr == 1) PG8_BAR;
        PG8_WAIT_V(4); PG8_BAR;
        PG8_STAGE(PG8_SB(1, 0), cB + kstep, voffB); PG8_STAGE_A(PG8_SA(1, 0), cA + kstepA, 0, false); PG8_STAGE(PG8_SB(1, 1), cB + hstep + kstep, voffB);
        PG8_WAIT_V(6); PG8_BAR;
    }
    for (;;) {
        const bool has_next = S.next(ui + 1, nxt);
        const char* nA = Sched::GATHER ? (const char*)g.A : (has_next ? (const char*)g.A + (size_t)nxt.pm * tstepA + (size_t)nxt.e * g.a_grp : cA); const char* nB = has_next ? (const char*)g.Bt + (size_t)nxt.pb * tstep : cB;
        if constexpr (Sched::GATHER) { const int npm = has_next ? nxt.pm : cur.pm;
#pragma unroll
            for (int i = 0; i < 2; ++i) { vn0[i] = (unsigned)g.a_gather[npm * BM + Rg[i]] * g.a_row + (unsigned)Cg[i] * 2u; vn1[i] = (unsigned)g.a_gather[npm * BM + HALF + Rg[i]] * g.a_row + (unsigned)Cg[i] * 2u; } }
#pragma unroll 1
        for (int t = 0; t < nt; t += 2) {
            const bool last = (t == nt - 2);
            const char* a1 = cA + (size_t)(t + 1) * kstepA;
            const char* a2 = last ? nA : cA + (size_t)(t + 2) * kstepA; const char* b2 = last ? nB : cB + (size_t)(t + 2) * kstep;
            const char* a3 = a2 + kstepA; const char* b3 = b2 + kstep;
            if (last && has_next) S.a_ready(nxt);
            if constexpr (SP2) {
            PG8_LDB(B0, 0, 0); PG8_LDB(B1, 0, 1); PG8_SCHED; PG8_LDA(At, 0, 0); PG8_STAGE_A(PG8_SA(1, 1), a1, 1, false);
            PG8_WAIT_V(8); PG8_WAIT_L(0); PG8_BAR; PG8_MMA(0, 0, At, B0); PG8_MMA(0, 1, At, B1); PG8_BAR; PG8_SCHED;
            PG8_LDA(At, 0, 1); PG8_STAGE(PG8_SB(0, 0), b2, voffB); PG8_STAGE(PG8_SB(0, 1), b2 + hstep, voffB); PG8_STAGE_A(PG8_SA(0, 0), a2, 0, last);
            PG8_WAIT_V(8); PG8_WAIT_L(0); PG8_BAR; PG8_MMA(1, 0, At, B0); PG8_MMA(1, 1, At, B1); PG8_BAR; PG8_SCHED;
            PG8_LDB(B0, 1, 0); PG8_LDB(B1, 1, 1); PG8_SCHED; PG8_LDA(At, 1, 0); PG8_STAGE_A(PG8_SA(0, 1), a2, 1, last);
            PG8_WAIT_V(8); PG8_WAIT_L(0); PG8_BAR; PG8_MMA(0, 0, At, B0); PG8_MMA(0, 1, At, B1); PG8_BAR; PG8_SCHED;
            PG8_LDA(At, 1, 1); PG8_STAGE(PG8_SB(1, 0), b3, voffB); PG8_STAGE(PG8_SB(1, 1), b3 + hstep, voffB); PG8_STAGE_A(PG8_SA(1, 0), a3, 0, last);
            PG8_WAIT_V(8); PG8_WAIT_L(0); PG8_BAR; PG8_MMA(1, 0, At, B0); PG8_MMA(1, 1, At, B1); PG8_BAR; PG8_SCHED;
            } else {
            PG8_LDB(B0, 0, 0); PG8_SCHED; PG8_LDA(At, 0, 0); PG8_STAGE_A(PG8_SA(1, 1), a1, 1, false);
            PG8_WAIT_L(8); PG8_BAR; PG8_WAIT_L(0); PG8_MMA(0, 0, At, B0); PG8_BAR; PG8_SCHED;
            PG8_LDB(B1, 0, 1); PG8_STAGE(PG8_SB(0, 0), b2, voffB);
            PG8_BAR; PG8_WAIT_L(0); PG8_MMA(0, 1, At, B1); PG8_BAR;
            PG8_LDA(At, 0, 1); PG8_STAGE_A(PG8_SA(0, 0), a2, 0, last);
            PG8_BAR; PG8_WAIT_L(0); PG8_MMA(1, 0, At, B0); PG8_BAR; PG8_SCHED;
            PG8_STAGE(PG8_SB(0, 1), b2 + hstep, voffB);
            PG8_WAIT_V(6); PG8_BAR; PG8_MMA(1, 1, At, B1); PG8_BAR;
            PG8_LDB(B0, 1, 0); PG8_SCHED; PG8_LDA(At, 1, 0); PG8_STAGE_A(PG8_SA(0, 1), a2, 1, last);
            PG8_WAIT_L(8); PG8_BAR; PG8_WAIT_L(0); PG8_MMA(0, 0, At, B0); PG8_BAR; PG8_SCHED;
            PG8_LDB(B1, 1, 1); PG8_STAGE(PG8_SB(1, 0), b3, voffB);
            PG8_BAR; PG8_WAIT_L(0); PG8_MMA(0, 1, At, B1); PG8_BAR;
            PG8_LDA(At, 1, 1); PG8_STAGE_A(PG8_SA(1, 0), a3, 0, last);
            PG8_BAR; PG8_WAIT_L(0); PG8_MMA(1, 0, At, B0); PG8_BAR; PG8_SCHED;
            PG8_STAGE(PG8_SB(1, 1), b3 + hstep, voffB);
            PG8_WAIT_V(6); PG8_BAR; PG8_MMA(1, 1, At, B1); PG8_BAR;
            }
        }
        if constexpr (ALIGN_EPI) { if (wr == 0) PG8_BAR; }
        E(acc, cur, wr, wc, fr, fq); S.done(cur);
        if (!has_next) break;
#pragma unroll
        for (int a = 0; a < 2; ++a)
#pragma unroll
            for (int b = 0; b < 2; ++b)
#pragma unroll
                for (int m = 0; m < 4; ++m)
#pragma unroll
                    for (int n = 0; n < 2; ++n) acc[a][b][m][n] = (f32x4){0.f, 0.f, 0.f, 0.f};
        cur = nxt; cA = nA; cB = nB; ++ui;
        if constexpr (Sched::GATHER) {
#pragma unroll
            for (int i = 0; i < 2; ++i) { vg0[i] = vn0[i]; vg1[i] = vn1[i]; } }
        if constexpr (ALIGN_EPI) { if (wr == 1) PG8_BAR; }
    }
    PG8_WAIT_V(0);
    if constexpr (!ALIGN_EPI) { if (wr == 0) PG8_BAR; }
    PG8_BAR;
#undef PG8_SA
#undef PG8_SB
#undef PG8_STAGE
#undef PG8_STAGE_A
#undef PG8_LDA
#undef PG8_LDB
#undef PG8_MMA
#undef PG8_WAIT_V
#undef PG8_WAIT_L
#undef PG8_BAR
#undef PG8_SCHED
}

__device__ __forceinline__ float fsig(float x) { return __builtin_amdgcn_rcpf(1.0f + __builtin_amdgcn_exp2f(-1.4426950408889634f * x)); }
#define EPI_LOOP(BODY) \
    _Pragma("unroll") for (int ai = 0; ai < 2; ++ai) _Pragma("unroll") for (int m = 0; m < 4; ++m) { const int row = u.pm * BM + ai * HALF + wr * 64 + m * 16 + fr; \
    _Pragma("unroll") for (int bj = 0; bj < 2; ++bj) _Pragma("unroll") for (int n = 0; n < 2; ++n) { const int col = u.pn * BM + bj * HALF + wc * 32 + n * 16 + 4 * fq; const f32x4 a = acc[ai][bj][m][n]; BODY } \
    asm volatile("" ::: "memory"); }
#define EPI_LOOP2(BODY) \
    _Pragma("unroll") for (int ai = 0; ai < 2; ++ai) _Pragma("unroll") for (int m = 0; m < 4; ++m) { const int row = u.pm * BM + ai * HALF + wr * 64 + m * 16 + fr; \
    _Pragma("unroll") for (int bj = 0; bj < 2; ++bj) _Pragma("unroll") for (int n = 0; n < 2; ++n) { const int col = u.pn * BM + bj * HALF + wc * 32 + n * 16 + 4 * fq; const f32x4 a = acc[ai][bj][m][n]; BODY } \
    if (m & 1) asm volatile("" ::: "memory"); }
__device__ __forceinline__ v2u pack4(f32x4 v) { v2u w; w.x = f2bf_bits(v[0]) | (f2bf_bits(v[1]) << 16); w.y = f2bf_bits(v[2]) | (f2bf_bits(v[3]) << 16); return w; }
__device__ __forceinline__ f32x4 unpack4(v2u w) { f32x4 v; v[0] = __uint_as_float(w.x << 16); v[1] = __uint_as_float(w.x & 0xffff0000u); v[2] = __uint_as_float(w.y << 16); v[3] = __uint_as_float(w.y & 0xffff0000u); return v; }

struct EpiStoreBf16 {
    static constexpr bool PERM = true;
    bf16_t* O; int ldc;
    __device__ __forceinline__ void operator()(const f32x4 (&acc)[2][2][4][2], const Unit& u, int wr, int wc, int fr, int fq) const {
#pragma unroll
        for (int ai = 0; ai < 2; ++ai)
#pragma unroll
            for (int m = 0; m < 4; ++m) { const int row = u.pm * BM + ai * HALF + wr * 64 + m * 16 + fr;
#pragma unroll
                for (int bj = 0; bj < 2; ++bj) { const int col = u.pn * BM + bj * HALF + wc * 32 + 8 * fq; const v2u lo = pack4(acc[ai][bj][m][0]), hi = pack4(acc[ai][bj][m][1]);
                    *(u32x4*)(O + (size_t)row * ldc + col) = (u32x4){lo.x, lo.y, hi.x, hi.y}; }
                asm volatile("" ::: "memory"); }
    }
};
struct EpiStoreQ8 {
    static constexpr bool PERM = true;
    bf16_t* O; int ldc; const float* rs; const float* cs;
    __device__ __forceinline__ void operator()(const f32x4 (&acc)[2][2][4][2], const Unit& u, int wr, int wc, int fr, int fq) const {
        f32x4 cv[2][2];
#pragma unroll
        for (int bj = 0; bj < 2; ++bj)
#pragma unroll
            for (int n = 0; n < 2; ++n) { cv[bj][n] = *(const f32x4*)(cs + u.pn * BM + bj * HALF + wc * 32 + 8 * fq + 4 * n);
#pragma unroll
                for (int j = 0; j < 4; ++j) cv[bj][n][j] = cv[bj][n][j] > 0.f ? cv[bj][n][j] * (1.0f / 127.0f) : 1.0f; }
#pragma unroll
        for (int ai = 0; ai < 2; ++ai)
#pragma unroll
            for (int m = 0; m < 4; ++m) { const int row = u.pm * BM + ai * HALF + wr * 64 + m * 16 + fr; const float r = rs[row];
#pragma unroll
                for (int bj = 0; bj < 2; ++bj) { const int col = u.pn * BM + bj * HALF + wc * 32 + 8 * fq; f32x4 v0, v1;
                    const i32x4 a0 = __builtin_bit_cast(i32x4, acc[ai][bj][m][0]), a1 = __builtin_bit_cast(i32x4, acc[ai][bj][m][1]);
#pragma unroll
                    for (int j = 0; j < 4; ++j) { v0[j] = (float)a0[j] * r * cv[bj][0][j]; v1[j] = (float)a1[j] * r * cv[bj][1][j]; }
                    const v2u lo = pack4(v0), hi = pack4(v1); *(u32x4*)(O + (size_t)row * ldc + col) = (u32x4){lo.x, lo.y, hi.x, hi.y}; }
                asm volatile("" ::: "memory"); }
    }
};
struct EpiS5a {
    static constexpr bool PERM = false;
    float* YS; float* SL;
    __device__ __forceinline__ void operator()(const f32x4 (&acc)[2][2][4][2], const Unit& u, int wr, int wc, int fr, int fq) const {
        EPI_LOOP({ if (row < S5R) { if (col < 512) *(f32x4*)(YS + (size_t)(row * S5T + (col >> 4)) * DH + u.e * S5N + (col & 15)) = a;
                                    else *(f32x4*)(SL + ((size_t)u.e * S5RP + row) * 256 + (col - 512)) = a; } })
    }
};
struct EpiS5b {
    static constexpr bool PERM = true;
    const float* YS; bf16_t* Gd;
    __device__ __forceinline__ void operator()(const f32x4 (&acc)[2][2][4][2], const Unit& u, int wr, int wc, int fr, int fq) const {
#pragma unroll
        for (int ai = 0; ai < 2; ++ai)
#pragma unroll
            for (int m = 0; m < 4; ++m) { const int row = u.pm * BM + ai * HALF + wr * 64 + m * 16 + fr;
                if (row < S5R) {
#pragma unroll
                    for (int bj = 0; bj < 2; ++bj) { const int col = u.pn * BM + bj * HALF + wc * 32 + 8 * fq; const size_t o = (size_t)(row * S5T + (col >> 4)) * DH + u.e * S5N + (col & 15);
                        const f32x4 y0 = *(const f32x4*)(YS + o) + acc[ai][bj][m][0], y1 = *(const f32x4*)(YS + o + 4) + acc[ai][bj][m][1]; f32x4 r0, r1;
#pragma unroll
                        for (int j = 0; j < 4; ++j) { r0[j] = y0[j] * fsig(1.5957691216057308f * (y0[j] + 0.044715f * y0[j] * y0[j] * y0[j])); r1[j] = y1[j] * fsig(1.5957691216057308f * (y1[j] + 0.044715f * y1[j] * y1[j] * y1[j])); }
                        const v2u lo = pack4(r0), hi = pack4(r1); *(u32x4*)(Gd + o) = (u32x4){lo.x, lo.y, hi.x, hi.y}; } }
                if (m & 1) asm volatile("" ::: "memory"); }
    }
};
struct EpiGlu {
    static constexpr bool PERM = true;
    const bf16_t* G; bf16_t* O;
    __device__ __forceinline__ void operator()(const f32x4 (&acc)[2][2][4][2], const Unit& u, int wr, int wc, int fr, int fq) const {
#pragma unroll
        for (int ai = 0; ai < 2; ++ai)
#pragma unroll
            for (int m = 0; m < 4; ++m) { const int row = u.pm * BM + ai * HALF + wr * 64 + m * 16 + fr;
#pragma unroll
                for (int bj = 0; bj < 2; ++bj) { const int col = u.pn * BM + bj * HALF + wc * 32 + 8 * fq;
                    if (col < DH) { const u32x4 gp = *(const u32x4*)(G + (size_t)row * DH + col); const f32x4 g0 = unpack4((v2u){gp.x, gp.y}), g1 = unpack4((v2u){gp.z, gp.w}); f32x4 o0, o1;
#pragma unroll
                        for (int j = 0; j < 4; ++j) { o0[j] = g0[j] * fsig(acc[ai][bj][m][0][j]); o1[j] = g1[j] * fsig(acc[ai][bj][m][1][j]); }
                        const v2u lo = pack4(o0), hi = pack4(o1); *(u32x4*)(O + (size_t)row * DH + col) = (u32x4){lo.x, lo.y, hi.x, hi.y}; } }
                if (m & 1) asm volatile("" ::: "memory"); }
    }
};
template <int MODE> struct EpiBr {
    static constexpr bool PERM = true;
    const bf16_t* P; int gcol; float* YF; bf16_t* YB;
    __device__ __forceinline__ void operator()(const f32x4 (&acc)[2][2][4][2], const Unit& u, int wr, int wc, int fr, int fq) const {
#pragma unroll
        for (int ai = 0; ai < 2; ++ai)
#pragma unroll
            for (int m = 0; m < 4; ++m) { const int row = u.pm * BM + ai * HALF + wr * 64 + m * 16 + fr;
#pragma unroll
                for (int bj = 0; bj < 2; ++bj) { const int col = u.pn * BM + bj * HALF + wc * 32 + 8 * fq;
                    const u32x4 mgp = *(const u32x4*)(P + (size_t)row * NP + gcol + col); bf16_t* yp = YB + (size_t)row * D + col;
                    const f32x4 g0 = unpack4((v2u){mgp.x, mgp.y}), g1 = unpack4((v2u){mgp.z, mgp.w}); f32x4 v0, v1;
#pragma unroll
                    for (int j = 0; j < 4; ++j) { v0[j] = fsig(g0[j]) * acc[ai][bj][m][0][j]; v1[j] = fsig(g1[j]) * acc[ai][bj][m][1][j]; }
                    if (MODE != 0) { const u32x4 yo = *(const u32x4*)yp; v0 = v0 + unpack4((v2u){yo.x, yo.y}); v1 = v1 + unpack4((v2u){yo.z, yo.w}); }
                    const v2u lo = pack4(v0), hi = pack4(v1); *(u32x4*)yp = (u32x4){lo.x, lo.y, hi.x, hi.y}; }
                if (m & 1) asm volatile("" ::: "memory"); }
    }
};
template <bool SRC32> struct EpiOut {
    static constexpr bool PERM = true;
    bf16_t* X; const float* modl; const float* xl; const float* xc;
    __device__ __forceinline__ void operator()(const f32x4 (&acc)[2][2][4][2], const Unit& u, int wr, int wc, int fr, int fq) const {
        const int row0 = u.pm * BM, mb = row0 < NTL ? row0 / SEQ : NB; f32x4 gv[2][2];
#pragma unroll
        for (int bj = 0; bj < 2; ++bj)
#pragma unroll
            for (int n = 0; n < 2; ++n) gv[bj][n] = *(const f32x4*)(modl + (size_t)mb * 6144 + 2 * D + u.pn * BM + bj * HALF + wc * 32 + 8 * fq + 4 * n);
#pragma unroll
        for (int ai = 0; ai < 2; ++ai)
#pragma unroll
            for (int m = 0; m < 4; ++m) { const int row = u.pm * BM + ai * HALF + wr * 64 + m * 16 + fr;
#pragma unroll
                for (int bj = 0; bj < 2; ++bj) { const int col = u.pn * BM + bj * HALF + wc * 32 + 8 * fq; f32x4 s0, s1;
                    if (SRC32) { const float* sp = (row < NTL ? xl + (size_t)row * D : xc + (size_t)(row - NTL) * D) + col; s0 = *(const f32x4*)sp; s1 = *(const f32x4*)(sp + 4); }
                    else { const u32x4 xo = *(const u32x4*)(X + (size_t)row * D + col); s0 = unpack4((v2u){xo.x, xo.y}); s1 = unpack4((v2u){xo.z, xo.w}); }
                    const v2u lo = pack4(s0 + gv[bj][0] * acc[ai][bj][m][0]), hi = pack4(s1 + gv[bj][1] * acc[ai][bj][m][1]);
                    *(u32x4*)(X + (size_t)row * D + col) = (u32x4){lo.x, lo.y, hi.x, hi.y}; }
                if (m & 1) asm volatile("" ::: "memory"); }
    }
};
struct EpiMoe1 {
    static constexpr bool PERM = false;
    bf16_t* ACT; const float* b1;
    __device__ __forceinline__ void operator()(const f32x4 (&acc)[2][2][4][2], const Unit& u, int wr, int wc, int fr, int fq) const {
        const int a0 = 128 * u.pn + 32 * wc + 8 * fq; const float* bb = b1 + (size_t)u.e * 1024 + 2 * a0; f32x4 bg[2], bl[2];
#pragma unroll
        for (int bj = 0; bj < 2; ++bj) { const f32x4 p0 = *(const f32x4*)(bb + 8 * bj), p1 = *(const f32x4*)(bb + 8 * bj + 4); bg[bj] = (f32x4){p0[0], p0[2], p1[0], p1[2]}; bl[bj] = (f32x4){p0[1], p0[3], p1[1], p1[3]}; }
#pragma unroll
        for (int ai = 0; ai < 2; ++ai)
#pragma unroll
            for (int m = 0; m < 4; ++m) { const int row = u.pm * BM + ai * HALF + wr * 64 + m * 16 + fr; v2u pk[2];
#pragma unroll
                for (int bj = 0; bj < 2; ++bj) { const f32x4 g = acc[ai][bj][m][0] + bg[bj], li = acc[ai][bj][m][1] + bl[bj]; f32x4 o;
#pragma unroll
                    for (int j = 0; j < 4; ++j) { const float xg = fminf(g[j], 7.0f); const float xl = fminf(fmaxf(li[j], -7.0f), 7.0f); o[j] = xg * fsig(1.702f * xg) * (xl + 1.0f); }
                    pk[bj] = pack4(o); }
                *(u32x4*)(ACT + (size_t)row * FF + a0) = (u32x4){pk[0].x, pk[0].y, pk[1].x, pk[1].y};
                asm volatile("" ::: "memory"); }
    }
};
struct EpiMoe1Q8 {
    static constexpr bool PERM = false;
    bf16_t* ACT; const float* b1; const float* rs; const float* cs;
    __device__ __forceinline__ void operator()(const f32x4 (&acc)[2][2][4][2], const Unit& u, int wr, int wc, int fr, int fq) const {
        const int a0 = 128 * u.pn + 32 * wc + 8 * fq; const float* bb = b1 + (size_t)u.e * 1024 + 2 * a0; const float* sb = cs + (size_t)u.e * 1024 + 2 * a0; f32x4 bg[2], bl[2], sg[2], sl[2];
#pragma unroll
        for (int bj = 0; bj < 2; ++bj) { const f32x4 p0 = *(const f32x4*)(bb + 8 * bj), p1 = *(const f32x4*)(bb + 8 * bj + 4); bg[bj] = (f32x4){p0[0], p0[2], p1[0], p1[2]}; bl[bj] = (f32x4){p0[1], p0[3], p1[1], p1[3]};
            const f32x4 q0 = *(const f32x4*)(sb + 8 * bj), q1 = *(const f32x4*)(sb + 8 * bj + 4); sg[bj] = (f32x4){q0[0], q0[2], q1[0], q1[2]}; sl[bj] = (f32x4){q0[1], q0[3], q1[1], q1[3]};
#pragma unroll
            for (int j = 0; j < 4; ++j) { sg[bj][j] = sg[bj][j] > 0.f ? sg[bj][j] * (1.0f / 127.0f) : 1.0f; sl[bj][j] = sl[bj][j] > 0.f ? sl[bj][j] * (1.0f / 127.0f) : 1.0f; } }
#pragma unroll
        for (int ai = 0; ai < 2; ++ai)
#pragma unroll
            for (int m = 0; m < 4; ++m) { const int row = u.pm * BM + ai * HALF + wr * 64 + m * 16 + fr; const float r = rs[row]; v2u pk[2];
#pragma unroll
                for (int bj = 0; bj < 2; ++bj) { const i32x4 ig = __builtin_bit_cast(i32x4, acc[ai][bj][m][0]), il = __builtin_bit_cast(i32x4, acc[ai][bj][m][1]); f32x4 o;
#pragma unroll
                    for (int j = 0; j < 4; ++j) { const float g = (float)ig[j] * r * sg[bj][j] + bg[bj][j], li = (float)il[j] * r * sl[bj][j] + bl[bj][j];
                        const float xg = fminf(g, 7.0f); const float xl = fminf(fmaxf(li, -7.0f), 7.0f); o[j] = xg * fsig(1.702f * xg) * (xl + 1.0f); }
                    pk[bj] = pack4(o); }
                *(u32x4*)(ACT + (size_t)row * FF + a0) = (u32x4){pk[0].x, pk[0].y, pk[1].x, pk[1].y};
                asm volatile("" ::: "memory"); }
    }
};
struct EpiMoe2 {
    static constexpr bool PERM = true;
    unsigned char* O; float* SC; const float* b2;
    __device__ __forceinline__ void operator()(const f32x4 (&acc)[2][2][4][2], const Unit& u, int wr, int wc, int fr, int fq) const {
        f32x4 bv[2][2];
#pragma unroll
        for (int bj = 0; bj < 2; ++bj)
#pragma unroll
            for (int n = 0; n < 2; ++n) bv[bj][n] = *(const f32x4*)(b2 + (size_t)u.e * D + u.pn * BM + bj * HALF + wc * 32 + 8 * fq + 4 * n);
#pragma unroll
        for (int ai = 0; ai < 2; ++ai)
#pragma unroll
            for (int m = 0; m < 4; ++m) { const int row = u.pm * BM + ai * HALF + wr * 64 + m * 16 + fr;
#pragma unroll
                for (int bj = 0; bj < 2; ++bj) { const int col = u.pn * BM + bj * HALF + wc * 32 + 8 * fq;
                    const f32x4 a = acc[ai][bj][m][0] + bv[bj][0], b = acc[ai][bj][m][1] + bv[bj][1];
                    float mx = fmaxf(fmaxf(fmaxf(fabsf(a[0]), fabsf(a[1])), fmaxf(fabsf(a[2]), fabsf(a[3]))), fmaxf(fmaxf(fabsf(b[0]), fabsf(b[1])), fmaxf(fabsf(b[2]), fabsf(b[3]))));
                    mx = fmaxf(mx, __shfl_xor(mx, 16)); mx = fmaxf(mx, __shfl_xor(mx, 32));
                    const float inv = mx > 0.f ? 127.0f / mx : 0.f; const float MG = 12582912.0f + 128.0f;
                    const unsigned q0 = __float_as_uint(fmaf(a[0], inv, MG)), q1 = __float_as_uint(fmaf(a[1], inv, MG)), q2 = __float_as_uint(fmaf(a[2], inv, MG)), q3 = __float_as_uint(fmaf(a[3], inv, MG));
                    const unsigned q4 = __float_as_uint(fmaf(b[0], inv, MG)), q5 = __float_as_uint(fmaf(b[1], inv, MG)), q6 = __float_as_uint(fmaf(b[2], inv, MG)), q7 = __float_as_uint(fmaf(b[3], inv, MG));
                    const unsigned w0 = __builtin_amdgcn_perm(__builtin_amdgcn_perm(q3, q2, 0x0c0c0400u), __builtin_amdgcn_perm(q1, q0, 0x0c0c0400u), 0x05040100u);
                    const unsigned w1 = __builtin_amdgcn_perm(__builtin_amdgcn_perm(q7, q6, 0x0c0c0400u), __builtin_amdgcn_perm(q5, q4, 0x0c0c0400u), 0x05040100u);
                    *(v2u*)(O + (size_t)row * D + col) = (v2u){w0, w1};
                    if (fq == 0) SC[(size_t)row * 32 + (col >> 5)] = mx * (1.0f / 127.0f); }
                asm volatile("" ::: "memory"); }
    }
};
}

#define XB_TMO      128
#define XB_XCNT(j)  (256  + 64 * (j))
#define XB_XSUB(j)  (1280 + 64 * (j))
#define XB_XGEN(j)  (2304 + 64 * (j))
#define XB_TOP      3328
#define XB_TOPGEN   3392
#define XCD_BAR_WORDS 3456
#define XB_SPIN_CAP (1u << 18)
__device__ __forceinline__ unsigned xb_ld(unsigned* p)              { return __hip_atomic_load(p, __ATOMIC_RELAXED, __HIP_MEMORY_SCOPE_AGENT); }
__device__ __forceinline__ unsigned xb_add(unsigned* p, unsigned v) { return __hip_atomic_fetch_add(p, v, __ATOMIC_RELAXED, __HIP_MEMORY_SCOPE_AGENT); }
__device__ __forceinline__ unsigned xb_xcc_id() { return (unsigned)__builtin_amdgcn_s_getreg((3 << 11) | 20) & 0xFu; }
#define XB_SPIN(cond, bar) do { unsigned _sp = 0; while (cond) { __builtin_amdgcn_s_sleep(1); \
    if ((++_sp & 255u) == 0u) { if (xb_ld(&(bar)[XB_TMO])) break; if (_sp > XB_SPIN_CAP) { atomicAdd(&(bar)[XB_TMO], 1u); break; } } } } while (0)
struct XcdBarrier { unsigned* bar; unsigned x; volatile LAS unsigned* st; };
__device__ __forceinline__ XcdBarrier xcd_barrier_post(unsigned* bar, volatile LAS unsigned* st) {
    XcdBarrier b; b.bar = bar; b.x = xb_xcc_id(); b.st = st;
    if (threadIdx.x == 0) (void)xb_add(&bar[XB_XCNT(b.x)], 1u);
    return b;
}
__device__ __forceinline__ void xcd_barrier_complete(unsigned* bar, unsigned x, unsigned& nloc, unsigned& nx) {
    const unsigned G = gridDim.x * gridDim.y * gridDim.z;
    unsigned sum, cnt, mine, sp = 0u;
    for (;;) {
        sum = 0u; cnt = 0u; mine = 0u;
#pragma unroll
        for (unsigned j = 0; j < 16; ++j) { const unsigned c = xb_ld(&bar[XB_XCNT(j)]); sum += c; cnt += (c > 0u) ? 1u : 0u; mine = (j == x) ? c : mine; }
        if (sum == G) break;
        __builtin_amdgcn_s_sleep(1);
        if ((++sp & 255u) == 0u) { if (xb_ld(&bar[XB_TMO])) break; if (sp > XB_SPIN_CAP) { atomicAdd(&bar[XB_TMO], 1u); break; } }
    }
    nloc = mine > 0u ? mine : 1u; nx = cnt > 0u ? cnt : 1u;
}
__device__ __forceinline__ void xcd_barrier(const XcdBarrier& b, int tid_) {
    asm volatile("s_waitcnt vmcnt(0)" ::: "memory");
    __syncthreads();
    if (tid_ == 0) {
        unsigned* bar = b.bar;
        __builtin_amdgcn_s_waitcnt(0);
        unsigned nloc = b.st[0], nx = b.st[1];
        if (nloc == 0u) { xcd_barrier_complete(bar, b.x, nloc, nx); b.st[0] = nloc; b.st[1] = nx; }
        const unsigned old = xb_add(&bar[XB_XSUB(b.x)], 1u);
        const unsigned gen = old / nloc;
        if (old + 1u == (gen + 1u) * nloc) {
            __builtin_amdgcn_fence(__ATOMIC_RELEASE, "agent");
            asm volatile("s_waitcnt vmcnt(0)" ::: "memory");
            const unsigned og = xb_add(&bar[XB_TOP], 1u);
            const unsigned tg = og / nx;
            if (og + 1u == (tg + 1u) * nx) xb_add(&bar[XB_TOPGEN], 1u);
            else XB_SPIN(xb_ld(&bar[XB_TOPGEN]) == tg, bar);
            __builtin_amdgcn_fence(__ATOMIC_ACQUIRE, "agent");
            xb_add(&bar[XB_XGEN(b.x)], 1u);
            asm volatile("s_waitcnt vmcnt(0)" ::: "memory");
        } else {
            XB_SPIN(xb_ld(&bar[XB_XGEN(b.x)]) == gen, bar);
            __builtin_amdgcn_fence(__ATOMIC_ACQUIRE, "agent");
            asm volatile("s_waitcnt vmcnt(0)" ::: "memory");
        }
    }
    __syncthreads();
}

__device__ __forceinline__ void split_arrive(unsigned* w, int tid_) {
    asm volatile("s_waitcnt vmcnt(0)" ::: "memory");
    __syncthreads();
    if (tid_ == 0) { __builtin_amdgcn_fence(__ATOMIC_RELEASE, "agent"); asm volatile("s_waitcnt vmcnt(0)" ::: "memory"); (void)xb_add(w, 1u); }
}
__device__ __forceinline__ void split_wait(unsigned* w, unsigned target, int tid_) {
    if (tid_ == 0) { unsigned sp = 0u; while (xb_ld(w) < target) { __builtin_amdgcn_s_sleep(1); if (++sp > XB_SPIN_CAP * 16u) break; }
        __builtin_amdgcn_fence(__ATOMIC_ACQUIRE, "agent"); asm volatile("s_waitcnt vmcnt(0)" ::: "memory"); }
    __syncthreads();
}

template <int CM> __device__ __forceinline__ void wconv_item(const float* W, int K, int Nsrc, int N, bf16* WT, LAS float* scr, int item, int lane, int nvalid) {
    const int nblk = N / 32, kb = item / nblk, nb = item % nblk, k0 = 64 * kb, n0 = 32 * nb;
    const int nn = n0 + (lane & 31);
    const int sc = CM == 1 ? win_src_col(nn) : (CM == 2 ? w1_src_col(nn) : (CM == 3 ? (nn < nvalid ? nn : -1) : nn));
    float ld[32];
#pragma unroll
    for (int i = 0; i < 32; ++i) { const int kk = 2 * i + (lane >> 5); ld[i] = sc >= 0 ? W[(size_t)(k0 + kk) * Nsrc + sc] : 0.f; }
#pragma unroll
    for (int i = 0; i < 32; ++i) { const int kk = 2 * i + (lane >> 5); scr[kk * 33 + (lane & 31)] = ld[i]; }
    LDS_WAIT(); asm volatile("" ::: "memory");
    const int cch = lane & 7;
#pragma unroll
    for (int j = 0; j < 4; ++j) { const int n = (lane >> 3) + 8 * j; const LAS float* s = scr + (8 * cch) * 33 + n;
        v4u o; o.x = f2bf_bits(s[0 * 33]) | (f2bf_bits(s[1 * 33]) << 16); o.y = f2bf_bits(s[2 * 33]) | (f2bf_bits(s[3 * 33]) << 16);
        o.z = f2bf_bits(s[4 * 33]) | (f2bf_bits(s[5 * 33]) << 16); o.w = f2bf_bits(s[6 * 33]) | (f2bf_bits(s[7 * 33]) << 16);
        *(v4u*)(WT + (size_t)(n0 + n) * K + k0 + 8 * cch) = o; }
    LDS_WAIT(); asm volatile("" ::: "memory");
}
template <int CM  > __device__ __forceinline__ void wconv_item_q8(const float* W, int K, int Nsrc, int N, signed char* WQ, const float* colscale, LAS float* scr, int item, int lane) {
    const int nblk = N / 32, kb = item / nblk, nb = item % nblk, k0 = 64 * kb, n0 = 32 * nb;
    const int sc = CM == 1 ? win_src_col(n0 + (lane & 31)) : w1_src_col(n0 + (lane & 31));
    float ld[32];
#pragma unroll
    for (int i = 0; i < 32; ++i) { const int kk = 2 * i + (lane >> 5); ld[i] = sc >= 0 ? W[(size_t)(k0 + kk) * Nsrc + sc] : 0.f; }
#pragma unroll
    for (int i = 0; i < 32; ++i) { const int kk = 2 * i + (lane >> 5); scr[kk * 33 + (lane & 31)] = ld[i]; }
    LDS_WAIT(); asm volatile("" ::: "memory");
#pragma unroll
    for (int j = 0; j < 2; ++j) { const int idx = lane + 64 * j, n = idx >> 2, cch = idx & 3; const float cs_ = colscale[CM == 1 ? n0 + n : w1_src_col(n0 + n)]; const float inv = cs_ > 0.f ? 127.0f / cs_ : 1.0f;     const LAS float* sp = scr + (16 * cch) * 33 + n; unsigned o[4];
#pragma unroll
        for (int w4 = 0; w4 < 4; ++w4) { unsigned pk = 0u;
#pragma unroll
            for (int e = 0; e < 4; ++e) { const int q = (int)__builtin_rintf(fminf(fmaxf(sp[(4 * w4 + e) * 33] * inv, -127.f), 127.f)); pk |= ((unsigned)q & 0xffu) << (8 * e); }
            o[w4] = pk; }
        *(v4u*)(WQ + (size_t)(n0 + n) * K + k0 + 16 * cch) = (v4u){o[0], o[1], o[2], o[3]}; }
    LDS_WAIT(); asm volatile("" ::: "memory");
}
template <int CM> __device__ __forceinline__ void wconv_mat(const float* W, int K, int Nsrc, int N, bf16* WT, LAS float* scr, int gw, int ngw, int lane, int nvalid = 0) {
    const int nit = (K / 64) * (N / 32);
    for (int it = gw; it < nit; it += ngw) wconv_item<CM>(W, K, Nsrc, N, WT, scr, it, lane, nvalid);
}

constexpr int NTHR_ = 512;

__device__ __forceinline__ void rk_build(const Ctx& c, LAS unsigned char* lds, int tid, int G, int bid) {
    const int lane = tid & 63, wave = __builtin_amdgcn_readfirstlane(tid >> 6); LAS float* T = (LAS float*)(lds + wave * 8704);
    const float* HF = wsp<float>(c, WS_HF); float* NP_ = wsp<float>(c, WS_NRMP);
    constexpr int NTB = RKT_LAT + RKT_CTX, NTILE = DEPTH * 2 * 2 * 12 * NTB;
    for (int tile = bid * 8 + wave; tile < NTILE; tile += G * 8) { int q = tile; const int tb = q % NTB; q /= NTB; const int cg = q % 12; q /= 12; const int dir = q % 2; q /= 2; const int o = q % 2, l = q / 2;
        const int ls = tb < RKT_LAT ? 0 : 1, tblk = ls ? tb - RKT_LAT : tb, L = ls ? CTXL : SEQ, pb = ls ? SEQ : 0, RKP = ls ? RKP1 : RKP0, t0 = tblk * 64;
        const float* src = HF + ((size_t)l * NPOS + pb + t0) * 1536 + o * 768 + dir * DH + cg * 32;
        { float ld[32];
#pragma unroll
          for (int i = 0; i < 32; ++i) ld[i] = src[(size_t)(2 * i + (lane >> 5)) * 1536 + (lane & 31)];
#pragma unroll
          for (int i = 0; i < 32; ++i) T[(2 * i + (lane >> 5)) * 33 + (lane & 31)] = ld[i]; }
        LDS_WAIT(); asm volatile("" ::: "memory");
        bf16* RK = wsp<bf16>(c, ls ? WS_RK1 : WS_RK0);
        float asum = 0.f;
        if (lane < 32) { for (int tt = 0; tt < 64; ++tt) { const float v = fabsf(T[tt * 33 + lane]); if (!(dir == 1 && t0 + tt == 0)) asum += v; }
            NP_[(((((size_t)l * 2 + ls) * 2 + o) * DH + cg * 32 + lane) * 64) + dir * 32 + tblk] = asum; }
        for (int cc = 0; cc < 32; ++cc) { bf16* row = RK + ((((size_t)l * 2 + o) * DH + cg * 32 + cc) * 2) * RKP;
            const int t = t0 + lane; const float v = T[lane * 33 + cc];
            if (!(dir == 1 && t == 0)) { const int n = dir ? L - 1 + t : L - 1 - t; const bf16 hv = f2bf(v); row[n] = hv; if (n >= 1) row[RKP + n - 1] = hv; } }
        LDS_WAIT(); asm volatile("" ::: "memory"); }
    for (int ls = 0; ls < 2; ++ls) { const int L = ls ? CTXL : SEQ, RKP = ls ? RKP1 : RKP0, ntail = RKP - (2 * L - 2); bf16* RK = wsp<bf16>(c, ls ? WS_RK1 : WS_RK0);
        for (long it = (long)bid * NTHR_ + tid; it < (long)DEPTH * 2 * DH * 2 * ntail; it += (long)G * NTHR_) { const int i = (int)(it % ntail); const long rowi = it / ntail; const int par = (int)(rowi % 2);
            const int idx = 2 * L - 1 - par + i; if (idx < RKP) RK[rowi * RKP + idx] = 0; } }
}
__device__ __forceinline__ void s5gen1_fast(const Ctx& c, int tid, int G, int bid) {
    const float* TAB = wsp<float>(c, WS_S5TAB); float* KD = wsp<float>(c, WS_KD);
    for (int it = bid * 512 + tid; it < DEPTH * S5G * 2 * 256 * 8; it += G * 512) { const int pp = it & 7, r = it >> 3; const int m = r % 16, n = (r / 16) % 16, d = (r / 256) % 2, g = (r / 512) % S5G, l = r / (512 * S5G);
        float acc[S5T];
#pragma unroll
        for (int j = 0; j < S5T; ++j) acc[j] = 0.f;
        { const int p0 = pp * 8; float t0[8], t1[8], t2[8], t3[8], brv[8], biv[8], crv[8], civ[8];
#pragma unroll
            for (int u = 0; u < 8; ++u) { const int p = p0 + u; const float* tb = TAB + ((((size_t)l * 2 + d) * S5G + g) * S5P + p) * 4; t0[u] = tb[0]; t1[u] = tb[1]; t2[u] = tb[2]; t3[u] = tb[3];
                const size_t bi = (((size_t)l * S5G + g) * S5P + p) * S5N + m, ci = (((size_t)l * S5G + g) * S5N + n) * S5P + p;
                brv[u] = c.in[I_BRE][bi]; biv[u] = c.in[I_BIM][bi]; crv[u] = c.in[I_CRE][ci]; civ[u] = c.in[I_CIM][ci]; }
#pragma unroll
            for (int u = 0; u < 8; ++u) { const float bbr = t2[u] * brv[u] - t3[u] * biv[u], bbi = t2[u] * biv[u] + t3[u] * brv[u];
                float zr = crv[u] * bbr - civ[u] * bbi, zi = crv[u] * bbi + civ[u] * bbr;
                const float mg = expf(t0[u]), lbr = mg * cosf(t1[u]), lbi = mg * sinf(t1[u]);
#pragma unroll
                for (int j = 0; j < S5T; ++j) { acc[j] += zr; const float t = zr * lbr - zi * lbi; zi = zr * lbi + zi * lbr; zr = t; } } }
#pragma unroll
        for (int j = 0; j < S5T; ++j) { acc[j] += __shfl_xor(acc[j], 1); acc[j] += __shfl_xor(acc[j], 2); acc[j] += __shfl_xor(acc[j], 4); }
#pragma unroll
        for (int j = 0; j < S5T; ++j) if ((j & 7) == pp) KD[((((size_t)l * S5G + g) * 2 + d) * S5T + j) * 256 + n * 16 + m] = acc[j]; }
}
__device__ __forceinline__ void modp_fast(const Ctx& c, LAS unsigned char* lds, int tid, int G, int bid) {
    const float* SL = wsp<float>(c, WS_SILU); float* MP = wsp<float>(c, WS_MODP); LAS float* S = (LAS float*)lds;
    constexpr int NKS = 16, KS = D / NKS;
    static_assert((DEPTH * 6144) % 512 == 0, "a workgroup's items share the k slice");
    for (int it0 = bid * 512; it0 < NKS * DEPTH * 6144; it0 += G * 512) { const int it = it0 + tid, ks = it0 / (DEPTH * 6144);
        __syncthreads();
        for (int i = tid; i < NMOD * KS; i += 512) { const int m = i / KS, k = i % KS; S[k * NMOD + m] = SL[m * D + ks * KS + k]; }
        __syncthreads();
        const int col = it % 6144, l = (it / 6144) % DEPTH;
        const float* w = c.in[I_ADAW] + ((size_t)l * D + ks * KS) * 6144 + col;
        float acc[NMOD];
#pragma unroll
        for (int m = 0; m < NMOD; ++m) acc[m] = 0.f;
        for (int k0 = 0; k0 < KS; k0 += 32) { float wv[32];
#pragma unroll
            for (int u = 0; u < 32; ++u) wv[u] = w[(size_t)(k0 + u) * 6144];
#pragma unroll
            for (int u = 0; u < 32; ++u)
#pragma unroll
                for (int m = 0; m < NMOD; ++m) acc[m] += S[(k0 + u) * NMOD + m] * wv[u]; }
#pragma unroll
        for (int m = 0; m < NMOD; ++m) MP[(((size_t)ks * DEPTH + l) * NMOD + m) * 6144 + col] = acc[m]; }
    __syncthreads();
}
__device__ __forceinline__ void wmax_part(const Ctx& c, int bid, int G, int tid) {
    unsigned* MX = wsp<unsigned>(c, WS_CTL) + CW_WMX;
    for (int it = bid * 512 + tid; it < DEPTH * 16 * NP; it += G * 512) { const int n = it % NP, kp = (it / NP) % 16, l = it / (16 * NP), sc = win_src_col(n);
        if (sc < 0) continue;
        const float* w = c.in[I_WIN] + (size_t)l * D * NIN + (size_t)(kp * 64) * NIN + sc; float mx = 0.f;
        for (int k0 = 0; k0 < 64; k0 += 16) { float v[16];
#pragma unroll
            for (int u = 0; u < 16; ++u) v[u] = w[(size_t)(k0 + u) * NIN];
#pragma unroll
            for (int u = 0; u < 16; ++u) mx = fmaxf(mx, fabsf(v[u])); }
        atomicMax(MX + l * NP + n, __float_as_uint(mx)); }
}
__device__ __forceinline__ void w1max_part(const Ctx& c, int l, int e0, int rank, int nidle, int tid) {
    unsigned* MX = wsp<unsigned>(c, WS_CTL) + CW_W1MX + ((size_t)l * NE + e0) * 1024; const float* W = c.in[I_W1] + ((size_t)l * NE + e0) * D * 1024;
    for (int it = rank * 512 + tid; it < 16 * 1024 * 16; it += nidle * 512) { const int col = it & 16383, kp = it >> 14, e = col >> 10, n = col & 1023;
        const float* w = W + (size_t)e * D * 1024 + (size_t)(kp * 64) * 1024 + n; float mx = 0.f;
        for (int k0 = 0; k0 < 64; k0 += 16) { float v[16];
#pragma unroll
            for (int u = 0; u < 16; ++u) v[u] = w[(size_t)(k0 + u) * 1024];
#pragma unroll
            for (int u = 0; u < 16; ++u) mx = fmaxf(mx, fabsf(v[u])); }
        atomicMax(MX + col, __float_as_uint(mx)); }
}
__device__ __forceinline__ void w1max_tail(const Ctx& c, int l, int e0, LAS unsigned char* lds, int tid, int G, int bid) {
    const int nblk = ((const LAS int*)(lds + 132096))[0]; int rank = bid, nidle = G; bool part = true;
    if (G == 256) { const int x = bid & 7, j = bid >> 3; nidle = 0; rank = 0;
        for (int xx = 0; xx < 8; ++xx) { const int nbx = (nblk - xx + 7) >> 3, rem = (nbx * 4) & 31, idl = 32 - rem; if (xx < x) rank += idl; if (xx == x) { part = j >= rem; rank += j - rem; } nidle += idl; } }
    if (part) w1max_part(c, l, e0, rank, nidle, tid);
}
__device__ __forceinline__ void moe_wconv(const Ctx& c, int l, LAS float* scr, int lo, int hi, int gw, int ngw, int lane) {
    constexpr int I1 = (D / 64) * (1024 / 32), I2 = (FF / 64) * (D / 32);
    for (int it = lo + gw; it < hi; it += ngw) { const int e = it / (I1 + I2), r = it % (I1 + I2);
        if (r < I1) wconv_item_q8<2>(c.in[I_W1] + ((size_t)l * NE + e) * D * 1024, D, 1024, 1024, wsp<signed char>(c, WS_W1T) + (size_t)e * 1024 * D, wsp<float>(c, WS_CTL) + CW_W1MX + ((size_t)l * NE + e) * 1024, scr, r, lane);
        else wconv_item<0>(c.in[I_W2] + ((size_t)l * NE + e) * FF * D, FF, D, D, wsp<bf16>(c, WS_W2T) + (size_t)e * D * FF, scr, r - I1, lane, 0); }
}
constexpr int MOE_WITEMS = NE * ((D / 64) * (1024 / 32) + (FF / 64) * (D / 32)), MOE_WS0 = 2304, MOE_WS1 = MOE_WS0 + 10240, MOE_WS2 = MOE_WS1 + 5120, MOE_WS3 = MOE_WS2 + 6912;

typedef short bf16x8_t __attribute__((ext_vector_type(8)));
typedef float f32x4_t __attribute__((ext_vector_type(4)));
typedef unsigned v4u_a4 __attribute__((ext_vector_type(4), aligned(4)));
__device__ __forceinline__ void hyf2_mfma(const Ctx& c, int tid, int G, int bid) {
    const int lane = tid & 63, wave = tid >> 6, m = lane & 15, q = lane >> 4;
    const float* HD2 = wsp<float>(c, WS_HD2); float* HF = wsp<float>(c, WS_HF);
    static_assert(NPOS % (16 * 16) == 0 && SEQ % 16 == 0, "position tiles");
    constexpr int NJT = 1536 / 16, NPT = NPOS / 16, PP = 16, TPI = NPT / PP;
    for (int it = bid * 8 + wave; it < DEPTH * NJT * PP; it += G * 8) { const int part = it % PP, jt = (it / PP) % NJT, l = it / (PP * NJT); const int j = 16 * jt + m;
        bf16x8_t Bh[2], Bl[2];
#pragma unroll
        for (int ks = 0; ks < 2; ++ks) { float w[8]; unsigned hb[8], lb[8];
#pragma unroll
            for (int e = 0; e < 8; ++e) w[e] = c.in[I_HW3][(size_t)l * 64 * 1536 + (size_t)(32 * ks + 8 * q + e) * 1536 + j];
#pragma unroll
            for (int e = 0; e < 8; ++e) { hb[e] = f2bf_bits(w[e]); lb[e] = f2bf_bits(w[e] - __uint_as_float(hb[e] << 16)); }
            Bh[ks] = __builtin_bit_cast(bf16x8_t, (v4u){hb[0] | (hb[1] << 16), hb[2] | (hb[3] << 16), hb[4] | (hb[5] << 16), hb[6] | (hb[7] << 16)});
            Bl[ks] = __builtin_bit_cast(bf16x8_t, (v4u){lb[0] | (lb[1] << 16), lb[2] | (lb[3] << 16), lb[4] | (lb[5] << 16), lb[6] | (lb[7] << 16)}); }
        const float b3 = c.in[I_HB3][l * 1536 + j]; const int ch = j % DH;
        const float dmin = -3.0701134573253940f, dmax = -15.350567286626973f;
        const float delta = fabsf(dmin + (float)ch * ((dmax - dmin) / 383.0f));
#pragma unroll 3
        for (int pt = part * TPI; pt < (part + 1) * TPI; ++pt) { const int pos0 = 16 * pt; const float* h = HD2 + ((size_t)l * NPOS + pos0 + m) * 64 + 8 * q;
            f32x4_t acc = (f32x4_t){0.f, 0.f, 0.f, 0.f};
#pragma unroll
            for (int ks = 0; ks < 2; ++ks) { const f32x4_t a0 = *(const f32x4_t*)(h + 32 * ks), a1 = *(const f32x4_t*)(h + 32 * ks + 4); const float av[8] = {a0[0], a0[1], a0[2], a0[3], a1[0], a1[1], a1[2], a1[3]}; unsigned hb[8], lb[8];
#pragma unroll
                for (int e = 0; e < 8; ++e) { hb[e] = f2bf_bits(av[e]); lb[e] = f2bf_bits(av[e] - __uint_as_float(hb[e] << 16)); }
                const bf16x8_t Ah = __builtin_bit_cast(bf16x8_t, (v4u){hb[0] | (hb[1] << 16), hb[2] | (hb[3] << 16), hb[4] | (hb[5] << 16), hb[6] | (hb[7] << 16)});
                const bf16x8_t Al = __builtin_bit_cast(bf16x8_t, (v4u){lb[0] | (lb[1] << 16), lb[2] | (lb[3] << 16), lb[4] | (lb[5] << 16), lb[6] | (lb[7] << 16)});
                acc = __builtin_amdgcn_mfma_f32_16x16x32_bf16(Ah, Bh[ks], acc, 0, 0, 0); acc = __builtin_amdgcn_mfma_f32_16x16x32_bf16(Al, Bh[ks], acc, 0, 0, 0); acc = __builtin_amdgcn_mfma_f32_16x16x32_bf16(Ah, Bl[ks], acc, 0, 0, 0); }
            const int L = pos0 < SEQ ? SEQ : CTXL, t0 = (pos0 < SEQ ? pos0 : pos0 - SEQ) + 4 * q;
#pragma unroll
            for (int jj = 0; jj < 4; ++jj) HF[((size_t)l * NPOS + pos0 + 4 * q + jj) * 1536 + j] = (acc[jj] + b3) * expf(-((float)(t0 + jj) / (float)(L - 1)) * delta); } }
}
constexpr int HP_PITCH = 772;
__device__ __forceinline__ void chan_pos(int r0, int& b, int& pos) { if (r0 < NTL) { b = r0 / SEQ; pos = r0 % SEQ; } else { const int q = r0 - NTL; b = q / CTXL; pos = SEQ + q % CTXL; } }
__device__ __forceinline__ void hy_prep(const Ctx& c, int l, LAS unsigned char* lds, int tid, int G, int bid) {
    const bf16* P = wsp<bf16>(c, WS_P); const int lane = tid & 63, wave = __builtin_amdgcn_readfirstlane(tid >> 6);
    for (int unit = bid; unit < (NT / 128) * 3; unit += G) { const int tile = unit / 3, part = unit % 3, r0 = tile * 128;
        { v4u sv[13];
#pragma unroll
          for (int k = 0; k < 13; ++k) { const int i = tid + k * NTHR_, rr = i / 48, ch = i % 48, r = r0 - 1 + rr; sv[k] = (v4u){0u, 0u, 0u, 0u};
              if (i < 130 * 48 && r >= 0 && r < NT) sv[k] = *(const v4u*)(P + (size_t)r * NP + PC_HY + part * DH + ch * 8); }
#pragma unroll
          for (int k = 0; k < 13; ++k) { const int i = tid + k * NTHR_, rr = i / 48, ch = i % 48;
              if (i < 130 * 48) { LAS unsigned* d = (LAS unsigned*)(lds + rr * HP_PITCH + ch * 16); d[0] = sv[k].x; d[1] = sv[k].y; d[2] = sv[k].z; d[3] = sv[k].w; } } }
        __syncthreads();
        int b, pos0; chan_pos(r0, b, pos0);
        const int ra = r0 + 2 * lane, rb = ra + 1;
        const float hp0 = has_prev(ra) ? 1.f : 0.f, hn0 = has_next(ra) ? 1.f : 0.f, hp1 = has_prev(rb) ? 1.f : 0.f, hn1 = has_next(rb) ? 1.f : 0.f;
        bf16* dst = wsp<bf16>(c, part == 0 ? WS_VT : (part == 1 ? WS_X1T : WS_X2T));
        const float* cw = c.in[I_HYCW] + (size_t)l * 3 * 1152 + part * DH; const float* cb = c.in[I_HYCB] + l * 1152 + part * DH;
        for (int cc = wave; cc < DH; cc += 8) {
            const LAS bf16* col = (const LAS bf16*)(lds + 2 * lane * HP_PITCH + cc * 2);
            const float xm = bf2f(col[0]), x0 = bf2f(col[HP_PITCH / 2]), x1 = bf2f(col[HP_PITCH]), x2 = bf2f(col[3 * (HP_PITCH / 2)]);
            const float w0 = cw[cc], w1 = cw[1152 + cc], w2 = cw[2304 + cc], bb = cb[cc];
            const float y0 = bb + w0 * xm * hp0 + w1 * x0 + w2 * x1 * hn0, y1 = bb + w0 * x0 * hp1 + w1 * x1 + w2 * x2 * hn1;
            *(unsigned*)(dst + ((size_t)cc * NB + b) * NPOS + pos0 + 2 * lane) = f2bf_bits(y0) | (f2bf_bits(y1) << 16); }
        __syncthreads(); }
}
template <int LS> __device__ __forceinline__ void hy_conv_seq(const Ctx& c, int l, int cc, LAS unsigned char* lds, int tid) {
    constexpr int L = LS ? CTXL : SEQ, PB = LS ? SEQ : 0, RKP = LS ? RKP1 : RKP0;
    constexpr int CP = (2 * L + 16) * 2, ZP = (L + 8) * 2, Z_OFF = 8 * CP, NST = L / 32, NTB = L / 128;
    static_assert(Z_OFF + 16 * ZP <= 147200 && (CP % 256) == 32, "hyena LDS map");
    const int lane = tid & 63, wave = __builtin_amdgcn_readfirstlane(tid >> 6), m = lane & 15, q = lane >> 4;
    const bf16* VT = wsp<bf16>(c, WS_VT); const bf16* X1T = wsp<bf16>(c, WS_X1T); const bf16* X2T = wsp<bf16>(c, WS_X2T); bf16* Z1T = wsp<bf16>(c, WS_Z1T); bf16* HYT = wsp<bf16>(c, WS_HYT);
    const size_t rowb = ((size_t)cc * NB) * NPOS + PB;
#pragma unroll 1
    for (int o = 0; o < 2; ++o) {
        const bf16* RK = wsp<bf16>(c, LS ? WS_RK1 : WS_RK0) + ((((size_t)l * 2 + o) * DH + cc) * 2) * RKP;
        const bf16* Zs = o == 0 ? VT : Z1T;
        { constexpr int NF = (8 * (CP / 16) + NTHR_ - 1) / NTHR_, NZ = (16 * (L / 8) + NTHR_ - 1) / NTHR_;
          v4u_a4 fv[NF]; v4u zv[NZ];
#pragma unroll
          for (int u = 0; u < NF; ++u) { const int i = tid + u * NTHR_, j = i / (CP / 16), k = i % (CP / 16); fv[u] = (v4u_a4){0u, 0u, 0u, 0u};
              if (i < 8 * (CP / 16)) fv[u] = *(const v4u_a4*)(RK + (size_t)(j & 1) * RKP + k * 8 + (j & ~1)); }
#pragma unroll
          for (int u = 0; u < NZ; ++u) { const int i = tid + u * NTHR_, b = i / (L / 8), k = i % (L / 8); zv[u] = (v4u){0u, 0u, 0u, 0u};
              if (i < 16 * (L / 8)) zv[u] = *(const v4u*)(Zs + rowb + (size_t)b * NPOS + k * 8); }
#pragma unroll
          for (int u = 0; u < NF; ++u) { const int i = tid + u * NTHR_, j = i / (CP / 16), k = i % (CP / 16); if (i < 8 * (CP / 16)) *(LAS v4u*)(lds + j * CP + k * 16) = (v4u){fv[u].x, fv[u].y, fv[u].z, fv[u].w}; }
#pragma unroll
          for (int u = 0; u < NZ; ++u) { const int i = tid + u * NTHR_, b = i / (L / 8), k = i % (L / 8); if (i < 16 * (L / 8)) *(LAS v4u*)(lds + Z_OFF + b * ZP + k * 16) = zv[u]; } }
        __syncthreads();
        const float bias = c.in[I_HBIAS][(l * 2 + o) * DH + cc];
        float inv; { const float* np = wsp<float>(c, WS_NRMP) + ((((size_t)l * 2 + LS) * 2 + o) * DH + cc) * 64; constexpr int NTBK = LS ? RKT_CTX : RKT_LAT; float sn = 0.f;
            for (int i = 0; i < NTBK; ++i) sn += np[i] + np[32 + i];
            inv = 1.0f / sn; }
        const int jc = (7 - m) & 7;
        for (int tb = wave; tb < NTB; tb += 8) {
            const int abase = jc * CP + 2 * ((m < 8 ? -7 : -15) + L - 1 - 128 * tb) + 16 * q, zbase = Z_OFF + m * ZP + 16 * q;
#define HY_LDA(k) (*(const LAS bf16x8_t*)(lds + abase + 32 * (k)))
            bf16x8_t win[8]; f32x4_t acc[8];
#pragma unroll
            for (int i = 0; i < 8; ++i) acc[i] = (f32x4_t){0.f, 0.f, 0.f, 0.f};
#pragma unroll
            for (int k = -7; k <= -2; ++k) win[(k + 8) & 7] = HY_LDA(k);
#pragma unroll 1
            for (int b4 = 0; b4 < NST / 4; ++b4) {
#pragma unroll
                for (int u = 0; u < 4; ++u) { const int st = 4 * b4 + u;
                    win[(2 * u) & 7] = HY_LDA(2 * st); win[(2 * u + 7) & 7] = HY_LDA(2 * st - 1);
                    const bf16x8_t zf = *(const LAS bf16x8_t*)(lds + zbase + 64 * st);
#pragma unroll
                    for (int i = 0; i < 8; ++i) acc[i] = __builtin_amdgcn_mfma_f32_16x16x32_bf16(win[(2 * u - i + 8) & 7], zf, acc[i], 0, 0, 0); } }
#undef HY_LDA
            const bf16* Xg = (o == 0 ? X1T : X2T) + rowb + (size_t)m * NPOS; bf16* Og = (o == 0 ? Z1T : HYT) + rowb + (size_t)m * NPOS;
#pragma unroll
            for (int i = 0; i < 8; ++i) { const int t = 128 * tb + 16 * i + 4 * q;
                const v2u xg = *(const v2u*)(Xg + t); const v2u zl = *(const LAS v2u*)(lds + Z_OFF + m * ZP + 2 * t);
                const float x0 = __uint_as_float(xg.x << 16), x1 = __uint_as_float(xg.x & 0xffff0000u), x2 = __uint_as_float(xg.y << 16), x3 = __uint_as_float(xg.y & 0xffff0000u);
                const float z0 = __uint_as_float(zl.x << 16), z1 = __uint_as_float(zl.x & 0xffff0000u), z2 = __uint_as_float(zl.y << 16), z3 = __uint_as_float(zl.y & 0xffff0000u);
                v2u w; w.x = f2bf_bits(x0 * (acc[i][0] * inv + bias * z0)) | (f2bf_bits(x1 * (acc[i][1] * inv + bias * z1)) << 16);
                w.y = f2bf_bits(x2 * (acc[i][2] * inv + bias * z2)) | (f2bf_bits(x3 * (acc[i][3] * inv + bias * z3)) << 16);
                *(v2u*)(Og + t) = w; } }
        __syncthreads();
    }
}
__device__ __forceinline__ void hy_conv(const Ctx& c, int l, LAS unsigned char* lds, int tid, int G, int bid) {
    for (int cc = bid; cc < DH; cc += G) { hy_conv_seq<0>(c, l, cc, lds, tid); hy_conv_seq<1>(c, l, cc, lds, tid); }
}
__device__ __forceinline__ void hy_post(const Ctx& c, LAS unsigned char* lds, int tid, int G, int bid) {
    constexpr int TPB = 260;
    const bf16* HYT = wsp<bf16>(c, WS_HYT); bf16* HY = wsp<bf16>(c, WS_HY); const int lane = tid & 63, wave = __builtin_amdgcn_readfirstlane(tid >> 6);
    for (int tile = bid; tile < NT / 128; tile += G) { const int r0 = tile * 128; int b, pos0; chan_pos(r0, b, pos0);
        for (int c0 = wave; c0 < DH; c0 += 8 * 16) { unsigned hv[16];
#pragma unroll
            for (int u = 0; u < 16; ++u) { const int cc = c0 + 8 * u; hv[u] = cc < DH ? *(const unsigned*)(HYT + ((size_t)cc * NB + b) * NPOS + pos0 + 2 * lane) : 0u; }
#pragma unroll
            for (int u = 0; u < 16; ++u) { const int cc = c0 + 8 * u; if (cc < DH) *(LAS unsigned*)(lds + cc * TPB + 4 * lane) = hv[u]; } }
        __syncthreads();
        for (int i = tid; i < 128 * 48; i += NTHR_) { const int t = i % 128, ch = i / 128; const LAS bf16* s0 = (const LAS bf16*)(lds + (ch * 8) * TPB + 2 * t);
            v4u o; o.x = (unsigned)s0[0] | ((unsigned)s0[TPB / 2] << 16); o.y = (unsigned)s0[2 * (TPB / 2)] | ((unsigned)s0[3 * (TPB / 2)] << 16);
            o.z = (unsigned)s0[4 * (TPB / 2)] | ((unsigned)s0[5 * (TPB / 2)] << 16); o.w = (unsigned)s0[6 * (TPB / 2)] | ((unsigned)s0[7 * (TPB / 2)] << 16);
            *(v4u*)(HY + (size_t)(r0 + t) * DH + ch * 8) = o; }
        __syncthreads(); }
}

constexpr int ML_QS = 0, ML_KS = 13312, ML_KT = 26624, ML_VT = 40448, ML_VW = 49664, ML_SP = 58880, ML_CB = 68096, ML_VEC = 81408, ML_DEN = 83968, ML_SCAL = 84224, ML_CW = 84480;
constexpr int ML_P1 = 208, ML_P2 = 144;
__device__ __forceinline__ float fexp(float x) { return __builtin_amdgcn_exp2f(1.4426950408889634f * x); }
__device__ __forceinline__ void ml_prep(const Ctx& c, int l, int tid, int G, int bid) {
    if (tid >= 384) return;
    const int ch = tid % 96, tg = tid / 96; const bf16* P = wsp<bf16>(c, WS_P); bf16* QK = wsp<bf16>(c, WS_QKC);
    float w0[8], w1[8], w2[8], bb[8];
#pragma unroll
    for (int e = 0; e < 8; ++e) { const float* cw = c.in[I_MLCW] + (size_t)l * 3 * 768 + ch * 8 + e; w0[e] = cw[0]; w1[e] = cw[768]; w2[e] = cw[1536]; bb[e] = c.in[I_MLCB][l * 768 + ch * 8 + e]; }
    const float ksc = ch >= 48 ? 0.10206207261596575f : 1.0f;
    for (int g0 = bid; g0 < NT / 4; g0 += 4 * G) {
        v4u x0[4], xm[4], xp[4];
#pragma unroll
        for (int u = 0; u < 4; ++u) { const int grp = g0 + u * G; x0[u] = (v4u){0u, 0u, 0u, 0u}; xm[u] = x0[u]; xp[u] = x0[u];
            if (grp < NT / 4) { const int r = grp * 4 + tg; const bf16* src = P + (size_t)r * NP + PC_Q + ch * 8; x0[u] = *(const v4u*)src;
                if (has_prev(r)) xm[u] = *(const v4u*)(src - NP); if (has_next(r)) xp[u] = *(const v4u*)(src + NP); } }
#pragma unroll
        for (int u = 0; u < 4; ++u) { const int grp = g0 + u * G; if (grp < NT / 4) { const int r = grp * 4 + tg; unsigned o[4];
#pragma unroll
            for (int e2 = 0; e2 < 4; ++e2) { float y[2];
#pragma unroll
                for (int hh = 0; hh < 2; ++hh) { const int e = 2 * e2 + hh; const unsigned um = xm[u][e2], u0 = x0[u][e2], up = xp[u][e2];
                    const float fm = __uint_as_float(hh ? (um & 0xffff0000u) : (um << 16)), f0 = __uint_as_float(hh ? (u0 & 0xffff0000u) : (u0 << 16)), fp = __uint_as_float(hh ? (up & 0xffff0000u) : (up << 16));
                    float v = bb[e] + w0[e] * fm + w1[e] * f0 + w2[e] * fp; y[hh] = v * pg8::fsig(v) * ksc; }
                o[e2] = f2bf_bits(y[0]) | (f2bf_bits(y[1]) << 16); }
            *(v4u*)(QK + (size_t)r * 768 + ch * 8) = (v4u){o[0], o[1], o[2], o[3]}; } } }
}
constexpr int ML_GV = 87552, ML_MP = 133632, ML_DEC = 133776, ML_SC = 133920, ML_NCH = NPOS / 64;
static_assert(ML_SC + ML_NCH * 8 <= 147200, "mLSTM LDS map");
#define ML_BAR() do { asm volatile("s_waitcnt lgkmcnt(0)" ::: "memory"); __builtin_amdgcn_s_barrier(); asm volatile("" ::: "memory"); } while (0)
__device__ __forceinline__ void ml_chain(const Ctx& c, int l, LAS unsigned char* lds, int tid, int unit) {
    const int d = unit >> 7, b = (unit >> 3) & 15, h = (unit >> 1) & 3, half = unit & 1;
    const int lane = tid & 63, wave = __builtin_amdgcn_readfirstlane(tid >> 6), m16 = lane & 15, q = lane >> 4;
    const bf16* P = wsp<bf16>(c, WS_P); const bf16* QK = wsp<bf16>(c, WS_QKC); bf16* HFB = wsp<bf16>(c, WS_HFB) + (size_t)d * NT * DH + h * MLD + half * 48;
    LAS float* GV = (LAS float*)(lds + ML_GV); LAS float* DEN = (LAS float*)(lds + ML_DEN);
    LAS float* MP = (LAS float*)(lds + ML_MP); LAS float* DEC = (LAS float*)(lds + ML_DEC); LAS float* SC = (LAS float*)(lds + ML_SC);
    for (int i = tid; i < 16 * 64; i += NTHR_) { const int row = 48 + i / 64, j = i % 64; ((LAS bf16*)(lds + ML_VT + row * ML_P2))[j] = row == 48 ? (bf16)0x3F80 : (bf16)0; ((LAS bf16*)(lds + ML_VW + row * ML_P2))[j] = 0; }
    for (int i = tid; i < 64 * ML_P1 / 4; i += NTHR_) ((LAS unsigned*)(lds + ML_CB))[i] = 0u;
    const float gbi = c.in[I_MLGB][l * 16 + (2 * d) * 4 + h], gbf = c.in[I_MLGB][l * 16 + (2 * d + 1) * 4 + h];
    for (int ch = wave; ch < ML_NCH; ch += 8) { const int r = seq_tok(d, b, ch * 64 + lane);
        const float gi = bf2f(P[(size_t)r * NP + PC_GT + (2 * d) * 4 + h]) + gbi, gf = logsig(bf2f(P[(size_t)r * NP + PC_GT + (2 * d + 1) * 4 + h]) + gbf);
        float bc = gf;
#pragma unroll
        for (int o = 1; o < 64; o <<= 1) { const float y = __shfl_up(bc, o); if (lane >= o) bc += y; }
        const float a = gi - bc; float pm = a;
#pragma unroll
        for (int o = 1; o < 64; o <<= 1) { const float y = __shfl_up(pm, o); if (lane >= o) pm = fmaxf(pm, y); }
        LAS float* V = GV + ch * 320; V[lane] = a; V[64 + lane] = pm; V[256 + lane] = bc;
        if (lane == 63) { SC[2 * ch] = pm; SC[2 * ch + 1] = bc; } }
    __syncthreads();
    if (wave == 0) { float mp = -1e30f;
        for (int ch = 0; ch < ML_NCH; ++ch) { if (lane == 0) MP[ch] = mp; mp = SC[2 * ch + 1] + fmaxf(mp, SC[2 * ch]); } }
    __syncthreads();
    for (int ch = wave; ch < ML_NCH; ch += 8) { LAS float* V = GV + ch * 320; const float mp = MP[ch], a = V[lane], pm = V[64 + lane], bc = V[256 + lane];
        const float M = fmaxf(mp, pm), M63 = __shfl(M, 63);
        V[64 + lane] = M; V[128 + lane] = fexp(mp - M); V[192 + lane] = fexp(a - M63); V[256 + lane] = fexp(-(bc + M));
        if (lane == 0) DEC[ch] = fexp(mp - M63); }
    f32x4_t accC[3];
#pragma unroll
    for (int i = 0; i < 3; ++i) accC[i] = (f32x4_t){0.f, 0.f, 0.f, 0.f};
    v4u x0[3], xv;
#define ML_LOAD(chn) do { const int t0_ = (chn) * 64; \
        _Pragma("unroll") for (int it = 0; it < 3; ++it) { const int idx = tid + NTHR_ * it, j = idx & 63, c8 = idx >> 6, isk = c8 >= 12 ? 1 : 0, cc = c8 - 12 * isk; \
            const int r = seq_tok(d, b, t0_ + j); x0[it] = *(const v4u*)(QK + (size_t)r * 768 + isk * DH + h * MLD + cc * 8); } \
        if (tid < 384) { const int j = tid & 63, c6 = tid >> 6, r = seq_tok(d, b, t0_ + j); xv = *(const v4u*)(P + (size_t)r * NP + PC_V + h * MLD + half * 48 + c6 * 8); } } while (0)
    xv = (v4u){0u, 0u, 0u, 0u};
    ML_LOAD(0);
    __syncthreads();
    float oval[2][4];
#pragma unroll
    for (int i = 0; i < 2; ++i)
#pragma unroll
        for (int jj = 0; jj < 4; ++jj) oval[i][jj] = 0.f;
#define ML_STORE_PREV(tau_) do { const int tq_ = wave >> 1, dq_ = 2 * (wave & 1); \
        _Pragma("unroll") for (int i = 0; i < 2; ++i) if (dq_ + i < 3) { _Pragma("unroll") for (int jj = 0; jj < 4; ++jj) { const int r_ = seq_tok(d, b, (tau_) + 16 * tq_ + 4 * q + jj); HFB[(size_t)r_ * DH + 16 * (dq_ + i) + m16] = f2bf(oval[i][jj]); } } } while (0)
#pragma unroll 1
    for (int ch = 0; ch < ML_NCH; ++ch) {
        const int tau0 = ch * 64; LAS float* V = GV + ch * 320;
#pragma unroll
        for (int it = 0; it < 3; ++it) { const int idx = tid + NTHR_ * it, j = idx & 63, c8 = idx >> 6, isk = c8 >= 12 ? 1 : 0, cc = c8 - 12 * isk;
            *(LAS v4u*)(lds + (isk ? ML_KS : ML_QS) + j * ML_P1 + cc * 16) = x0[it];
            if (isk) {
#pragma unroll
                for (int e = 0; e < 8; ++e) ((LAS bf16*)(lds + ML_KT + (cc * 8 + e) * ML_P2))[j] = (bf16)((e & 1) ? (x0[it][e >> 1] >> 16) : (x0[it][e >> 1] & 0xffffu)); } }
        if (tid < 384) { const int j = tid & 63, c6 = tid >> 6; const float wj = V[192 + j];
#pragma unroll
            for (int e = 0; e < 8; ++e) { const unsigned u = xv[e >> 1]; const unsigned bits = (e & 1) ? (u >> 16) : (u & 0xffffu);
                ((LAS bf16*)(lds + ML_VT + (c6 * 8 + e) * ML_P2))[j] = (bf16)bits; ((LAS bf16*)(lds + ML_VW + (c6 * 8 + e) * ML_P2))[j] = f2bf(wj * __uint_as_float(bits << 16)); } }
        else if (tid < 448) { const int j = tid - 384; ((LAS bf16*)(lds + ML_VW + 48 * ML_P2))[j] = f2bf(V[192 + j]); }
        if (ch > 0) ML_STORE_PREV(tau0 - 64);
        if (ch + 1 < ML_NCH) ML_LOAD(ch + 1);
        ML_BAR();
        {
            const unsigned long long TS = 0x313210210100ull, TT = 0x203333222110ull;
#pragma unroll
            for (int rep = 0; rep < 2; ++rep) { const int idx = wave + 8 * rep; if (idx < 12) { const int st = (int)((TS >> (4 * idx)) & 15), tt = (int)((TT >> (4 * idx)) & 15);
                f32x4_t acc = (f32x4_t){0.f, 0.f, 0.f, 0.f};
                if (idx < 10) {
#pragma unroll
                    for (int ks = 0; ks < 3; ++ks) { const bf16x8_t a = *(const LAS bf16x8_t*)(lds + ML_KS + (16 * st + m16) * ML_P1 + (ks * 32 + 8 * q) * 2);
                        const bf16x8_t bq = *(const LAS bf16x8_t*)(lds + ML_QS + (16 * tt + m16) * ML_P1 + (ks * 32 + 8 * q) * 2); acc = __builtin_amdgcn_mfma_f32_16x16x32_bf16(a, bq, acc, 0, 0, 0); } }
                const int t = 16 * tt + m16, s0 = 16 * st + 4 * q; const float Mt = V[64 + t]; const f32x4_t a4 = *(const LAS f32x4_t*)(V + s0); float o[4];
#pragma unroll
                for (int jj = 0; jj < 4; ++jj) o[jj] = (idx < 10 && s0 + jj <= t) ? acc[jj] * fexp(a4[jj] - Mt) : 0.f;
                *(LAS v2u*)(lds + ML_SP + t * ML_P2 + s0 * 2) = (v2u){f2bf_bits(o[0]) | (f2bf_bits(o[1]) << 16), f2bf_bits(o[2]) | (f2bf_bits(o[3]) << 16)}; } }
        }
        const int tt = wave >> 1, dt0 = 2 * (wave & 1);
        f32x4_t accB[2], accA[2];
#pragma unroll
        for (int i = 0; i < 2; ++i) { accB[i] = (f32x4_t){0.f, 0.f, 0.f, 0.f}; accA[i] = (f32x4_t){0.f, 0.f, 0.f, 0.f}; }
#pragma unroll
        for (int ks = 0; ks < 3; ++ks) { const bf16x8_t a = *(const LAS bf16x8_t*)(lds + ML_QS + (16 * tt + m16) * ML_P1 + (ks * 32 + 8 * q) * 2);
#pragma unroll
            for (int i = 0; i < 2; ++i) { const bf16x8_t bb = *(const LAS bf16x8_t*)(lds + ML_CB + (16 * (dt0 + i) + m16) * ML_P1 + (ks * 32 + 8 * q) * 2); accB[i] = __builtin_amdgcn_mfma_f32_16x16x32_bf16(a, bb, accB[i], 0, 0, 0); } }
        ML_BAR();
#pragma unroll
        for (int ks = 0; ks < 2; ++ks) if (ks <= (tt >> 1)) { const bf16x8_t a = *(const LAS bf16x8_t*)(lds + ML_SP + (16 * tt + m16) * ML_P2 + (ks * 32 + 8 * q) * 2);
#pragma unroll
            for (int i = 0; i < 2; ++i) { const bf16x8_t bb = *(const LAS bf16x8_t*)(lds + ML_VT + (16 * (dt0 + i) + m16) * ML_P2 + (ks * 32 + 8 * q) * 2); accA[i] = __builtin_amdgcn_mfma_f32_16x16x32_bf16(a, bb, accA[i], 0, 0, 0); } }
        { const f32x4_t wa4 = *(const LAS f32x4_t*)(V + 128 + 16 * tt + 4 * q);
#pragma unroll
          for (int i = 0; i < 2; ++i) accA[i] = accA[i] + wa4 * accB[i];
          if (dt0 == 2 && m16 == 0) *(LAS f32x4_t*)(DEN + 16 * tt + 4 * q) = accA[1]; }
        { const float decay = DEC[ch]; const int dtile = wave >> 1, et0 = 3 * (wave & 1);
#pragma unroll
          for (int i = 0; i < 3; ++i) accC[i] = accC[i] * decay;
#pragma unroll
          for (int ks = 0; ks < 2; ++ks) { const bf16x8_t a = *(const LAS bf16x8_t*)(lds + ML_VW + (16 * dtile + m16) * ML_P2 + (ks * 32 + 8 * q) * 2);
#pragma unroll
              for (int i = 0; i < 3; ++i) { const bf16x8_t bb = *(const LAS bf16x8_t*)(lds + ML_KT + (16 * (et0 + i) + m16) * ML_P2 + (ks * 32 + 8 * q) * 2); accC[i] = __builtin_amdgcn_mfma_f32_16x16x32_bf16(a, bb, accC[i], 0, 0, 0); } }
#pragma unroll
          for (int i = 0; i < 3; ++i)
#pragma unroll
              for (int jj = 0; jj < 4; ++jj) ((LAS bf16*)(lds + ML_CB + (16 * dtile + 4 * q + jj) * ML_P1))[16 * (et0 + i) + m16] = f2bf(accC[i][jj]); }
        ML_BAR();
        { const f32x4_t dn = *(const LAS f32x4_t*)(DEN + 16 * tt + 4 * q), em = *(const LAS f32x4_t*)(V + 256 + 16 * tt + 4 * q);
#pragma unroll
          for (int i = 0; i < 2; ++i)
#pragma unroll
              for (int jj = 0; jj < 4; ++jj) oval[i][jj] = accA[i][jj] / fmaxf(fabsf(dn[jj]), em[jj]); }
    }
    ML_STORE_PREV((ML_NCH - 1) * 64);
#undef ML_LOAD
#undef ML_STORE_PREV
    __syncthreads();
}
constexpr int NR_SS = 0, NR_PL = 1024, NR_LG = 17408;
template <int MODE, bool COMB, bool FROMIN = false> __device__ __forceinline__ void norm_rows(const Ctx& c, int l, int lc, LAS unsigned char* lds, int tid, int G, int bid, int nrows = NT) {
    const int lane = tid & 63, wave = __builtin_amdgcn_readfirstlane(tid >> 6), m = lane & 15, q = lane >> 4;
    bf16* X = wsp<bf16>(c, WS_X); const float* MOD = wsp<float>(c, WS_MOD); bf16* H = wsp<bf16>(c, WS_H); (void)H;
    LAS float* SS = (LAS float*)(lds + NR_SS); LAS float* PL = (LAS float*)(lds + NR_PL); LAS float* LG = (LAS float*)(lds + NR_LG);
    bf16x8_t Bh[4][2], Bl[4][2];
    if (MODE == 1) {
#pragma unroll
        for (int i = 0; i < 4; ++i)
#pragma unroll
            for (int nt = 0; nt < 2; ++nt) { const size_t o = ((size_t)l * NE + 16 * nt + m) * D + 128 * wave + 32 * i + 8 * q;
                Bh[i][nt] = *(const bf16x8_t*)(wsp<bf16>(c, WS_WRH) + o); Bl[i][nt] = *(const bf16x8_t*)(wsp<bf16>(c, WS_WRL) + o); } }
    const int ngrp = (MODE == 2 ? NTL : nrows) / 16; int par = 0; const int kb = 128 * wave + 8 * q;
    f32x4_t xa[4], xb[4]; v4u sl = (v4u){0u, 0u, 0u, 0u}; f32x4_t wk = (f32x4_t){0.f, 0.f, 0.f, 0.f};
#define NR_LOAD(g_) do { const int row_ = (g_) * 16 + m; \
        if (FROMIN) { const float* xs_ = row_ < NTL ? c.in[I_X] + (size_t)row_ * D : c.in[I_CTX] + (size_t)(row_ - NTL) * D; \
            _Pragma("unroll") for (int i = 0; i < 4; ++i) { xa[i] = *(const f32x4_t*)(xs_ + kb + 32 * i); xb[i] = *(const f32x4_t*)(xs_ + kb + 32 * i + 4); } } \
        else { const bf16* xs_ = X + (size_t)row_ * D; \
            _Pragma("unroll") for (int i = 0; i < 4; ++i) { const v4u w_ = *(const v4u*)(xs_ + kb + 32 * i); \
                xa[i] = (f32x4_t){__uint_as_float(w_.x << 16), __uint_as_float(w_.x & 0xffff0000u), __uint_as_float(w_.y << 16), __uint_as_float(w_.y & 0xffff0000u)}; \
                xb[i] = (f32x4_t){__uint_as_float(w_.z << 16), __uint_as_float(w_.z & 0xffff0000u), __uint_as_float(w_.w << 16), __uint_as_float(w_.w & 0xffff0000u)}; } } \
        if (COMB) { sl = *(const v4u*)(wsp<int>(c, WS_ASGS) + (size_t)row_ * TOPK); wk = *(const f32x4_t*)(wsp<float>(c, WS_ASGW) + (size_t)row_ * TOPK); } } while (0)
    if (bid < ngrp) NR_LOAD(bid);
    for (int grp = bid; grp < ngrp; grp += G, par ^= 1) {
        const int r0 = grp * 16, row = r0 + m, mb = r0 < NTL ? r0 / SEQ : NB;
        float xv[4][8];
#pragma unroll
        for (int i = 0; i < 4; ++i) { xv[i][0] = xa[i][0]; xv[i][1] = xa[i][1]; xv[i][2] = xa[i][2]; xv[i][3] = xa[i][3]; xv[i][4] = xb[i][0]; xv[i][5] = xb[i][1]; xv[i][6] = xb[i][2]; xv[i][7] = xb[i][3]; }
        const v4u slc = sl; const f32x4_t wkc = wk;
        if (COMB) {
            const unsigned char* O = wsp<unsigned char>(c, WS_OUTS); const float* OSC = wsp<float>(c, WS_OUTSC);
            const float* g2 = MOD + ((size_t)lc * NMOD + mb) * 6144 + 5 * D + kb;
#pragma unroll
            for (int i = 0; i < 4; ++i) { float f[8]; float ssum = 0.f;
#pragma unroll
                for (int e = 0; e < 8; ++e) f[e] = 0.f;
#pragma unroll
                for (int kk = 0; kk < TOPK; ++kk) { const v2u o = *(const v2u*)(O + (size_t)slc[kk] * D + kb + 32 * i); const float sc = wkc[kk] * OSC[(size_t)slc[kk] * 32 + 4 * wave + i]; ssum += sc;
                    f[0] += sc * (float)(o.x & 0xffu); f[1] += sc * (float)((o.x >> 8) & 0xffu); f[2] += sc * (float)((o.x >> 16) & 0xffu); f[3] += sc * (float)(o.x >> 24);
                    f[4] += sc * (float)(o.y & 0xffu); f[5] += sc * (float)((o.y >> 8) & 0xffu); f[6] += sc * (float)((o.y >> 16) & 0xffu); f[7] += sc * (float)(o.y >> 24); }
#pragma unroll
                for (int e = 0; e < 8; ++e) f[e] -= 128.0f * ssum;
                const f32x4_t ga = *(const f32x4_t*)(g2 + 32 * i), gb = *(const f32x4_t*)(g2 + 32 * i + 4);
#pragma unroll
                for (int e = 0; e < 4; ++e) { xv[i][e] += ga[e] * f[e]; xv[i][4 + e] += gb[e] * f[4 + e]; }
                if (MODE != 2) { *(v4u*)(X + (size_t)row * D + kb + 32 * i) = (v4u){f2bf_bits(xv[i][0]) | (f2bf_bits(xv[i][1]) << 16), f2bf_bits(xv[i][2]) | (f2bf_bits(xv[i][3]) << 16), f2bf_bits(xv[i][4]) | (f2bf_bits(xv[i][5]) << 16), f2bf_bits(xv[i][6]) | (f2bf_bits(xv[i][7]) << 16)};
#pragma unroll
                    for (int e = 0; e < 8; ++e) xv[i][e] = __uint_as_float(f2bf_bits(xv[i][e]) << 16); } }
        }
        if (grp + G < ngrp) NR_LOAD(grp + G);
        float ss = 0.f;
#pragma unroll
        for (int i = 0; i < 4; ++i)
#pragma unroll
            for (int e = 0; e < 8; ++e) ss += xv[i][e] * xv[i][e];
        ss += __shfl_xor(ss, 16); ss += __shfl_xor(ss, 32);
        if (q == 0) SS[par * 128 + wave * 16 + m] = ss;
        ML_BAR();
        float tot = 0.f;
#pragma unroll
        for (int w = 0; w < 8; ++w) tot += SS[par * 128 + w * 16 + m];
        const float rs = 1.0f / sqrtf(tot * (1.0f / D) + EPS);
        if (MODE == 2) { const float* fg = c.in[I_FNG] + kb;
#pragma unroll
            for (int i = 0; i < 4; ++i) { const f32x4_t ga = *(const f32x4_t*)(fg + 32 * i), gb = *(const f32x4_t*)(fg + 32 * i + 4);
                *(f32x4_t*)(c.out + (size_t)row * D + kb + 32 * i) = (f32x4_t){xv[i][0] * rs * ga[0], xv[i][1] * rs * ga[1], xv[i][2] * rs * ga[2], xv[i][3] * rs * ga[3]};
                *(f32x4_t*)(c.out + (size_t)row * D + kb + 32 * i + 4) = (f32x4_t){xv[i][4] * rs * gb[0], xv[i][5] * rs * gb[1], xv[i][6] * rs * gb[2], xv[i][7] * rs * gb[3]}; }
            continue; }
        const float* ng = c.in[MODE == 1 ? I_N2G : I_N1G] + l * D + kb; const float* sh = MOD + ((size_t)l * NMOD + mb) * 6144 + (MODE == 1 ? 3 : 0) * D + kb; const float* sc = sh + D;
        if (MODE == 0) {
            float amax = 0.f;
#pragma unroll
            for (int i = 0; i < 4; ++i)
#pragma unroll
                for (int hh = 0; hh < 2; ++hh) { const f32x4_t g4 = *(const f32x4_t*)(ng + 32 * i + 4 * hh), s4 = *(const f32x4_t*)(sc + 32 * i + 4 * hh), h4 = *(const f32x4_t*)(sh + 32 * i + 4 * hh);
#pragma unroll
                    for (int e = 0; e < 4; ++e) { const float hv = xv[i][4 * hh + e] * rs * g4[e] * (1.0f + s4[e]) + h4[e]; xv[i][4 * hh + e] = hv; amax = fmaxf(amax, fabsf(hv)); } }
            amax = fmaxf(amax, __shfl_xor(amax, 16)); amax = fmaxf(amax, __shfl_xor(amax, 32));
            LAS float* MX = (LAS float*)(lds + 20480);
            if (q == 0) MX[par * 128 + wave * 16 + m] = amax;
            ML_BAR();
            float rmax = 0.f;
#pragma unroll
            for (int w = 0; w < 8; ++w) rmax = fmaxf(rmax, MX[par * 128 + w * 16 + m]);
            const float qs = rmax > 0.f ? rmax * (1.0f / 127.0f) : 1.0f, qi = 1.0f / qs;
            if (wave == 0 && q == 0) wsp<float>(c, WS_HS)[row] = qs;
            signed char* HQ = wsp<signed char>(c, WS_H);
#pragma unroll
            for (int i = 0; i < 4; ++i) { unsigned pk[2];
#pragma unroll
                for (int w2 = 0; w2 < 2; ++w2) { unsigned v = 0u;
#pragma unroll
                    for (int e = 0; e < 4; ++e) { const int qq = (int)__builtin_rintf(xv[i][4 * w2 + e] * qi); v |= ((unsigned)qq & 0xffu) << (8 * e); }
                    pk[w2] = v; }
                *(v2u*)(HQ + (size_t)row * D + kb + 32 * i) = (v2u){pk[0], pk[1]}; }
            continue; }
        f32x4_t accL[2] = {(f32x4_t){0.f, 0.f, 0.f, 0.f}, (f32x4_t){0.f, 0.f, 0.f, 0.f}}; float amax1 = 0.f;
#pragma unroll
        for (int i = 0; i < 4; ++i) { float hv[8];
#pragma unroll
            for (int hh = 0; hh < 2; ++hh) { const f32x4_t g4 = *(const f32x4_t*)(ng + 32 * i + 4 * hh), s4 = *(const f32x4_t*)(sc + 32 * i + 4 * hh), h4 = *(const f32x4_t*)(sh + 32 * i + 4 * hh);
#pragma unroll
                for (int e = 0; e < 4; ++e) { hv[4 * hh + e] = xv[i][4 * hh + e] * rs * g4[e] * (1.0f + s4[e]) + h4[e]; xv[i][4 * hh + e] = hv[4 * hh + e]; amax1 = fmaxf(amax1, fabsf(hv[4 * hh + e])); } }
            unsigned hb[8];
#pragma unroll
            for (int e = 0; e < 8; ++e) hb[e] = f2bf_bits(hv[e]);
            const v4u hp = (v4u){hb[0] | (hb[1] << 16), hb[2] | (hb[3] << 16), hb[4] | (hb[5] << 16), hb[6] | (hb[7] << 16)};
            { unsigned lb[8];
#pragma unroll
                for (int e = 0; e < 8; ++e) lb[e] = f2bf_bits(hv[e] - __uint_as_float(hb[e] << 16));
                const v4u lp = (v4u){lb[0] | (lb[1] << 16), lb[2] | (lb[3] << 16), lb[4] | (lb[5] << 16), lb[6] | (lb[7] << 16)};
                const bf16x8_t Ah = __builtin_bit_cast(bf16x8_t, hp), Al = __builtin_bit_cast(bf16x8_t, lp);
#pragma unroll
                for (int nt = 0; nt < 2; ++nt) { accL[nt] = __builtin_amdgcn_mfma_f32_16x16x32_bf16(Ah, Bh[i][nt], accL[nt], 0, 0, 0);
                    accL[nt] = __builtin_amdgcn_mfma_f32_16x16x32_bf16(Al, Bh[i][nt], accL[nt], 0, 0, 0); accL[nt] = __builtin_amdgcn_mfma_f32_16x16x32_bf16(Ah, Bl[i][nt], accL[nt], 0, 0, 0); } } }
        { amax1 = fmaxf(amax1, __shfl_xor(amax1, 16)); amax1 = fmaxf(amax1, __shfl_xor(amax1, 32)); LAS float* MX = (LAS float*)(lds + 20480); if (q == 0) MX[par * 128 + wave * 16 + m] = amax1; }
        if (MODE == 1) {
#pragma unroll
            for (int nt = 0; nt < 2; ++nt)
#pragma unroll
                for (int j = 0; j < 4; ++j) PL[(wave * 16 + 4 * q + j) * 32 + 16 * nt + m] = accL[nt][j];
            ML_BAR();
            { const LAS float* MX = (const LAS float*)(lds + 20480); float rmax = 0.f;
#pragma unroll
              for (int w = 0; w < 8; ++w) rmax = fmaxf(rmax, MX[par * 128 + w * 16 + m]);
              const float qs = rmax > 0.f ? rmax * (1.0f / 127.0f) : 1.0f, qi = 1.0f / qs;
              if (wave == 0 && q == 0) wsp<float>(c, WS_HS)[row] = qs;
              signed char* HQ = wsp<signed char>(c, WS_H);
#pragma unroll
              for (int i = 0; i < 4; ++i) { unsigned pk[2];
#pragma unroll
                  for (int w2 = 0; w2 < 2; ++w2) { unsigned v = 0u;
#pragma unroll
                      for (int e = 0; e < 4; ++e) { const int qq = (int)__builtin_rintf(xv[i][4 * w2 + e] * qi); v |= ((unsigned)qq & 0xffu) << (8 * e); }
                      pk[w2] = v; }
                  *(v2u*)(HQ + (size_t)row * D + kb + 32 * i) = (v2u){pk[0], pk[1]}; } }
            { const int rr = tid >> 5, e = tid & 31; float v = c.in[I_RB][l * NE + e];
#pragma unroll
              for (int w = 0; w < 8; ++w) v += PL[(w * 16 + rr) * 32 + e];
              LG[rr * 32 + e] = v; }
            ML_BAR();
            if (tid < 16) { const int r = r0 + tid; float lg[NE];
#pragma unroll
                for (int e = 0; e < NE; ++e) lg[e] = LG[tid * 32 + e];
                int sel[TOPK]; float sv[TOPK]; unsigned taken = 0u;
#pragma unroll
                for (int kk = 0; kk < TOPK; ++kk) { float best = -3.0e38f; int bi = 0;
#pragma unroll
                    for (int e = 0; e < NE; ++e) { if (!((taken >> e) & 1u) && lg[e] > best) { best = lg[e]; bi = e; } }
                    sel[kk] = bi; sv[kk] = best; taken |= 1u << bi; }
                float es[TOPK], sum = 0.f;
#pragma unroll
                for (int kk = 0; kk < TOPK; ++kk) { es[kk] = expf(sv[kk] - sv[0]); sum += es[kk]; }
                int* AE = wsp<int>(c, WS_ASGE); int* AP = wsp<int>(c, WS_ASGP); float* AW = wsp<float>(c, WS_ASGW); unsigned* CNT = wsp<unsigned>(c, WS_CTL) + CW_CNT + l * NE;
#pragma unroll
                for (int kk = 0; kk < TOPK; ++kk) { AE[r * TOPK + kk] = sel[kk]; AW[r * TOPK + kk] = es[kk] / sum; AP[r * TOPK + kk] = atomic_inc(CNT + sel[kk]); } } }
    }
#undef NR_LOAD
    __syncthreads();
}

__device__ __forceinline__ void ml_headout(const Ctx& c, int l, int tid, int G, int bid) {
    const int lane = tid & 63, wave = __builtin_amdgcn_readfirstlane(tid >> 6), sub = lane & 7, hd = lane >> 3;
    const bf16* HFB = wsp<bf16>(c, WS_HFB); const bf16* P = wsp<bf16>(c, WS_P); bf16* MLO = wsp<bf16>(c, WS_MLO);
    for (int it = bid * 8 + wave; it < NT * MLH / 8; it += G * 8) { const int th = it * 8 + hd, r = th >> 2, h = th & 3; const size_t o = (size_t)r * DH + h * MLD + sub * 12;
        float v[12];
#pragma unroll
        for (int i = 0; i < 3; ++i) { const v2u a = *(const v2u*)(HFB + o + 4 * i), b = *(const v2u*)(HFB + (size_t)NT * DH + o + 4 * i);
            v[4 * i] = __uint_as_float(a.x << 16) + __uint_as_float(b.x << 16); v[4 * i + 1] = __uint_as_float(a.x & 0xffff0000u) + __uint_as_float(b.x & 0xffff0000u);
            v[4 * i + 2] = __uint_as_float(a.y << 16) + __uint_as_float(b.y << 16); v[4 * i + 3] = __uint_as_float(a.y & 0xffff0000u) + __uint_as_float(b.y & 0xffff0000u); }
        float ss = 0.f;
#pragma unroll
        for (int e = 0; e < 12; ++e) ss += v[e] * v[e];
        ss += __shfl_xor(ss, 1); ss += __shfl_xor(ss, 2); ss += __shfl_xor(ss, 4);
        const float rs = 1.0f / sqrtf(ss * (1.0f / MLD) + EPS); const float* ng = c.in[I_MLNG] + l * DH + h * MLD + sub * 12;
#pragma unroll
        for (int i = 0; i < 3; ++i) { const f32x4_t g4 = *(const f32x4_t*)(ng + 4 * i); const v2u og = *(const v2u*)(P + (size_t)r * NP + PC_O + h * MLD + sub * 12 + 4 * i);
            const float o0 = __uint_as_float(og.x << 16), o1 = __uint_as_float(og.x & 0xffff0000u), o2 = __uint_as_float(og.y << 16), o3 = __uint_as_float(og.y & 0xffff0000u);
            const float y0 = v[4 * i] * rs * g4[0] * pg8::fsig(o0), y1 = v[4 * i + 1] * rs * g4[1] * pg8::fsig(o1), y2 = v[4 * i + 2] * rs * g4[2] * pg8::fsig(o2), y3 = v[4 * i + 3] * rs * g4[3] * pg8::fsig(o3);
            *(v2u*)(MLO + o + 4 * i) = (v2u){f2bf_bits(y0) | (f2bf_bits(y1) << 16), f2bf_bits(y2) | (f2bf_bits(y3) << 16)}; } }
}
__device__ __forceinline__ void moe_dispatch(const Ctx& c, int l, LAS unsigned char* lds, int tid, int G, int bid, int nrows) {
    LAS int* PS = (LAS int*)lds; const unsigned* CNT = wsp<unsigned>(c, WS_CTL) + CW_CNT + l * NE;
    if (tid < NE) { int run = 0; for (int e = 0; e < tid; ++e) run += ((int)CNT[e] + 255) / 256; PS[tid] = run * 256;
        if (bid == 0) { int* TAB = wsp<int>(c, WS_TAB); const int nb = ((int)CNT[tid] + 255) / 256; for (int j = 0; j < nb; ++j) TAB[64 + run + j] = tid; if (tid == NE - 1) TAB[32] = run + nb; } }
    __syncthreads();
    const int* AE = wsp<int>(c, WS_ASGE); const int* AP = wsp<int>(c, WS_ASGP); int* AS_ = wsp<int>(c, WS_ASGS); int* ST = wsp<int>(c, WS_SLTOK); float* SLS = wsp<float>(c, WS_SLS); const float* HS = wsp<float>(c, WS_HS);
    for (long a = (long)bid * NTHR_ + tid; a < (long)nrows * TOPK; a += (long)G * NTHR_) { const int slot = PS[AE[a]] + AP[a]; AS_[a] = slot; ST[slot] = (int)(a / TOPK); SLS[slot] = HS[a / TOPK]; }
    if (bid == 0) for (int e = 0; e < NE; ++e) { const int cnt = (int)CNT[e], pad = ((cnt + 255) / 256) * 256; for (int i = cnt + tid; i < pad; i += NTHR_) { ST[PS[e] + i] = 0; SLS[PS[e] + i] = 0.f; } }
    __syncthreads();
}

constexpr int NWAVES = 8, NTHR = NWAVES * 64;
constexpr int RING_BYTES = 131072, MISC_OFF = 147200, LDS_BYTES = 147456;

struct Args { Ctx c; };
__global__ void __launch_bounds__(NTHR, 2) fwd_kernel(Args args) {
    extern __shared__ __attribute__((aligned(16))) unsigned char lds_raw[];
    LAS unsigned char* lds = (LAS unsigned char*)lds_raw;
    volatile LAS unsigned* MISC = (volatile LAS unsigned*)(lds + MISC_OFF);
    const int wave0_ = __builtin_amdgcn_readfirstlane((int)threadIdx.x >> 6);
    for (int u = threadIdx.x; u < (LDS_BYTES - MISC_OFF) / 4; u += NTHR) ((LAS unsigned*)(lds + MISC_OFF))[u] = 0u;
    __syncthreads();
    unsigned* ctl = (unsigned*)(args.c.ws + WS_CTL);
    const bool multi = (args.c.ph_hi - args.c.ph_lo) > 1;
    XcdBarrier bar; bar.bar = ctl + CW_BAR; bar.x = 0; bar.st = nullptr;
    if (multi) bar = xcd_barrier_post(ctl + CW_BAR, MISC + 8);
    const int lo = args.c.ph_lo, hi = args.c.ph_hi;
#ifndef PH_MASK
#define PH_MASK 0xFFFFFFFFu
#endif
#define PHEN(j) (((PH_MASK) >> (j)) & 1u)
#define IN(k) (lo <= (k) && (k) < hi)
#define SEAM(k) do { if (IN(k) && IN((k) + 1)) { XcdBarrier bq_ = bar; asm volatile("" : "+s"(bq_.bar)); xcd_barrier(bq_, wave0_ * 64 + (int)__builtin_amdgcn_mbcnt_hi(~0u, __builtin_amdgcn_mbcnt_lo(~0u, 0u))); } } while (0)
#define LOADCTX() Ctx c; { int z_ = 0; asm volatile("" : "+s"(z_)); _Pragma("unroll") for (int i_ = 0; i_ < N_INPUTS; ++i_) c.in[i_] = args.c.in[i_ + z_]; c.out = args.c.out; { size_t zo_ = 0; asm volatile("" : "+s"(zo_)); c.ws = args.c.ws + zo_; } c.ph_lo = 0; c.ph_hi = 0; } int tid = wave0_ * 64 + (int)__builtin_amdgcn_mbcnt_hi(~0u, __builtin_amdgcn_mbcnt_lo(~0u, 0u)); asm volatile("" : "+v"(tid)); int bid = blockIdx.x, G = gridDim.x; asm volatile("" : "+s"(bid), "+s"(G)); const long gstride = (long)G * NTHR; const long gt = (long)bid * NTHR + tid; const int lane = tid & 63, wave = __builtin_amdgcn_readfirstlane(tid >> 6); (void)lane; (void)wave;

    if (PHEN(15) && IN(0)) for (int rep_ = 0; rep_ <= (int)((REP_MASK >> 15) & 1u); ++rep_) { if (rep_) __syncthreads(); LOADCTX();
        ph_pre0(c, gt, gstride); ph_s5tab(c, gt, gstride); ph_wr(c, gt, gstride); ph_zt(c, gt, gstride);
        LAS float* scr = (LAS float*)(lds + wave * 16384);
        const int gw = bid * NWAVES + wave, ngw = G * NWAVES;
        { constexpr int IB = (DH / 64) * (D / 32), IO = (D / 64) * (D / 32), IG = (DH / 64) * (512 / 32), IL = 3 * IB + IO + IG;
          for (int it = gw; it < DEPTH * IL; it += ngw) { const int l = it / IL; int r = it % IL;
              if (r < 3 * IB) { const int br = r / IB; const float* wsrc = br == 0 ? c.in[I_WBHY] : (br == 1 ? c.in[I_WBS5] : c.in[I_WBML]); wconv_item<0>(wsrc + (size_t)l * DH * D, DH, D, D, wsp<bf16>(c, WS_WBR) + ((size_t)l * 3 + br) * D * DH, scr, r % IB, lane, 0); continue; } r -= 3 * IB;
              if (r < IO) { wconv_item<0>(c.in[I_WOUT] + (size_t)l * D * D, D, D, D, wsp<bf16>(c, WS_WOUT) + (size_t)l * D * D, scr, r, lane, 0); continue; } r -= IO;
              wconv_item<3>(c.in[I_GLU] + (size_t)l * DH * DH, DH, DH, 512, wsp<bf16>(c, WS_GLU) + (size_t)l * 512 * DH, scr, r, lane, DH); } }
        wmax_part(c, bid, G, tid); w1max_part(c, 0, 0, bid, G, tid); w1max_part(c, 0, 16, bid, G, tid);
    }
    SEAM(0);
    if (PHEN(16) && IN(1)) for (int rep_ = 0; rep_ <= (int)((REP_MASK >> 16) & 1u); ++rep_) { if (rep_) __syncthreads(); LOADCTX(); modp_fast(c, lds, tid, G, bid); ph_hd1(c, gt, gstride); ph_s5pow(c, gt, gstride); s5gen1_fast(c, tid, G, bid);
        { constexpr int IW = (D / 64) * (NP / 32); LAS float* scr = (LAS float*)(lds + wave * 16384); const int gw = bid * NWAVES + wave, ngw = G * NWAVES;
          for (int it = gw; it < DEPTH * IW; it += ngw) { const int l = it / IW;
              wconv_item_q8<1>(c.in[I_WIN] + (size_t)l * D * NIN, D, NIN, NP, wsp<signed char>(c, WS_WIN) + (size_t)l * NP * D, wsp<float>(c, WS_CTL) + CW_WMX + (size_t)l * NP, scr, it % IW, lane); } } }
    SEAM(1);
    if (PHEN(17) && IN(2)) for (int rep_ = 0; rep_ <= (int)((REP_MASK >> 17) & 1u); ++rep_) { if (rep_) __syncthreads(); LOADCTX(); ph_modf(c, gt, gstride); ph_hd2(c, gt, gstride); ph_s5gen2(c, gt, gstride); }
    SEAM(2);
    if (PHEN(18) && IN(3)) for (int rep_ = 0; rep_ <= (int)((REP_MASK >> 18) & 1u); ++rep_) { if (rep_) __syncthreads(); LOADCTX(); hyf2_mfma(c, tid, G, bid); }
    SEAM(3);
    if (PHEN(18) && IN(4)) for (int rep_ = 0; rep_ <= (int)((REP_MASK >> 18) & 1u); ++rep_) { if (rep_) __syncthreads(); LOADCTX(); rk_build(c, lds, tid, G, bid); }
    SEAM(4);

#define MOE_LTAB() do { const int* tb_ = wsp<int>(c, WS_TAB) + 32; for (int i_ = tid; i_ < 704; i_ += NTHR) ((LAS int*)(lds + 132096))[i_] = tb_[i_]; __syncthreads(); } while (0)
#define LAYER_BODY(l) { \
        const int pb = NPRO + l * NLP; const int MR = (l == DEPTH - 1) ? NTL : NT;     \
        if (PHEN(0) && IN(pb + 0)) { LOADCTX(); if (l == 0) norm_rows<0, false, true>(c, l, 0, lds, tid, G, bid); else norm_rows<0, true>(c, l, l - 1, lds, tid, G, bid); } \
        SEAM(pb + 0); \
        if (PHEN(1) && IN(pb + 1)) for (int rep_ = 0; rep_ <= (int)((REP_MASK >> 1) & 1u); ++rep_) { if (rep_) __syncthreads(); LOADCTX(); \
            const pg8::Gemm g = pg8::make_gemm(wsp<bf16>(c, WS_H), wsp<bf16>(c, WS_WIN) + (size_t)l * NP * D / 2, NT, NP, D / 2); pg8::StaticOrder S; S.init(NT, NP, G, bid);     \
            pg8::EpiStoreQ8 E{wsp<bf16>(c, WS_P), NP, wsp<float>(c, WS_HS), wsp<float>(c, WS_CTL) + CW_WMX + (size_t)l * NP}; \
            pg8::gemm_phase<pg8::EpiStoreQ8, pg8::StaticOrder, true, true, true>(lds, g, S, E, tid); \
            if (G == 256 && bid >= 16) { moe_wconv(c, l, (LAS float*)(lds + wave * 16384), 0, MOE_WS0, (bid - 16) * NWAVES + wave, 240 * NWAVES, lane); __syncthreads(); } \
        } \
        SEAM(pb + 1); \
        if (PHEN(2) && IN(pb + 2)) for (int rep_ = 0; rep_ <= (int)((REP_MASK >> 2) & 1u); ++rep_) { if (rep_) __syncthreads(); \
            { LOADCTX(); hy_prep(c, l, lds, tid, G, bid); } \
            { LOADCTX(); ml_prep(c, l, tid, G, bid); } \
            { LOADCTX(); pg8::Gemm g = pg8::make_gemm(wsp<bf16>(c, WS_P) + PC_S5, wsp<bf16>(c, WS_BT1) + (size_t)l * S5G * 768 * 512, S5RP, 768, 512); \
              g.a_row = S5T * NP * 2; g.a_kstep = 4 * NP * 2; g.a_sub = NP * 2; g.a_grp = S5N * 2; g.a_mode = 1; \
              pg8::S5Order S{3, G, (bid + 152) % G}; pg8::EpiS5a E{wsp<float>(c, WS_YS5), wsp<float>(c, WS_SLOC)}; \
              pg8::gemm_phase<pg8::EpiS5a, pg8::S5Order, true, true>(lds, g, S, E, tid); } \
        } \
        SEAM(pb + 2); \
        if (PHEN(3) && IN(pb + 3)) for (int rep_ = 0; rep_ <= (int)((REP_MASK >> 3) & 1u); ++rep_) { if (rep_) __syncthreads(); \
            for (int r2_ = 0; r2_ <= (int)((REP_MASK >> 21) & 1u); ++r2_) { LOADCTX(); for (int u = bid; u < 256; u += G) ml_chain(c, l, lds, tid, u); } \
            for (int r2_ = 0; r2_ <= (int)((REP_MASK >> 22) & 1u); ++r2_) { LOADCTX(); hy_conv(c, l, lds, tid, G, bid); } \
            { LOADCTX(); if (G == 256 && bid >= 128) { moe_wconv(c, l, (LAS float*)(lds + wave * 16384), MOE_WS0, MOE_WS1, (bid - 128) * NWAVES + wave, 128 * NWAVES, lane); __syncthreads(); } } \
            { LOADCTX(); if (G == 256) { if (bid >= 128) ph_s5cscan(c, l, (long)(bid - 128) * NTHR + tid, 128L * NTHR); } else ph_s5cscan(c, l, gt, gstride); } } \
        SEAM(pb + 3); \
        if (PHEN(4) && IN(pb + 4)) for (int rep_ = 0; rep_ <= (int)((REP_MASK >> 4) & 1u); ++rep_) { if (rep_) __syncthreads(); { LOADCTX(); hy_post(c, lds, tid, G, bid); } \
            { LOADCTX(); pg8::Gemm g = pg8::make_gemm(wsp<bf16>(c, WS_XIN), wsp<bf16>(c, WS_BT2) + (size_t)l * S5G * 512 * 256, S5RP, 512, 256); \
              g.a_grp = S5RP * 256 * 2; \
              pg8::S5Order S{2, G, bid}; pg8::EpiS5b E{wsp<float>(c, WS_YS5), wsp<bf16>(c, WS_G)}; \
              pg8::gemm_phase<pg8::EpiS5b, pg8::S5Order, true, true>(lds, g, S, E, tid); } \
            { LOADCTX(); ml_headout(c, l, tid, G, bid); } } \
        SEAM(pb + 4); \
        if (PHEN(5) && IN(pb + 5)) for (int rep_ = 0; rep_ <= (int)((REP_MASK >> 5) & 1u); ++rep_) { if (rep_) __syncthreads(); \
            { LOADCTX(); const pg8::Gemm g = pg8::make_gemm(wsp<bf16>(c, WS_G), wsp<bf16>(c, WS_GLU) + (size_t)l * 512 * DH, MR, 512, DH); pg8::StaticOrder S; if (G == 256 && MR == NT) S.init(MR, 512, 192, bid >= 64 ? bid - 64 : (1 << 20)); else S.init(MR, 512, G, bid);     \
              pg8::EpiGlu E{wsp<bf16>(c, WS_G), wsp<bf16>(c, WS_S5O)}; \
              pg8::gemm_phase<pg8::EpiGlu, pg8::StaticOrder, true, true>(lds, g, S, E, tid); \
              split_arrive(wsp<unsigned>(c, WS_CTL) + CW_GLU + (l), tid); } \
            { LOADCTX(); pg8::StaticOrder S; S.init(MR, D, G, bid); const bf16* wbr = wsp<bf16>(c, WS_WBR) + (size_t)l * 3 * D * DH; \
              { const pg8::Gemm g = pg8::make_gemm(wsp<bf16>(c, WS_HY), wbr, NT, D, DH); pg8::EpiBr<0> E{wsp<bf16>(c, WS_P), PC_MG, wsp<float>(c, WS_YF), wsp<bf16>(c, WS_YB)}; \
                pg8::gemm_phase<pg8::EpiBr<0>, pg8::StaticOrder, true, true>(lds, g, S, E, tid); } \
              { const pg8::Gemm g = pg8::make_gemm(wsp<bf16>(c, WS_MLO), wbr + (size_t)2 * D * DH, NT, D, DH); pg8::EpiBr<1> E{wsp<bf16>(c, WS_P), PC_MG + 2 * D, wsp<float>(c, WS_YF), wsp<bf16>(c, WS_YB)}; \
                pg8::gemm_phase<pg8::EpiBr<1>, pg8::StaticOrder, true, true>(lds, g, S, E, tid); } \
              split_wait(wsp<unsigned>(c, WS_CTL) + CW_GLU + (l), (unsigned)G, tid);     \
              { const pg8::Gemm g = pg8::make_gemm(wsp<bf16>(c, WS_S5O), wbr + (size_t)D * DH, NT, D, DH); pg8::EpiBr<2> E{wsp<bf16>(c, WS_P), PC_MG + D, wsp<float>(c, WS_YF), wsp<bf16>(c, WS_YB)}; \
                pg8::gemm_phase<pg8::EpiBr<2>, pg8::StaticOrder, true, true>(lds, g, S, E, tid); } \
              if (G == 256 && MR == NT && bid >= 64) { moe_wconv(c, l, (LAS float*)(lds + wave * 16384), MOE_WS1, MOE_WS2, (bid - 64) * NWAVES + wave, 192 * NWAVES, lane); __syncthreads(); } } \
        } \
        SEAM(pb + 5); \
        if (PHEN(7) && IN(pb + 7)) { LOADCTX(); \
            const pg8::Gemm g = pg8::make_gemm(wsp<bf16>(c, WS_YB), wsp<bf16>(c, WS_WOUT) + (size_t)l * D * D, NT, D, D); pg8::StaticOrder S; S.init(MR, D, G, bid); \
            pg8::EpiOut<(l) == 0> E{wsp<bf16>(c, WS_X), wsp<float>(c, WS_MOD) + (size_t)l * NMOD * 6144, c.in[I_X], c.in[I_CTX]}; \
            pg8::gemm_phase<pg8::EpiOut<(l) == 0>, pg8::StaticOrder, true, true>(lds, g, S, E, tid); \
            if (G == 256 && MR == NT && bid >= 64) { moe_wconv(c, l, (LAS float*)(lds + wave * 16384), MOE_WS2, MOE_WS3, (bid - 64) * NWAVES + wave, 192 * NWAVES, lane); __syncthreads(); } \
        } \
        SEAM(pb + 7); \
        if (PHEN(8) && IN(pb + 8)) { LOADCTX(); \
            norm_rows<1, false>(c, l, 0, lds, tid, G, bid, MR); \
            LAS float* scr = (LAS float*)(lds + wave * 16384); \
            const int gw = bid * NWAVES + wave, ngw = G * NWAVES; \
            for (int rep_ = 0; rep_ <= (int)((REP_MASK >> 14) & 1u); ++rep_) moe_wconv(c, l, scr, (G == 256 ? (MR == NT ? MOE_WS3 : MOE_WS1) : 0), MOE_WITEMS, gw, ngw, lane); \
        } \
        SEAM(pb + 8); \
        if (PHEN(9) && IN(pb + 9)) for (int rep_ = 0; rep_ <= (int)((REP_MASK >> 9) & 1u); ++rep_) { if (rep_) __syncthreads(); LOADCTX(); moe_dispatch(c, l, lds, tid, G, bid, MR); } \
        SEAM(pb + 9); \
        if (PHEN(10) && IN(pb + 10)) for (int rep_ = 0; rep_ <= (int)((REP_MASK >> 10) & 1u); ++rep_) { if (rep_) __syncthreads(); LOADCTX(); \
            pg8::Gemm g = pg8::make_gemm(wsp<bf16>(c, WS_H), wsp<bf16>(c, WS_W1T), NSLOT, 1024, D / 2); g.a_gather = wsp<int>(c, WS_SLTOK);     MOE_LTAB(); pg8::MoeOrderT<true> S{(const LAS int*)(lds + 132096), 4, G, bid}; \
            pg8::EpiMoe1Q8 E{wsp<bf16>(c, WS_ACT), c.in[I_B1] + (size_t)l * NE * 1024, wsp<float>(c, WS_SLS), wsp<float>(c, WS_CTL) + CW_W1MX + (size_t)l * NE * 1024}; \
            pg8::gemm_phase<pg8::EpiMoe1Q8, pg8::MoeOrderT<true>, true, true, true>(lds, g, S, E, tid); \
            if ((l) < DEPTH - 1) w1max_tail(c, (l) + 1, 0, lds, tid, G, bid); \
        } \
        SEAM(pb + 10); \
        if (PHEN(11) && IN(pb + 11)) for (int rep_ = 0; rep_ <= (int)((REP_MASK >> 13) & 1u); ++rep_) { if (rep_) __syncthreads(); LOADCTX(); \
            const pg8::Gemm g = pg8::make_gemm(wsp<bf16>(c, WS_ACT), wsp<bf16>(c, WS_W2T), NSLOT, D, FF); MOE_LTAB(); pg8::MoeOrderT<false> S{(const LAS int*)(lds + 132096), 4, G, bid}; \
            pg8::EpiMoe2 E{wsp<unsigned char>(c, WS_OUTS), wsp<float>(c, WS_OUTSC), c.in[I_B2] + (size_t)l * NE * D}; \
            pg8::gemm_phase<pg8::EpiMoe2, pg8::MoeOrderT<false>, true, true>(lds, g, S, E, tid); \
            if ((l) < DEPTH - 1) w1max_tail(c, (l) + 1, 16, lds, tid, G, bid); \
        } \
        SEAM(pb + 11); \
    }
    LAYER_BODY(0) LAYER_BODY(1) LAYER_BODY(2) LAYER_BODY(3)
    static_assert(DEPTH == 4, "layer bodies written out four times");
    static_assert(MOE_WS3 == MOE_WITEMS, "conversion shares cover every item");
    if (PHEN(19) && IN(NPHASE - 1)) { LOADCTX(); norm_rows<2, true>(c, 0, DEPTH - 1, lds, tid, G, bid); }
#undef IN
#undef SEAM
}

#ifndef N_LAUNCH_MODE
#define N_LAUNCH_MODE 1
#endif
extern "C" void kernel_launch(void* const* d_in, const int* in_sizes, int n_in, void* d_out, int out_size, void* d_ws, size_t ws_size, hipStream_t stream) {
    static int grid = 0;
    if (grid == 0) {
        if (n_in != N_INPUTS || out_size != NTL * D || ws_size < WS_END) { fprintf(stderr, "kernel_launch: shape/workspace mismatch: n_in %d out %d ws %zu (need %zu)\n", n_in, out_size, ws_size, (size_t)WS_END); grid = -1; return; }
        int dev = 0, cus = 0, per_cu = 0;
        if (hipGetDevice(&dev) != hipSuccess || hipDeviceGetAttribute(&cus, hipDeviceAttributeMultiprocessorCount, dev) != hipSuccess) { grid = -1; return; }
        if (hipFuncSetAttribute((const void*)fwd_kernel, hipFuncAttributeMaxDynamicSharedMemorySize, LDS_BYTES) != hipSuccess) { fprintf(stderr, "kernel_launch: hipFuncSetAttribute failed\n"); grid = -1; return; }
        if (hipOccupancyMaxActiveBlocksPerMultiprocessor(&per_cu, (const void*)fwd_kernel, NTHR, LDS_BYTES) != hipSuccess || per_cu < 1) { fprintf(stderr, "kernel_launch: occupancy query says %d\n", per_cu); }
        (void)hipGetLastError();
        grid = cus;
    }
    if (grid < 0) return;
    if (hipMemsetAsync((char*)d_ws + WS_CTL, 0, CTL_BYTES, stream) != hipSuccess) return;
    Args a; std::memset((void*)&a, 0, sizeof(a));
    for (int i = 0; i < N_INPUTS; ++i) a.c.in[i] = (const float*)d_in[i];
    a.c.out = (float*)d_out; a.c.ws = (unsigned char*)d_ws;
    if (N_LAUNCH_MODE == 1) {
        a.c.ph_lo = 0; a.c.ph_hi = NPHASE;
        hipLaunchKernelGGL(fwd_kernel, dim3(grid), dim3(NTHR), LDS_BYTES, stream, a);
    } else {
        for (int p = 0; p < NPHASE; ++p) { a.c.ph_lo = p; a.c.ph_hi = p + 1; hipLaunchKernelGGL(fwd_kernel, dim3(grid), dim3(NTHR), LDS_BYTES, stream, a); }
    }
}
#endif
```

```cpp
#ifdef HOST_TEST
#include <cmath>
#include <cstdio>
#include <cstdlib>
#include <cstring>
#include <cstdint>
#define HD inline
#else
#include <hip/hip_runtime.h>
#include <cstdio>
#include <cstdint>
#include <cstring>
#define HD __host__ __device__ __forceinline__
#endif

#ifndef CFG_BATCH
#define CFG_BATCH 16
#endif
#ifndef CFG_SEQ
#define CFG_SEQ 2048
#endif
#ifndef CFG_CTX
#define CFG_CTX 256
#endif
#ifndef CFG_DEPTH
#define CFG_DEPTH 4
#endif

#ifndef REP_MASK
#define REP_MASK 0u
#endif
typedef unsigned short bf16;
constexpr int D = 1024, NB = CFG_BATCH, SEQ = CFG_SEQ, CTXL = CFG_CTX, DEPTH = CFG_DEPTH, GRIDW = 64;
constexpr int NTL = NB * SEQ, NTC = NB * CTXL, NT = NTL + NTC, NMOD = NB + 1;
constexpr int DH = 384, NPOS = SEQ + CTXL;
constexpr int NP = 6400;
constexpr int PC_S5 = 0, PC_Q = 384, PC_K = 768, PC_V = 1152, PC_HY = 1536, PC_O = 2688, PC_MG = 3072, PC_GT = 6144;
constexpr int NIN = 6160;
constexpr int S5G = 24, S5P = 64, S5N = 16;
constexpr int MLH = 4, MLD = 96;
constexpr int NE = 32, TOPK = 4, FF = 512;
constexpr int NSLOT = ((NT * TOPK + 255) / 256 + NE) * 256;
constexpr float EPS = 1e-6f;

HD int win_src_col(int n) { return n < 1536 ? n : (n < 6144 ? n + 16 : (n < 6160 ? n - 6144 + 1536 : -1)); }
HD int w1_src_col(int n) { const int pn = n >> 8, bj = (n >> 7) & 1, wc = (n >> 5) & 3, nn = (n >> 4) & 1, fq = (n >> 2) & 3, i = n & 3; return 2 * (128 * pn + 32 * wc + 8 * fq + 4 * bj + i) + nn; }

enum { I_X, I_C, I_CTX, I_CCTX, I_ADAW, I_ADAB, I_N1G, I_N2G, I_FNG, I_WIN, I_HYCW, I_HYCB, I_HW1, I_HB1, I_HW2, I_HB2, I_HW3, I_HB3, I_HSF, I_HBIAS,
       I_LRE, I_LIM, I_LDT, I_BRE, I_BIM, I_CRE, I_CIM, I_S5D, I_GLU, I_MLCW, I_MLCB, I_MLGB, I_MLNG, I_WBHY, I_WBS5, I_WBML, I_WOUT,
       I_RW, I_RB, I_W1, I_B1, I_W2, I_B2, N_INPUTS };

constexpr size_t al256(size_t x) { return (x + 255) & ~(size_t)255; }
constexpr size_t WS_CTL = 0, CTL_BYTES = 1u << 20;
constexpr int CW_CNT = 64;
constexpr int CW_W1MX = 131072;
constexpr int CW_WMX = 65536;
constexpr int CW_BAR = 4096;
constexpr size_t WS_MOD = CTL_BYTES;
constexpr size_t WS_SILU = WS_MOD + al256((size_t)DEPTH * NMOD * 6144 * 4);
constexpr size_t WS_HD2 = WS_SILU + al256((size_t)NMOD * D * 4);
constexpr size_t WS_HF = WS_HD2 + al256((size_t)DEPTH * NPOS * 64 * 4);
constexpr size_t WS_NRM = WS_HF + al256((size_t)DEPTH * NPOS * 1536 * 4);
constexpr size_t WS_WIN = WS_NRM + al256((size_t)DEPTH * 2 * 2 * DH * 4);
constexpr size_t WS_WBR = WS_WIN + al256((size_t)DEPTH * NP * D * 2);
constexpr size_t WS_WOUT = WS_WBR + al256((size_t)DEPTH * 3 * D * DH * 2);
constexpr size_t WS_GLU = WS_WOUT + al256((size_t)DEPTH * D * D * 2);
constexpr size_t WS_W1T = WS_GLU + al256((size_t)DEPTH * 512 * DH * 2);
constexpr size_t WS_W2T = WS_W1T + al256((size_t)NE * D * D * 2);
constexpr size_t WS_X = WS_W2T + al256((size_t)NE * D * FF * 2);
constexpr size_t WS_H = WS_X + al256((size_t)NT * D * 4);
constexpr size_t WS_HY = WS_H + al256((size_t)NT * D * 2);
constexpr size_t WS_S5O = WS_HY + al256((size_t)NT * DH * 2);
constexpr size_t WS_MLO = WS_S5O + al256((size_t)NT * DH * 2);
constexpr size_t WS_ASGE = WS_MLO + al256((size_t)NT * DH * 2);
constexpr size_t WS_ASGP = WS_ASGE + al256((size_t)NT * 4 * 4);
constexpr size_t WS_ASGS = WS_ASGP + al256((size_t)NT * 4 * 4);
constexpr size_t WS_ASGW = WS_ASGS + al256((size_t)NT * 4 * 4);
constexpr size_t WS_TAB = WS_ASGW + al256((size_t)NT * 4 * 4);
constexpr size_t WS_SLTOK = WS_TAB + al256(4096 * 4);
constexpr size_t WS_RA = WS_SLTOK + al256((size_t)NSLOT * 4);
constexpr size_t WS_P = WS_RA;
constexpr size_t WS_RB = WS_P + al256((size_t)NT * NP * 2);
constexpr size_t WS_HYC = WS_RB;
constexpr size_t WS_Z1 = WS_HYC + al256((size_t)NT * 1152 * 2);
constexpr size_t WS_QKC = WS_Z1 + al256((size_t)NT * DH * 4);
constexpr size_t WS_GI = WS_QKC + al256((size_t)NT * 768 * 4);
constexpr size_t WS_GF = WS_GI + al256((size_t)2 * NT * 4 * 4);
constexpr size_t WS_CF = WS_GF + al256((size_t)2 * NT * 4 * 4);
constexpr size_t WS_HFB = WS_CF + al256((size_t)2 * NT * 4 * 4);
constexpr size_t WS_YS5 = WS_HFB + al256((size_t)2 * NT * DH * 4);
constexpr size_t WS_G = WS_YS5 + al256((size_t)NT * DH * 4);
constexpr size_t WS_XS = WS_G + al256((size_t)NT * DH * 2);
constexpr size_t WS_YF = WS_XS;
constexpr size_t WS_YB = WS_YF + al256((size_t)NT * D * 4);
constexpr size_t WS_END1 = WS_XS + al256((size_t)NT * S5G * S5P * 8);
constexpr size_t WS_AS = WS_RA;
constexpr size_t WS_ACT = WS_AS + al256((size_t)NSLOT * D * 2);
constexpr size_t WS_OUTS = WS_ACT + al256((size_t)NSLOT * FF * 2);
constexpr size_t WS_OUTSC = WS_OUTS + al256((size_t)NSLOT * D);
constexpr size_t WS_END2 = WS_OUTS + al256((size_t)NSLOT * D * 2);
constexpr size_t WS_END12 = WS_END1 > WS_END2 ? WS_END1 : WS_END2;
constexpr int RKP0 = 2 * SEQ + 24, RKP1 = 2 * CTXL + 24;
constexpr size_t WS_RK0 = WS_END12;
constexpr size_t WS_RK1 = WS_RK0 + al256((size_t)DEPTH * 2 * DH * 2 * RKP0 * 2);
constexpr size_t WS_S5TAB = WS_RK1 + al256((size_t)DEPTH * 2 * DH * 2 * RKP1 * 2);
constexpr size_t WS_KD = WS_S5TAB + al256((size_t)DEPTH * 2 * S5G * S5P * 16);
constexpr size_t WS_BT1 = WS_KD + al256((size_t)DEPTH * S5G * 2 * 32 * 256 * 4);
constexpr size_t WS_BT2 = WS_BT1 + al256((size_t)DEPTH * S5G * 768 * 512 * 2);
constexpr size_t WS_WRH = WS_BT2 + al256((size_t)DEPTH * S5G * 512 * 256 * 2);
constexpr size_t WS_WRL = WS_WRH + al256((size_t)DEPTH * NE * D * 2);
constexpr size_t WS_MODP = WS_WRL + al256((size_t)DEPTH * NE * D * 2);
constexpr size_t WS_HD1 = WS_MODP + al256((size_t)16 * DEPTH * NMOD * 6144 * 4);
constexpr size_t WS_POWT = WS_HD1 + al256((size_t)DEPTH * NPOS * 64 * 4);
constexpr int RKT_LAT = SEQ / 64, RKT_CTX = CTXL / 64;
constexpr size_t WS_NRMP = WS_POWT + al256((size_t)DEPTH * 2 * S5G * S5P * 33 * 8);
constexpr size_t WS_ZT = WS_NRMP + al256((size_t)DEPTH * 2 * 2 * DH * 64 * 4);
constexpr size_t WS_HS = WS_ZT + al256((size_t)NPOS * 33 * 4);
constexpr size_t WS_WSC = WS_HS + al256((size_t)NT * 4);
constexpr size_t WS_W1S = WS_WSC + al256((size_t)DEPTH * NP * 4);
constexpr size_t WS_SLS = WS_W1S + al256((size_t)DEPTH * NE * 1024 * 4);
constexpr size_t WS_END = WS_SLS + al256((size_t)NSLOT * 4);
constexpr int S5T = 32, S5R = NT / S5T, S5RP = ((S5R + 255) / 256) * 256;
constexpr size_t WS_SLOC = WS_YB + al256((size_t)NT * D * 2);
constexpr size_t WS_XIN = WS_SLOC + al256((size_t)S5G * S5RP * 256 * 4);
static_assert(WS_XIN + (size_t)S5G * S5RP * 256 * 2 <= WS_END1, "S5 chunk buffers inside the old XS region");
constexpr size_t WS_VT = WS_HYC, WS_X1T = WS_VT + (size_t)DH * NB * NPOS * 2, WS_X2T = WS_X1T + (size_t)DH * NB * NPOS * 2;
constexpr size_t WS_Z1T = WS_Z1, WS_HYT = WS_Z1T + (size_t)DH * NB * NPOS * 2;
static_assert(WS_X2T + (size_t)DH * NB * NPOS * 2 <= WS_Z1 && WS_HYT + (size_t)DH * NB * NPOS * 2 <= WS_QKC, "hyena channel-major buffers");
static_assert(WS_YB + (size_t)NT * D * 2 <= WS_END1, "YF/YB inside XS");

struct Ctx {
    const float* in[N_INPUTS];
    float* out;
    unsigned char* ws;
    int ph_lo, ph_hi;
};
template <class T> HD T* wsp(const Ctx& c, size_t off) { return (T*)(c.ws + off); }

HD unsigned f2bf_bits(float f) { unsigned u; __builtin_memcpy(&u, &f, 4); return (u + 0x7fffu + ((u >> 16) & 1u)) >> 16; }
HD bf16 f2bf(float f) { return (bf16)f2bf_bits(f); }
HD float bf2f(bf16 b) { unsigned u = ((unsigned)b) << 16; float f; __builtin_memcpy(&f, &u, 4); return f; }
HD float sigm(float x) { return 1.0f / (1.0f + expf(-x)); }
HD float siluf(float x) { return x * sigm(x); }
HD float logsig(float x) { return x >= 0.f ? -log1pf(expf(-x)) : x - log1pf(expf(x)); }
HD float gelu_t(float x) { return 0.5f * x * (1.0f + tanhf(0.7978845608028654f * (x + 0.044715f * x * x * x))); }
HD void tokinfo(int r, int& b, int& t, int& L, int& base, int& mb) {
    if (r < NTL) { b = r / SEQ; t = r % SEQ; L = SEQ; base = b * SEQ; mb = b; }
    else { const int q = r - NTL; b = q / CTXL; t = q % CTXL; L = CTXL; base = NTL + b * CTXL; mb = NB; }
}
HD bool has_prev(int r) { if (r < NTL) return (r % GRIDW) != 0; return ((r - NTL) % CTXL) != 0; }
HD bool has_next(int r) { if (r < NTL) return (r % GRIDW) != GRIDW - 1; return ((r - NTL) % CTXL) != CTXL - 1; }
HD int seq_tok(int d, int b, int tau) {
    if (tau < CTXL) return NTL + b * CTXL + (d ? CTXL - 1 - tau : tau);
    const int t = tau - CTXL; return b * SEQ + (d ? SEQ - 1 - t : t);
}
HD int tok_tau(int d, int r) {
    if (r < NTL) { const int t = r % SEQ; return CTXL + (d ? SEQ - 1 - t : t); }
    const int t = (r - NTL) % CTXL; return d ? CTXL - 1 - t : t;
}

#define GS_LOOP(it, n) for (long it = gtid; it < (long)(n); it += gstride)

HD void ph_pre0(const Ctx& c, long gtid, long gstride) {
    float* SL = wsp<float>(c, WS_SILU);
    GS_LOOP(i, NMOD * D) { const int mb = (int)(i / D), k = (int)(i % D); const float v = mb < NB ? c.in[I_C][mb * D + k] : c.in[I_CCTX][k]; SL[i] = siluf(v); }
}
HD void ph_wmax(const Ctx& c, long gtid, long gstride) {
    float* WSC = wsp<float>(c, WS_WSC);
    GS_LOOP(it, DEPTH * NP) { const int n = (int)(it % NP), l = (int)(it / NP), sc = win_src_col(n); float mx = 0.f;
        if (sc >= 0) { const float* w = c.in[I_WIN] + (size_t)l * D * NIN + sc;
            for (int k0 = 0; k0 < D; k0 += 16) { float v[16];
#pragma unroll
                for (int u = 0; u < 16; ++u) v[u] = w[(size_t)(k0 + u) * NIN];
#pragma unroll
                for (int u = 0; u < 16; ++u) mx = fmaxf(mx, fabsf(v[u])); } }
        WSC[it] = mx > 0.f ? mx * (1.0f / 127.0f) : 1.0f; }
}
HD void ph_w1max(const Ctx& c, long gtid, long gstride) {
    float* W1S = wsp<float>(c, WS_W1S);
    GS_LOOP(it, DEPTH * NE * 1024) { const int n = (int)(it % 1024); const long le = it / 1024; const float* w = c.in[I_W1] + (size_t)le * D * 1024 + n; float mx = 0.f;
        for (int k0 = 0; k0 < D; k0 += 16) { float v[16];
#pragma unroll
            for (int u = 0; u < 16; ++u) v[u] = w[(size_t)(k0 + u) * 1024];
#pragma unroll
            for (int u = 0; u < 16; ++u) mx = fmaxf(mx, fabsf(v[u])); }
        W1S[it] = mx > 0.f ? mx * (1.0f / 127.0f) : 1.0f; }
}
HD void ph_modp(const Ctx& c, long gtid, long gstride) {
    const float* SL = wsp<float>(c, WS_SILU); float* MP = wsp<float>(c, WS_MODP);
    GS_LOOP(it, 8 * DEPTH * 6144) { const int col = (int)(it % 6144), l = (int)((it / 6144) % DEPTH), ks = (int)(it / (6144 * DEPTH));
        float acc[NMOD];
#pragma unroll
        for (int m = 0; m < NMOD; ++m) acc[m] = 0.f;
        const float* w = c.in[I_ADAW] + ((size_t)l * D + ks * 128) * 6144 + col;
        for (int k = 0; k < 128; ++k) { const float wv = w[(size_t)k * 6144];
#pragma unroll
            for (int m = 0; m < NMOD; ++m) acc[m] += SL[m * D + ks * 128 + k] * wv; }
#pragma unroll
        for (int m = 0; m < NMOD; ++m) MP[(((size_t)ks * DEPTH + l) * NMOD + m) * 6144 + col] = acc[m]; }
}
HD void ph_modf(const Ctx& c, long gtid, long gstride) {
    const float* MP = wsp<float>(c, WS_MODP); float* MOD = wsp<float>(c, WS_MOD);
    GS_LOOP(it, DEPTH * NMOD * 6144) { const int col = (int)(it % 6144), l = (int)(it / ((long)NMOD * 6144)); float v = c.in[I_ADAB][l * 6144 + col];
#pragma unroll
        for (int ks = 0; ks < 16; ++ks) v += MP[(size_t)ks * DEPTH * NMOD * 6144 + it];
        MOD[it] = v; }
}
HD void ph_zt(const Ctx& c, long gtid, long gstride) {
    float* ZT = wsp<float>(c, WS_ZT);
    GS_LOOP(it, NPOS * 33) { const int e = (int)(it % 33), pidx = (int)(it / 33); const int L = pidx < SEQ ? SEQ : CTXL, t = pidx < SEQ ? pidx : pidx - SEQ;
        const float w = 6.283185307179586f * (float)t / (float)L; float v;
        if (e == 0) v = (float)t / (float)(L - 1);
        else { const int j = (e - 1) & 15; const float f = 1e-4f + (float)j * ((15.0f - 1e-4f) / 15.0f); v = e <= 16 ? cosf(f * w) : -sinf(f * w); }
        ZT[it] = v; }
}
HD void ph_hd1(const Ctx& c, long gtid, long gstride) {
    float* HD1 = wsp<float>(c, WS_HD1); const float* ZT = wsp<float>(c, WS_ZT);
    GS_LOOP(it, (long)DEPTH * NPOS * 64) { const int k = (int)(it % 64); const long q = it / 64; const int pidx = (int)(q % NPOS), l = (int)(q / NPOS);
        const float* w1 = c.in[I_HW1] + (size_t)l * 33 * 64 + k; const float* z = ZT + pidx * 33; float a1 = c.in[I_HB1][l * 64 + k];
#pragma unroll
        for (int e = 0; e < 33; ++e) a1 += z[e] * w1[e * 64];
        HD1[it] = sinf(c.in[I_HSF][l * 128 + k] * a1); }
}
HD void ph_hd2(const Ctx& c, long gtid, long gstride) {
    const float* HD1 = wsp<float>(c, WS_HD1); float* HD2 = wsp<float>(c, WS_HD2);
    GS_LOOP(it, (long)DEPTH * NPOS * 64) { const int i = (int)(it % 64); const long q = it / 64; const int l = (int)(q / NPOS);
        const float* h = HD1 + q * 64; const float* w2 = c.in[I_HW2] + (size_t)l * 64 * 64 + i; float a2 = c.in[I_HB2][l * 64 + i];
        float wv[64];
#pragma unroll
        for (int k = 0; k < 64; ++k) wv[k] = w2[k * 64];
#pragma unroll
        for (int k = 0; k < 64; ++k) a2 += h[k] * wv[k];
        HD2[it] = sinf(c.in[I_HSF][l * 128 + 64 + i] * a2); }
}
HD void ph_hyf2(const Ctx& c, long gtid, long gstride) {
    const float* HD2 = wsp<float>(c, WS_HD2); float* HF = wsp<float>(c, WS_HF);
    static_assert(NPOS % 4 == 0, "four positions per item");
    GS_LOOP(it, (long)DEPTH * (NPOS / 4) * 1536) { const int j = (int)(it % 1536); const long q4 = it / 1536; const int p4 = (int)(q4 % (NPOS / 4)), l = (int)(q4 / (NPOS / 4));
        const float* w3 = c.in[I_HW3] + (size_t)l * 64 * 1536 + j; float w[64];
#pragma unroll
        for (int i = 0; i < 64; ++i) w[i] = w3[(size_t)i * 1536];
        const float b3 = c.in[I_HB3][l * 1536 + j]; const int ch = j % DH;
        const float dmin = -3.0701134573253940f, dmax = -15.350567286626973f;
        const float delta = fabsf(dmin + (float)ch * ((dmax - dmin) / 383.0f));
#pragma unroll
        for (int u = 0; u < 4; ++u) { const int pidx = p4 * 4 + u; const int L = pidx < SEQ ? SEQ : CTXL, t = pidx < SEQ ? pidx : pidx - SEQ;
            const float* h = HD2 + ((size_t)l * NPOS + pidx) * 64; float a = b3;
#pragma unroll
            for (int i = 0; i < 64; ++i) a += h[i] * w[i];
            HF[((size_t)l * NPOS + pidx) * 1536 + j] = a * expf(-((float)t / (float)(L - 1)) * delta); } }
}
HD float hy_tap(const float* HFl, int pb, int o, int ch, int lag) {
    return lag >= 0 ? HFl[(size_t)(pb + lag) * 1536 + o * 768 + ch] : HFl[(size_t)(pb - lag) * 1536 + o * 768 + DH + ch];
}
HD void ph_s5tab(const Ctx& c, long gtid, long gstride) {
    float* TAB = wsp<float>(c, WS_S5TAB);
    GS_LOOP(it, DEPTH * 2 * S5G * S5P) { const int p = (int)(it % S5P), g = (int)((it / S5P) % S5G), d = (int)((it / (S5P * S5G)) % 2), l = (int)(it / (S5P * S5G * 2));
        const size_t li = ((size_t)(l * 2 + d) * S5G + g) * S5P + p;
        const float lre = c.in[I_LRE][li], lim = c.in[I_LIM][li], dt = expf(c.in[I_LDT][(l * 2 + d) * S5G + g]);
        const float mag = expf(lre * dt), lbr = mag * cosf(lim * dt), lbi = mag * sinf(lim * dt);
        const float nr = lbr - 1.0f, ni = lbi, den = lre * lre + lim * lim;
        TAB[it * 4 + 0] = lre * dt; TAB[it * 4 + 1] = lim * dt; TAB[it * 4 + 2] = (nr * lre + ni * lim) / den; TAB[it * 4 + 3] = (ni * lre - nr * lim) / den; }
}
HD void s5_pow(const float* tab, float e, float& pr, float& pi) { const float mg = expf(e * tab[0]); pr = mg * cosf(e * tab[1]); pi = mg * sinf(e * tab[1]); }
HD void ph_s5pow(const Ctx& c, long gtid, long gstride) {
    const float* TAB = wsp<float>(c, WS_S5TAB); float* PW = wsp<float>(c, WS_POWT);
    GS_LOOP(it, (long)DEPTH * 2 * S5G * S5P * 33) { const int e = (int)(it % 33); const long q = it / 33; float pr, pi; s5_pow(TAB + q * 4, (float)e, pr, pi); PW[it * 2] = pr; PW[it * 2 + 1] = pi; }
}
HD void ph_s5gen1(const Ctx& c, long gtid, long gstride) {
    const float* TAB = wsp<float>(c, WS_S5TAB); float* KD = wsp<float>(c, WS_KD);
    GS_LOOP(it, DEPTH * S5G * 2 * 256) { const int m = (int)(it % 16), n = (int)((it / 16) % 16), d = (int)((it / 256) % 2), g = (int)((it / 512) % S5G), l = (int)(it / (512 * S5G));
        float acc[S5T];
#pragma unroll
        for (int j = 0; j < S5T; ++j) acc[j] = 0.f;
        for (int p0 = 0; p0 < S5P; p0 += 8) { float t0[8], t1[8], t2[8], t3[8], brv[8], biv[8], crv[8], civ[8];
#pragma unroll
            for (int u = 0; u < 8; ++u) { const int p = p0 + u; const float* tb = TAB + ((((size_t)l * 2 + d) * S5G + g) * S5P + p) * 4; t0[u] = tb[0]; t1[u] = tb[1]; t2[u] = tb[2]; t3[u] = tb[3];
                const size_t bi = (((size_t)l * S5G + g) * S5P + p) * S5N + m, ci = (((size_t)l * S5G + g) * S5N + n) * S5P + p;
                brv[u] = c.in[I_BRE][bi]; biv[u] = c.in[I_BIM][bi]; crv[u] = c.in[I_CRE][ci]; civ[u] = c.in[I_CIM][ci]; }
#pragma unroll
            for (int u = 0; u < 8; ++u) { const float bbr = t2[u] * brv[u] - t3[u] * biv[u], bbi = t2[u] * biv[u] + t3[u] * brv[u];
                float zr = crv[u] * bbr - civ[u] * bbi, zi = crv[u] * bbi + civ[u] * bbr;
                const float mg = expf(t0[u]), lbr = mg * cosf(t1[u]), lbi = mg * sinf(t1[u]);
#pragma unroll
                for (int j = 0; j < S5T; ++j) { acc[j] += zr; const float t = zr * lbr - zi * lbi; zi = zr * lbi + zi * lbr; zr = t; } } }
#pragma unroll
        for (int j = 0; j < S5T; ++j) KD[((((size_t)l * S5G + g) * 2 + d) * S5T + j) * 256 + n * 16 + m] = acc[j]; }
}
HD void ph_s5gen2(const Ctx& c, long gtid, long gstride) {
    const float* TAB = wsp<float>(c, WS_S5TAB); const float* KD = wsp<float>(c, WS_KD); bf16* BT1 = wsp<bf16>(c, WS_BT1); bf16* BT2 = wsp<bf16>(c, WS_BT2); const float* PW = wsp<float>(c, WS_POWT);
    GS_LOOP(it16, (long)DEPTH * S5G * 768 * 32) { const long it = it16 * 16; const int s = (int)(it16 % 32), n1 = (int)((it16 / 32) % 768); const long lg = it16 / (32 * 768); const int g = (int)(lg % S5G), l = (int)(lg / S5G);
        float v[16];
        if (n1 < 512) { const int t = n1 / 16, n = n1 % 16; const float* kd = KD + (((size_t)l * S5G + g) * 2) * S5T * 256 + n * 16;
            if (t != s) { const float* q = kd + (size_t)(t > s ? t - s : S5T + s - t) * 256;
#pragma unroll
                for (int u = 0; u < 16; ++u) v[u] = q[u]; }
            else { const float* q = kd + (size_t)S5T * 256; const float dd = c.in[I_S5D][l * DH + g * S5N + n];
#pragma unroll
                for (int u = 0; u < 16; ++u) v[u] = kd[u] + q[u] + (n == u ? dd : 0.f); } }
        else { const int idx = n1 - 512, d = idx / 128, p = (idx % 128) / 2, cc = idx % 2; const float* tb = TAB + ((((size_t)l * 2 + d) * S5G + g) * S5P + p) * 4;
            const size_t bi = (((size_t)l * S5G + g) * S5P + p) * S5N; const float t2 = tb[2], t3 = tb[3];
            const float* pw = PW + (((((size_t)l * 2 + d) * S5G + g) * S5P + p) * 33 + (d == 0 ? S5T - 1 - s : s)) * 2; const float pr = pw[0], pi = pw[1];
            float br[16], bim[16];
#pragma unroll
            for (int u = 0; u < 16; ++u) { br[u] = c.in[I_BRE][bi + u]; bim[u] = c.in[I_BIM][bi + u]; }
#pragma unroll
            for (int u = 0; u < 16; ++u) { const float bbr = t2 * br[u] - t3 * bim[u], bbi = t2 * bim[u] + t3 * br[u]; v[u] = cc == 0 ? pr * bbr - pi * bbi : pr * bbi + pi * bbr; } }
#pragma unroll
        for (int u = 0; u < 16; ++u) BT1[it + u] = f2bf(v[u]); }
    GS_LOOP(it16, (long)DEPTH * S5G * 512 * 16) { const long it = it16 * 16; const int k16 = (int)(it16 % 16), n2 = (int)((it16 / 16) % 512); const long lg = it16 / (16 * 512); const int g = (int)(lg % S5G), l = (int)(lg / S5G);
        const int t = n2 / 16, n = n2 % 16, d = k16 / 8, p0 = (k16 % 8) * 8; float cr[8], cim[8], pr[8], pi[8];
        const size_t ci = (((size_t)l * S5G + g) * S5N + n) * S5P + p0;
#pragma unroll
        for (int u = 0; u < 8; ++u) { cr[u] = c.in[I_CRE][ci + u]; cim[u] = c.in[I_CIM][ci + u];
            const float* pw = PW + (((((size_t)l * 2 + d) * S5G + g) * S5P + p0 + u) * 33 + (d == 0 ? t + 1 : S5T - t)) * 2; pr[u] = pw[0]; pi[u] = pw[1]; }
#pragma unroll
        for (int u = 0; u < 8; ++u) { BT2[it + 2 * u] = f2bf(cr[u] * pr[u] - cim[u] * pi[u]); BT2[it + 2 * u + 1] = f2bf(-(cr[u] * pi[u] + cim[u] * pr[u])); } }
}
HD int s5_row(int d, int b, int step) {
    constexpr int NCC = CTXL / S5T, NCL = SEQ / S5T;
    if (step < NCC) return NTL / S5T + b * NCC + (d ? NCC - 1 - step : step);
    const int i = step - NCC; return b * NCL + (d ? NCL - 1 - i : i);
}
HD void ph_s5cscan(const Ctx& c, int l, long gtid, long gstride) {
    const float* TAB = wsp<float>(c, WS_S5TAB); const float* SL = wsp<float>(c, WS_SLOC); bf16* XI = wsp<bf16>(c, WS_XIN);
    GS_LOOP(it, NB * S5G * 2 * S5P) { const int p = (int)(it % S5P), d = (int)((it / S5P) % 2), g = (int)((it / (2 * S5P)) % S5G), b = (int)(it / (2 * S5P * S5G));
        const float* tb = TAB + ((((size_t)l * 2 + d) * S5G + g) * S5P + p) * 4; float lr, li; s5_pow(tb, (float)S5T, lr, li);
        float xr = 0.f, xi = 0.f;
        for (int st0 = 0; st0 < NPOS / S5T; st0 += 8) { float sr[8], si[8]; size_t o[8];
#pragma unroll
            for (int k = 0; k < 8; ++k) { o[k] = ((size_t)g * S5RP + s5_row(d, b, st0 + k)) * 256 + d * 128 + 2 * p; sr[k] = SL[o[k]]; si[k] = SL[o[k] + 1]; }
#pragma unroll
            for (int k = 0; k < 8; ++k) { XI[o[k]] = f2bf(xr); XI[o[k] + 1] = f2bf(xi); const float t = lr * xr - li * xi + sr[k]; xi = lr * xi + li * xr + si[k]; xr = t; } } }
}
HD void ph_wr(const Ctx& c, long gtid, long gstride) {
    bf16* WH = wsp<bf16>(c, WS_WRH); bf16* WL = wsp<bf16>(c, WS_WRL);
    GS_LOOP(it, DEPTH * NE * D) { const int k = (int)(it % D), e = (int)((it / D) % NE), l = (int)(it / (D * NE)); const float w = c.in[I_RW][((size_t)l * D + k) * NE + e];
        const bf16 hi = f2bf(w); WH[it] = hi; WL[it] = f2bf(w - bf2f(hi)); }
}
HD void ph_norm1(const Ctx& c, int l, long gtid, long gstride) {
    const float* X = wsp<float>(c, WS_X); bf16* H = wsp<bf16>(c, WS_H); const float* MOD = wsp<float>(c, WS_MOD);
    GS_LOOP(r, NT) { int b, t, L, base, mb; tokinfo((int)r, b, t, L, base, mb);
        const float* x = X + (size_t)r * D; float ss = 0.f;
        for (int k = 0; k < D; ++k) ss += x[k] * x[k];
        const float rs = 1.0f / sqrtf(ss / D + EPS);
        const float* g = c.in[I_N1G] + l * D; const float* sh = MOD + ((size_t)l * NMOD + mb) * 6144; const float* sc = sh + D;
        for (int k = 0; k < D; ++k) H[(size_t)r * D + k] = f2bf(x[k] * rs * g[k] * (1.0f + sc[k]) + sh[k]); }
}
HD float conv3(const bf16* P, int r, int col, const float* w, const float* b, int wpitch, int j) {
    float y = b[j] + bf2f(P[(size_t)r * NP + col]) * w[wpitch + j];
    if (has_prev(r)) y += bf2f(P[(size_t)(r - 1) * NP + col]) * w[j];
    if (has_next(r)) y += bf2f(P[(size_t)(r + 1) * NP + col]) * w[2 * wpitch + j];
    return y;
}
HD void ph_s5scan(const Ctx& c, int l, int d, long gtid, long gstride) {
    const bf16* P = wsp<bf16>(c, WS_P); float* XS = wsp<float>(c, WS_XS);
    GS_LOOP(it, NB * S5G * S5P) { const int p = (int)(it % S5P), g = (int)((it / S5P) % S5G), b = (int)(it / (S5P * S5G));
        const size_t li = ((size_t)(l * 2 + d) * S5G + g) * S5P + p;
        const float lre = c.in[I_LRE][li], lim = c.in[I_LIM][li], dt = expf(c.in[I_LDT][(l * 2 + d) * S5G + g]);
        const float mag = expf(lre * dt), lbr = mag * cosf(lim * dt), lbi = mag * sinf(lim * dt);
        const float nr = lbr - 1.0f, ni = lbi, den = lre * lre + lim * lim;
        const float rr = (nr * lre + ni * lim) / den, ri = (ni * lre - nr * lim) / den;
        float bbr[S5N], bbi[S5N];
#pragma unroll
        for (int n = 0; n < S5N; ++n) { const size_t bi = (((size_t)l * S5G + g) * S5P + p) * S5N + n; const float br = c.in[I_BRE][bi], bim = c.in[I_BIM][bi];
            bbr[n] = rr * br - ri * bim; bbi[n] = rr * bim + ri * br; }
        float xr = 0.f, xi = 0.f;
        for (int tau = 0; tau < NPOS; ++tau) { const int r = seq_tok(d, b, tau); const bf16* u = P + (size_t)r * NP + PC_S5 + g * S5N;
            float ur = 0.f, ui = 0.f;
#pragma unroll
            for (int n = 0; n < S5N; ++n) { const float uv = bf2f(u[n]); ur += bbr[n] * uv; ui += bbi[n] * uv; }
            const float nxr = lbr * xr - lbi * xi + ur, nxi = lbr * xi + lbi * xr + ui; xr = nxr; xi = nxi;
            float* o = XS + (((size_t)r * S5G + g) * S5P + p) * 2; o[0] = xr; o[1] = xi; } }
}
HD void ph_mixA(const Ctx& c, int l, long gtid, long gstride) {
    const bf16* P = wsp<bf16>(c, WS_P);
}
HD void ph_s5proj(const Ctx& c, int l, int d, long gtid, long gstride) {
    const bf16* P = wsp<bf16>(c, WS_P); const float* XS = wsp<float>(c, WS_XS); float* YS = wsp<float>(c, WS_YS5); bf16* G = wsp<bf16>(c, WS_G);
    GS_LOOP(it, (long)NT * DH) { const int n = (int)(it % S5N), g = (int)((it / S5N) % S5G), r = (int)(it / DH);
        const float* cr = c.in[I_CRE] + (((size_t)l * S5G + g) * S5N + n) * S5P; const float* ci = c.in[I_CIM] + (((size_t)l * S5G + g) * S5N + n) * S5P;
        const float* xs = XS + ((size_t)r * S5G + g) * S5P * 2; float a = 0.f;
        for (int p = 0; p < S5P; ++p) a += xs[2 * p] * cr[p] - xs[2 * p + 1] * ci[p];
        if (d == 0) YS[it] = c.in[I_S5D][l * DH + g * S5N + n] * bf2f(P[(size_t)r * NP + PC_S5 + g * S5N + n]) + a;
        else G[it] = f2bf(gelu_t(YS[it] + a)); }
}
HD void ph_mixB(const Ctx& c, int l, long gtid, long gstride) {
}
HD void ph_mixC(const Ctx& c, int l, long gtid, long gstride) {
}
HD void ph_mixD(const Ctx& c, int l, long gtid, long gstride) {
    const bf16* P = wsp<bf16>(c, WS_P); const float* HFB = wsp<float>(c, WS_HFB); bf16* MLO = wsp<bf16>(c, WS_MLO);
    GS_LOOP(it, (long)NT * MLH) { const int h = (int)(it % MLH), r = (int)(it / MLH);
        const float* a = HFB + (size_t)r * DH + h * MLD; const float* bq = HFB + ((size_t)NT + r) * DH + h * MLD; float ss = 0.f;
        for (int e = 0; e < MLD; ++e) { const float v = a[e] + bq[e]; ss += v * v; }
        const float rs = 1.0f / sqrtf(ss / MLD + EPS);
        for (int e = 0; e < MLD; ++e) { const float v = (a[e] + bq[e]) * rs * c.in[I_MLNG][l * DH + h * MLD + e];
            MLO[(size_t)r * DH + h * MLD + e] = f2bf(v * sigm(bf2f(P[(size_t)r * NP + PC_O + h * MLD + e]))); } }
}
#ifdef HOST_TEST
HD int atomic_inc(unsigned* p) { return (int)((*p)++); }
#else
__device__ __forceinline__ int atomic_inc(unsigned* p) { return (int)__hip_atomic_fetch_add(p, 1u, __ATOMIC_RELAXED, __HIP_MEMORY_SCOPE_AGENT); }
#endif
HD void ph_route(const Ctx& c, int l, long gtid, long gstride) {
    const float* X = wsp<float>(c, WS_X); bf16* H = wsp<bf16>(c, WS_H); const float* MOD = wsp<float>(c, WS_MOD);
    int* AE = wsp<int>(c, WS_ASGE); int* AP = wsp<int>(c, WS_ASGP); float* AW = wsp<float>(c, WS_ASGW); unsigned* CNT = wsp<unsigned>(c, WS_CTL) + CW_CNT + l * NE;
    GS_LOOP(r, NT) { int b, t, L, base, mb; tokinfo((int)r, b, t, L, base, mb);
        const float* x = X + (size_t)r * D; float ss = 0.f;
        for (int k = 0; k < D; ++k) ss += x[k] * x[k];
        const float rs = 1.0f / sqrtf(ss / D + EPS);
        const float* g = c.in[I_N2G] + l * D; const float* sh = MOD + ((size_t)l * NMOD + mb) * 6144 + 3 * D; const float* sc = sh + D;
        const float* rw = c.in[I_RW] + (size_t)l * D * NE;
        float lg[NE];
#pragma unroll
        for (int e = 0; e < NE; ++e) lg[e] = c.in[I_RB][l * NE + e];
        for (int k = 0; k < D; ++k) { const float hv = x[k] * rs * g[k] * (1.0f + sc[k]) + sh[k]; H[(size_t)r * D + k] = f2bf(hv);
#pragma unroll
            for (int e = 0; e < NE; ++e) lg[e] += hv * rw[k * NE + e]; }
        int sel[TOPK]; float sv[TOPK]; unsigned taken = 0u;
#pragma unroll
        for (int kk = 0; kk < TOPK; ++kk) { float best = -3.0e38f; int bi = 0;
#pragma unroll
            for (int e = 0; e < NE; ++e) { if (!((taken >> e) & 1u) && lg[e] > best) { best = lg[e]; bi = e; } }
            sel[kk] = bi; sv[kk] = best; taken |= 1u << bi; }
        float es[TOPK], sum = 0.f;
#pragma unroll
        for (int kk = 0; kk < TOPK; ++kk) { es[kk] = expf(sv[kk] - sv[0]); sum += es[kk]; }
#pragma unroll
        for (int kk = 0; kk < TOPK; ++kk) { AE[r * TOPK + kk] = sel[kk]; AW[r * TOPK + kk] = es[kk] / sum; AP[r * TOPK + kk] = atomic_inc(CNT + sel[kk]); } }
}
HD void ph_offs(const Ctx& c, int l, long gtid, long gstride) {
    if (gtid != 0) return;
    const unsigned* CNT = wsp<unsigned>(c, WS_CTL) + CW_CNT + l * NE; int* TAB = wsp<int>(c, WS_TAB); int run = 0;
    for (int e = 0; e < NE; ++e) { TAB[e] = run * 256; const int nb = ((int)CNT[e] + 255) / 256; for (int j = 0; j < nb; ++j) TAB[64 + run + j] = e; run += nb; }
    TAB[32] = run;
}
HD void ph_dispatch(const Ctx& c, int l, long gtid, long gstride) {
    const int* AE = wsp<int>(c, WS_ASGE); const int* AP = wsp<int>(c, WS_ASGP); int* AS_ = wsp<int>(c, WS_ASGS); const int* TAB = wsp<int>(c, WS_TAB);
    const uint4* H = wsp<uint4>(c, WS_H); uint4* A = wsp<uint4>(c, WS_AS);
    GS_LOOP(it, (long)NT * TOPK * 128) { const int ch = (int)(it % 128); const long a = it / 128; const int r = (int)(a / TOPK);
        const int slot = TAB[AE[a]] + AP[a]; A[(size_t)slot * 128 + ch] = H[(size_t)r * 128 + ch]; if (ch == 0) AS_[a] = slot; }
}
HD void ph_combine(const Ctx& c, int l, long gtid, long gstride) {
    const int* AS_ = wsp<int>(c, WS_ASGS); const float* AW = wsp<float>(c, WS_ASGW); const bf16* O = wsp<bf16>(c, WS_OUTS); float* X = wsp<float>(c, WS_X); const float* MOD = wsp<float>(c, WS_MOD);
    GS_LOOP(it, (long)NT * D) { const int col = (int)(it % D), r = (int)(it / D); int b, t, L, base, mb; tokinfo(r, b, t, L, base, mb); float f = 0.f;
#pragma unroll
        for (int kk = 0; kk < TOPK; ++kk) f += AW[r * TOPK + kk] * bf2f(O[(size_t)AS_[r * TOPK + kk] * D + col]);
        X[it] += MOD[((size_t)l * NMOD + mb) * 6144 + 5 * D + col] * f; }
}
HD void ph_final(const Ctx& c, long gtid, long gstride) {
    const float* X = wsp<float>(c, WS_X);
    GS_LOOP(r, NTL) { const float* x = X + (size_t)r * D; float ss = 0.f;
        for (int k = 0; k < D; ++k) ss += x[k] * x[k];
        const float rs = 1.0f / sqrtf(ss / D + EPS);
        for (int k = 0; k < D; ++k) c.out[(size_t)r * D + k] = x[k] * rs * c.in[I_FNG][k]; }
}

constexpr int NPRO = 5, NLP = 12, NPHASE = NPRO + DEPTH * NLP + 1;

#ifndef HOST_TEST
#define LAS __attribute__((address_space(3)))
#define GAS __attribute__((address_space(1)))
typedef unsigned v4u __attribute__((ext_vector_type(4)));
typedef unsigned v2u __attribute__((ext_vector_type(2)));
#define LDS_WAIT() asm volatile("s_waitcnt lgkmcnt(0)" ::: "memory")

namespace pg8 {
#define PG8_LAS __attribute__((address_space(3)))
typedef unsigned short bf16_t;
typedef short bf16x8 __attribute__((ext_vector_type(8)));
typedef float f32x4 __attribute__((ext_vector_type(4)));
typedef unsigned u32x4 __attribute__((ext_vector_type(4)));
constexpr int BM = 256, BK = 64, HALF = 128, HTB = HALF * BK * 2, STAGE_BYTES = 8 * HTB, NXCD = 8, WGM = 8;
__host__ __device__ __forceinline__ int lds_byte(int r, int c) { const int st = (r >> 4) * 2 + (c >> 5), rr = r & 15, cc = c & 31, ob = rr * 64 + cc * 2; return st * 1024 + (ob ^ (((ob >> 9) & 1) << 5)); }
__host__ __device__ __forceinline__ void stage_rc(int b, int& R, int& C) { const int st = b / 1024, sb = b % 1024, swz = sb ^ (((sb >> 9) & 1) << 5); R = (st >> 1) * 16 + swz / 64; C = (st & 1) * 32 + (swz % 64) / 2; }
__host__ __device__ __forceinline__ int perm32(int rho) { const int n = rho >> 4, i = rho & 15; return 8 * (i >> 2) + 4 * n + (i & 3); }

struct Unit { int pm, pn, pb, e; };
struct Gemm { const bf16_t* A; const bf16_t* Bt; int M, N, K; unsigned a_row, a_kstep, a_sub, a_grp; int a_mode; const int* a_gather; };
__host__ __device__ __forceinline__ Gemm make_gemm(const bf16_t* A, const bf16_t* Bt, int M, int N, int K) { Gemm g; g.A = A; g.Bt = Bt; g.M = M; g.N = N; g.K = K; g.a_row = (unsigned)K * 2u; g.a_kstep = BK * 2; g.a_sub = 0; g.a_grp = 0; g.a_mode = 0; g.a_gather = nullptr; return g; }

struct StaticOrder {
    static constexpr bool GATHER = false;
    int nM, nN, nwg, G, c;
    __host__ __device__ void init(int M, int N, int G_, int c_) { nM = M / BM; nN = N / BM; nwg = nM * nN; G = G_; c = c_; }
    __host__ __device__ bool next(int i, Unit& u) const {
        const long L = (long)i * G + c; if (L >= nwg) return false;
        int wgid = (int)L; { const int q = nwg / NXCD, r = nwg % NXCD, xcd = wgid % NXCD, off = wgid / NXCD; wgid = (xcd < r ? xcd * (q + 1) : r * (q + 1) + (xcd - r) * q) + off; }
        const int nig = WGM * nN, gid = wgid / nig, fm = gid * WGM, gsz = (nM - fm) < WGM ? (nM - fm) : WGM;
        u.pm = fm + ((wgid % nig) % gsz); u.pn = (wgid % nig) / gsz; u.pb = u.pn; u.e = 0; return true;
    }
    __device__ __forceinline__ void a_ready(const Unit&) const {}
    __device__ __forceinline__ void done(const Unit&) const {}
};
template <bool GATH> struct MoeOrderT {
    static constexpr bool GATHER = GATH;
    const PG8_LAS int* tab; int nN, G, c;
    __device__ bool next(int i, Unit& u) const {
        const int nblk = tab[0]; int blk, pn;
        if ((G & 7) == 0) { const int x = c & 7, j = c >> 3, uu = i * (G >> 3) + j; blk = (uu / nN) * 8 + x; pn = uu % nN; }
        else { const long L = (long)i * G + c; blk = (int)(L / nN); pn = (int)(L % nN); }
        if (blk >= nblk) return false;
        u.pm = blk; u.pn = pn; u.e = tab[32 + blk]; u.pb = u.e * nN + pn; return true;
    }
    __device__ __forceinline__ void a_ready(const Unit&) const {}
    __device__ __forceinline__ void done(const Unit&) const {}
};

struct S5Order {
    static constexpr bool GATHER = false;
    int nN, G, c;
    __device__ bool next(int i, Unit& u) const {
        constexpr int nM = S5RP / BM; const long L = (long)i * G + c; if (L >= (long)S5G * nM * nN) return false;
        u.pn = (int)(L % nN); u.pm = (int)((L / nN) % nM); u.e = (int)(L / (nN * nM)); u.pb = u.e * nN + u.pn; return true;
    }
    __device__ __forceinline__ void a_ready(const Unit&) const {}
    __device__ __forceinline__ void done(const Unit&) const {}
};
typedef int i32x4 __attribute__((ext_vector_type(4)));
template <class Epi, class Sched, bool ALIGN_EPI = false, bool SP2 = false, bool I8 = false>
__device__ __forceinline__ void gemm_phase(PG8_LAS unsigned char* lds, const Gemm g, const Sched& S, const Epi& E, int tid_in) {
    int tid = tid_in; asm volatile("" : "+v"(tid));
    const int wid = __builtin_amdgcn_readfirstlane(tid >> 6), lane = tid & 63, wr = wid >> 2, wc = wid & 3, fr = lane & 15, fq = lane >> 4;
    const int K = g.K, nt = K / BK;
    unsigned voffA[2], voffB[2];
#pragma unroll
    for (int i = 0; i < 2; ++i) { int R, C; stage_rc(tid * 16 + i * 8192, R, C); const int Rb = Epi::PERM ? ((R & ~31) + perm32(R & 31)) : R;
        voffA[i] = (unsigned)R * g.a_row + (g.a_mode ? (unsigned)(C >> 4) * g.a_sub + (unsigned)(C & 15) * 2u : (unsigned)C * 2u); voffB[i] = (unsigned)(Rb * K + C) * 2u; }
    const size_t kstep = (size_t)(BK * 2), kstepA = g.a_kstep;
    const size_t hstep = (size_t)HALF * K * 2, hstepA = (size_t)HALF * g.a_row;
    const size_t tstep = 2 * hstep, tstepA = 2 * hstepA;
    const unsigned ldsw = (unsigned)wid * 1024u;
    const int aoff = lds_byte(wr * 64 + fr, fq * 8), boff = lds_byte(wc * 32 + fr, fq * 8);
#define PG8_SA(b, h) (((b) * 2 + (h)) * HTB)
#define PG8_SB(b, h) ((4 + (b) * 2 + (h)) * HTB)
#define PG8_STAGE(bufoff, gbase, voff) do { _Pragma("unroll") for (int _i = 0; _i < 2; ++_i) \
        __builtin_amdgcn_global_load_lds((const unsigned*)((const char*)(gbase) + (voff)[_i]), (PG8_LAS unsigned*)(lds + (bufoff) + ldsw + _i * 8192), 16, 0, 0); } while (0)
#define PG8_LDA(dst, b, h) do { _Pragma("unroll") for (int m = 0; m < 4; ++m) _Pragma("unroll") for (int k = 0; k < 2; ++k) dst[m][k] = *(const PG8_LAS bf16x8*)(lds + PG8_SA(b, h) + aoff + m * 2048 + k * 1024); } while (0)
#define PG8_LDB(dst, b, h) do { _Pragma("unroll") for (int n = 0; n < 2; ++n) _Pragma("unroll") for (int k = 0; k < 2; ++k) dst[n][k] = *(const PG8_LAS bf16x8*)(lds + PG8_SB(b, h) + boff + n * 2048 + k * 1024); } while (0)
#define PG8_MMA(ai, bj, At, Bt) do { __builtin_amdgcn_s_setprio(1); _Pragma("unroll") for (int m = 0; m < 4; ++m) _Pragma("unroll") for (int n = 0; n < 2; ++n) _Pragma("unroll") for (int k = 0; k < 2; ++k) \
        { if constexpr (I8) acc[ai][bj][m][n] = __builtin_bit_cast(f32x4, __builtin_amdgcn_mfma_i32_16x16x64_i8(__builtin_bit_cast(i32x4, Bt[n][k]), __builtin_bit_cast(i32x4, At[m][k]), __builtin_bit_cast(i32x4, acc[ai][bj][m][n]), 0, 0, 0)); \
          else acc[ai][bj][m][n] = __builtin_amdgcn_mfma_f32_16x16x32_bf16(Bt[n][k], At[m][k], acc[ai][bj][m][n], 0, 0, 0); } __builtin_amdgcn_s_setprio(0); } while (0)
#define PG8_WAIT_V(n) asm volatile("s_waitcnt vmcnt(" #n ")" ::: "memory")
#define PG8_WAIT_L(n) asm volatile("s_waitcnt lgkmcnt(" #n ")" ::: "memory")
#define PG8_BAR __builtin_amdgcn_s_barrier()
#define PG8_SCHED __builtin_amdgcn_sched_barrier(0)
    Unit cur, nxt; int ui = 0;
    if (!S.next(0, cur)) return;
    f32x4 acc[2][2][4][2];
#pragma unroll
    for (int a = 0; a < 2; ++a)
#pragma unroll
        for (int b = 0; b < 2; ++b)
#pragma unroll
            for (int m = 0; m < 4; ++m)
#pragma unroll
                for (int n = 0; n < 2; ++n) acc[a][b][m][n] = (f32x4){0.f, 0.f, 0.f, 0.f};
    bf16x8 At[4][2], B0[2][2], B1[2][2];
    const char* cA = Sched::GATHER ? (const char*)g.A : (const char*)g.A + (size_t)cur.pm * tstepA + (size_t)cur.e * g.a_grp; const char* cB = (const char*)g.Bt + (size_t)cur.pb * tstep;
    int Rg[2], Cg[2]; unsigned vg0[2] = {0u, 0u}, vg1[2] = {0u, 0u}, vn0[2] = {0u, 0u}, vn1[2] = {0u, 0u};
    if constexpr (Sched::GATHER) {
#pragma unroll
        for (int i = 0; i < 2; ++i) { stage_rc(tid * 16 + i * 8192, Rg[i], Cg[i]);
            vg0[i] = (unsigned)g.a_gather[cur.pm * BM + Rg[i]] * g.a_row + (unsigned)Cg[i] * 2u; vg1[i] = (unsigned)g.a_gather[cur.pm * BM + HALF + Rg[i]] * g.a_row + (unsigned)Cg[i] * 2u; } }
#define PG8_STAGE_A(bufoff, gbase, half, nx) do { if constexpr (Sched::GATHER) { _Pragma("unroll") for (int _i = 0; _i < 2; ++_i) { const unsigned _v = (nx) ? ((half) ? vn1[_i] : vn0[_i]) : ((half) ? vg1[_i] : vg0[_i]); \
        __builtin_amdgcn_global_load_lds((const unsigned*)((const char*)(gbase) + _v), (PG8_LAS unsigned*)(lds + (bufoff) + ldsw + _i * 8192), 16, 0, 0); } } \
        else { PG8_STAGE(bufoff, (gbase) + ((half) ? hstepA : 0), voffA); } } while (0)
    S.a_ready(cur);
    if constexpr (SP2) {
        PG8_STAGE(PG8_SB(0, 0), cB, voffB); PG8_STAGE(PG8_SB(0, 1), cB + hstep, voffB); PG8_STAGE_A(PG8_SA(0, 0), cA, 0, false); PG8_STAGE_A(PG8_SA(0, 1), cA, 1, false);
        if (wr == 1) PG8_BAR;
        PG8_WAIT_V(2); PG8_BAR;
        PG8_STAGE(PG8_SB(1, 0), cB + kstep, voffB); PG8_STAGE_A(PG8_SA(1, 0), cA + kstepA, 0, false); PG8_STAGE(PG8_SB(1, 1), cB + hstep + kstep, voffB);
        PG8_WAIT_V(6); PG8_BAR;
    } else {
        PG8_STAGE(PG8_SB(0, 0), cB, voffB); PG8_STAGE_A(PG8_SA(0, 0), cA, 0, false); PG8_STAGE(PG8_SB(0, 1), cB + hstep, voffB); PG8_STAGE_A(PG8_SA(0, 1), cA, 1, false);
        if (wr == 1) PG8_BAR;
        PG8_WAIT_V(4); PG8_BAR;
        PG8_STAGE(PG8_SB(1, 0), cB + kstep, voffB); PG8_STAGE_A(PG8_SA(1, 0), cA + kstepA, 0, false); PG8_STAGE(PG8_SB(1, 1), cB + hstep + kstep, voffB);
        PG8_WAIT_V(6); PG8_BAR;
    }
    for (;;) {
        const bool has_next = S.next(ui + 1, nxt);
        const char* nA = Sched::GATHER ? (const char*)g.A : (has_next ? (const char*)g.A + (size_t)nxt.pm * tstepA + (size_t)nxt.e * g.a_grp : cA); const char* nB = has_next ? (const char*)g.Bt + (size_t)nxt.pb * tstep : cB;
        if constexpr (Sched::GATHER) { const int npm = has_next ? nxt.pm : cur.pm;
#pragma unroll
            for (int i = 0; i < 2; ++i) { vn0[i] = (unsigned)g.a_gather[npm * BM + Rg[i]] * g.a_row + (unsigned)Cg[i] * 2u; vn1[i] = (unsigned)g.a_gather[npm * BM + HALF + Rg[i]] * g.a_row + (unsigned)Cg[i] * 2u; } }
#pragma unroll 1
        for (int t = 0; t < nt; t += 2) {
            const bool last = (t == nt - 2);
            const char* a1 = cA + (size_t)(t + 1) * kstepA;
            const char* a2 = last ? nA : cA + (size_t)(t + 2) * kstepA; const char* b2 = last ? nB : cB + (size_t)(t + 2) * kstep;
            const char* a3 = a2 + kstepA; const char* b3 = b2 + kstep;
            if (last && has_next) S.a_ready(nxt);
            if constexpr (SP2) {
            PG8_LDB(B0, 0, 0); PG8_LDB(B1, 0, 1); PG8_SCHED; PG8_LDA(At, 0, 0); PG8_STAGE_A(PG8_SA(1, 1), a1, 1, false);
            PG8_WAIT_V(8); PG8_WAIT_L(0); PG8_BAR; PG8_MMA(0, 0, At, B0); PG8_MMA(0, 1, At, B1); PG8_BAR; PG8_SCHED;
            PG8_LDA(At, 0, 1); PG8_STAGE(PG8_SB(0, 0), b2, voffB); PG8_STAGE(PG8_SB(0, 1), b2 + hstep, voffB); PG8_STAGE_A(PG8_SA(0, 0), a2, 0, last);
            PG8_WAIT_V(8); PG8_WAIT_L(0); PG8_BAR; PG8_MMA(1, 0, At, B0); PG8_MMA(1, 1, At, B1); PG8_BAR; PG8_SCHED;
            PG8_LDB(B0, 1, 0); PG8_LDB(B1, 1, 1); PG8_SCHED; PG8_LDA(At, 1, 0); PG8_STAGE_A(PG8_SA(0, 1), a2, 1, last);
            PG8_WAIT_V(8); PG8_WAIT_L(0); PG8_BAR; PG8_MMA(0, 0, At, B0); PG8_MMA(0, 1, At, B1); PG8_BAR; PG8_SCHED;
            PG8_LDA(At, 1, 1); PG8_STAGE(PG8_SB(1, 0), b3, voffB); PG8_STAGE(PG8_SB(1, 1), b3 + hstep, voffB); PG8_STAGE_A(PG8_SA(1, 0), a3, 0, last);
            PG8_WAIT_V(8); PG8_WAIT_L(0); PG8_BAR; PG8_MMA(1, 0, At, B0); PG8_MMA(1, 1, At, B1); PG8_BAR; PG8_SCHED;
            } else {
            PG8_LDB(B0, 0, 0); PG8_SCHED; PG8_LDA(At, 0, 0); PG8_STAGE_A(PG8_SA(1, 1), a1, 1, false);
            PG8_WAIT_L(8); PG8_BAR; PG8_WAIT_L(0); PG8_MMA(0, 0, At, B0); PG8_BAR; PG8_SCHED;
            PG8_LDB(B1, 0, 1); PG8_STAGE(PG8_SB(0, 0), b2, voffB);
            PG8_BAR; PG8_WAIT_L(0); PG8_MMA(0, 1, At, B1); PG8_BAR;
            PG8_LDA(At, 0, 1); PG8_STAGE_A(PG8_SA(0, 0), a2, 0, last);
            PG8_BAR; PG8_WAIT_L(0); PG8_MMA(1, 0, At, B0); PG8_BAR; PG8_SCHED;
            PG8_STAGE(PG8_SB(0, 1), b2 + hstep, voffB);
            PG8_WAIT_V(6); PG8_BAR; PG8_MMA(1, 1, At, B1); PG8_BAR;
            PG8_LDB(B0, 1, 0); PG8_SCHED; PG8_LDA(At, 1, 0); PG8_STAGE_A(PG8_SA(0, 1), a2, 1, last);
            PG8_WAIT_L(8); PG8_BAR; PG8_WAIT_L(0); PG8_MMA(0, 0, At, B0); PG8_BAR; PG8_SCHED;
            PG8_LDB(B1, 1, 1); PG8_STAGE(PG8_SB(1, 0), b3, voffB);
            PG8_BAR; PG8_WAIT_L(0); PG8_MMA(0, 1, At, B1); PG8_BAR;
            PG8_LDA(At, 1, 1); PG8_STAGE_A(PG8_SA(1, 0), a3, 0, last);
            PG8_BAR; PG8_WAIT_L(0); PG8_MMA(1, 0, At, B0); PG8_BAR; PG8_SCHED;
            PG8_STAGE(PG8_SB(1, 1), b3 + hstep, voffB);
            PG8_WAIT_V(6); PG8_BAR; PG8_MMA(1, 1, At, B1); PG8_BAR;
            }
        }
        if constexpr (ALIGN_EPI) { if (wr == 0) PG8_BAR; }
        E(acc, cur, wr, wc, fr, fq); S.done(cur);
        if (!has_next) break;
#pragma unroll
        for (int a = 0; a < 2; ++a)
#pragma unroll
            for (int b = 0; b < 2; ++b)
#pragma unroll
                for (int m = 0; m < 4; ++m)
#pragma unroll
                    for (int n = 0; n < 2; ++n) acc[a][b][m][n] = (f32x4){0.f, 0.f, 0.f, 0.f};
        cur = nxt; cA = nA; cB = nB; ++ui;
        if constexpr (Sched::GATHER) {
#pragma unroll
            for (int i = 0; i < 2; ++i) { vg0[i] = vn0[i]; vg1[i] = vn1[i]; } }
        if constexpr (ALIGN_EPI) { if (wr == 1) PG8_BAR; }
    }
    PG8_WAIT_V(0);
    if constexpr (!ALIGN_EPI) { if (wr == 0) PG8_BAR; }
    PG8_BAR;
#undef PG8_SA
#undef PG8_SB
#undef PG8_STAGE
#undef PG8_STAGE_A
#undef PG8_LDA
#undef PG8_LDB
#undef PG8_MMA
#undef PG8_WAIT_V
#undef PG8_WAIT_L
#undef PG8_BAR
#undef PG8_SCHED
}

__device__ __forceinline__ float fsig(float x) { return __builtin_amdgcn_rcpf(1.0f + __builtin_amdgcn_exp2f(-1.4426950408889634f * x)); }
#define EPI_LOOP(BODY) \
    _Pragma("unroll") for (int ai = 0; ai < 2; ++ai) _Pragma("unroll") for (int m = 0; m < 4; ++m) { const int row = u.pm * BM + ai * HALF + wr * 64 + m * 16 + fr; \
    _Pragma("unroll") for (int bj = 0; bj < 2; ++bj) _Pragma("unroll") for (int n = 0; n < 2; ++n) { const int col = u.pn * BM + bj * HALF + wc * 32 + n * 16 + 4 * fq; const f32x4 a = acc[ai][bj][m][n]; BODY } \
    asm volatile("" ::: "memory"); }
#define EPI_LOOP2(BODY) \
    _Pragma("unroll") for (int ai = 0; ai < 2; ++ai) _Pragma("unroll") for (int m = 0; m < 4; ++m) { const int row = u.pm * BM + ai * HALF + wr * 64 + m * 16 + fr; \
    _Pragma("unroll") for (int bj = 0; bj < 2; ++bj) _Pragma("unroll") for (int n = 0; n < 2; ++n) { const int col = u.pn * BM + bj * HALF + wc * 32 + n * 16 + 4 * fq; const f32x4 a = acc[ai][bj][m][n]; BODY } \
    if (m & 1) asm volatile("" ::: "memory"); }
__device__ __forceinline__ v2u pack4(f32x4 v) { v2u w; w.x = f2bf_bits(v[0]) | (f2bf_bits(v[1]) << 16); w.y = f2bf_bits(v[2]) | (f2bf_bits(v[3]) << 16); return w; }
__device__ __forceinline__ f32x4 unpack4(v2u w) { f32x4 v; v[0] = __uint_as_float(w.x << 16); v[1] = __uint_as_float(w.x & 0xffff0000u); v[2] = __uint_as_float(w.y << 16); v[3] = __uint_as_float(w.y & 0xffff0000u); return v; }

struct EpiStoreBf16 {
    static constexpr bool PERM = true;
    bf16_t* O; int ldc;
    __device__ __forceinline__ void operator()(const f32x4 (&acc)[2][2][4][2], const Unit& u, int wr, int wc, int fr, int fq) const {
#pragma unroll
        for (int ai = 0; ai < 2; ++ai)
#pragma unroll
            for (int m = 0; m < 4; ++m) { const int row = u.pm * BM + ai * HALF + wr * 64 + m * 16 + fr;
#pragma unroll
                for (int bj = 0; bj < 2; ++bj) { const int col = u.pn * BM + bj * HALF + wc * 32 + 8 * fq; const v2u lo = pack4(acc[ai][bj][m][0]), hi = pack4(acc[ai][bj][m][1]);
                    *(u32x4*)(O + (size_t)row * ldc + col) = (u32x4){lo.x, lo.y, hi.x, hi.y}; }
                asm volatile("" ::: "memory"); }
    }
};
struct EpiStoreQ8 {
    static constexpr bool PERM = true;
    bf16_t* O; int ldc; const float* rs; const float* cs;
    __device__ __forceinline__ void operator()(const f32x4 (&acc)[2][2][4][2], const Unit& u, int wr, int wc, int fr, int fq) const {
        f32x4 cv[2][2];
#pragma unroll
        for (int bj = 0; bj < 2; ++bj)
#pragma unroll
            for (int n = 0; n < 2; ++n) { cv[bj][n] = *(const f32x4*)(cs + u.pn * BM + bj * HALF + wc * 32 + 8 * fq + 4 * n);
#pragma unroll
                for (int j = 0; j < 4; ++j) cv[bj][n][j] = cv[bj][n][j] > 0.f ? cv[bj][n][j] * (1.0f / 127.0f) : 1.0f; }
#pragma unroll
        for (int ai = 0; ai < 2; ++ai)
#pragma unroll
            for (int m = 0; m < 4; ++m) { const int row = u.pm * BM + ai * HALF + wr * 64 + m * 16 + fr; const float r = rs[row];
#pragma unroll
                for (int bj = 0; bj < 2; ++bj) { const int col = u.pn * BM + bj * HALF + wc * 32 + 8 * fq; f32x4 v0, v1;
                    const i32x4 a0 = __builtin_bit_cast(i32x4, acc[ai][bj][m][0]), a1 = __builtin_bit_cast(i32x4, acc[ai][bj][m][1]);
#pragma unroll
                    for (int j = 0; j < 4; ++j) { v0[j] = (float)a0[j] * r * cv[bj][0][j]; v1[j] = (float)a1[j] * r * cv[bj][1][j]; }
                    const v2u lo = pack4(v0), hi = pack4(v1); *(u32x4*)(O + (size_t)row * ldc + col) = (u32x4){lo.x, lo.y, hi.x, hi.y}; }
                asm volatile("" ::: "memory"); }
    }
};
struct EpiS5a {
    static constexpr bool PERM = false;
    float* YS; float* SL;
    __device__ __forceinline__ void operator()(const f32x4 (&acc)[2][2][4][2], const Unit& u, int wr, int wc, int fr, int fq) const {
        EPI_LOOP({ if (row < S5R) { if (col < 512) *(f32x4*)(YS + (size_t)(row * S5T + (col >> 4)) * DH + u.e * S5N + (col & 15)) = a;
                                    else *(f32x4*)(SL + ((size_t)u.e * S5RP + row) * 256 + (col - 512)) = a; } })
    }
};
struct EpiS5b {
    static constexpr bool PERM = true;
    const float* YS; bf16_t* Gd;
    __device__ __forceinline__ void operator()(const f32x4 (&acc)[2][2][4][2], const Unit& u, int wr, int wc, int fr, int fq) const {
#pragma unroll
        for (int ai = 0; ai < 2; ++ai)
#pragma unroll
            for (int m = 0; m < 4; ++m) { const int row = u.pm * BM + ai * HALF + wr * 64 + m * 16 + fr;
                if (row < S5R) {
#pragma unroll
                    for (int bj = 0; bj < 2; ++bj) { const int col = u.pn * BM + bj * HALF + wc * 32 + 8 * fq; const size_t o = (size_t)(row * S5T + (col >> 4)) * DH + u.e * S5N + (col & 15);
                        const f32x4 y0 = *(const f32x4*)(YS + o) + acc[ai][bj][m][0], y1 = *(const f32x4*)(YS + o + 4) + acc[ai][bj][m][1]; f32x4 r0, r1;
#pragma unroll
                        for (int j = 0; j < 4; ++j) { r0[j] = y0[j] * fsig(1.5957691216057308f * (y0[j] + 0.044715f * y0[j] * y0[j] * y0[j])); r1[j] = y1[j] * fsig(1.5957691216057308f * (y1[j] + 0.044715f * y1[j] * y1[j] * y1[j])); }
                        const v2u lo = pack4(r0), hi = pack4(r1); *(u32x4*)(Gd + o) = (u32x4){lo.x, lo.y, hi.x, hi.y}; } }
                if (m & 1) asm volatile("" ::: "memory"); }
    }
};
struct EpiGlu {
    static constexpr bool PERM = true;
    const bf16_t* G; bf16_t* O;
    __device__ __forceinline__ void operator()(const f32x4 (&acc)[2][2][4][2], const Unit& u, int wr, int wc, int fr, int fq) const {
#pragma unroll
        for (int ai = 0; ai < 2; ++ai)
#pragma unroll
            for (int m = 0; m < 4; ++m) { const int row = u.pm * BM + ai * HALF + wr * 64 + m * 16 + fr;
#pragma unroll
                for (int bj = 0; bj < 2; ++bj) { const int col = u.pn * BM + bj * HALF + wc * 32 + 8 * fq;
                    if (col < DH) { const u32x4 gp = *(const u32x4*)(G + (size_t)row * DH + col); const f32x4 g0 = unpack4((v2u){gp.x, gp.y}), g1 = unpack4((v2u){gp.z, gp.w}); f32x4 o0, o1;
#pragma unroll
                        for (int j = 0; j < 4; ++j) { o0[j] = g0[j] * fsig(acc[ai][bj][m][0][j]); o1[j] = g1[j] * fsig(acc[ai][bj][m][1][j]); }
                        const v2u lo = pack4(o0), hi = pack4(o1); *(u32x4*)(O + (size_t)row * DH + col) = (u32x4){lo.x, lo.y, hi.x, hi.y}; } }
                if (m & 1) asm volatile("" ::: "memory"); }
    }
};
template <int MODE> struct EpiBr {
    static constexpr bool PERM = true;
    const bf16_t* P; int gcol; float* YF; bf16_t* YB;
    __device__ __forceinline__ void operator()(const f32x4 (&acc)[2][2][4][2], const Unit& u, int wr, int wc, int fr, int fq) const {
#pragma unroll
        for (int ai = 0; ai < 2; ++ai)
#pragma unroll
            for (int m = 0; m < 4; ++m) { const int row = u.pm * BM + ai * HALF + wr * 64 + m * 16 + fr;
#pragma unroll
                for (int bj = 0; bj < 2; ++bj) { const int col = u.pn * BM + bj * HALF + wc * 32 + 8 * fq;
                    const u32x4 mgp = *(const u32x4*)(P + (size_t)row * NP + gcol + col); bf16_t* yp = YB + (size_t)row * D + col;
                    const f32x4 g0 = unpack4((v2u){mgp.x, mgp.y}), g1 = unpack4((v2u){mgp.z, mgp.w}); f32x4 v0, v1;
#pragma unroll
                    for (int j = 0; j < 4; ++j) { v0[j] = fsig(g0[j]) * acc[ai][bj][m][0][j]; v1[j] = fsig(g1[j]) * acc[ai][bj][m][1][j]; }
                    if (MODE != 0) { const u32x4 yo = *(const u32x4*)yp; v0 = v0 + unpack4((v2u){yo.x, yo.y}); v1 = v1 + unpack4((v2u){yo.z, yo.w}); }
                    const v2u lo = pack4(v0), hi = pack4(v1); *(u32x4*)yp = (u32x4){lo.x, lo.y, hi.x, hi.y}; }
                if (m & 1) asm volatile("" ::: "memory"); }
    }
};
template <bool SRC32> struct EpiOut {
    static constexpr bool PERM = true;
    bf16_t* X; const float* modl; const float* xl; const float* xc;
    __device__ __forceinline__ void operator()(const f32x4 (&acc)[2][2][4][2], const Unit& u, int wr, int wc, int fr, int fq) const {
        const int row0 = u.pm * BM, mb = row0 < NTL ? row0 / SEQ : NB; f32x4 gv[2][2];
#pragma unroll
        for (int bj = 0; bj < 2; ++bj)
#pragma unroll
            for (int n = 0; n < 2; ++n) gv[bj][n] = *(const f32x4*)(modl + (size_t)mb * 6144 + 2 * D + u.pn * BM + bj * HALF + wc * 32 + 8 * fq + 4 * n);
#pragma unroll
        for (int ai = 0; ai < 2; ++ai)
#pragma unroll
            for (int m = 0; m < 4; ++m) { const int row = u.pm * BM + ai * HALF + wr * 64 + m * 16 + fr;
#pragma unroll
                for (int bj = 0; bj < 2; ++bj) { const int col = u.pn * BM + bj * HALF + wc * 32 + 8 * fq; f32x4 s0, s1;
                    if (SRC32) { const float* sp = (row < NTL ? xl + (size_t)row * D : xc + (size_t)(row - NTL) * D) + col; s0 = *(const f32x4*)sp; s1 = *(const f32x4*)(sp + 4); }
                    else { const u32x4 xo = *(const u32x4*)(X + (size_t)row * D + col); s0 = unpack4((v2u){xo.x, xo.y}); s1 = unpack4((v2u){xo.z, xo.w}); }
                    const v2u lo = pack4(s0 + gv[bj][0] * acc[ai][bj][m][0]), hi = pack4(s1 + gv[bj][1] * acc[ai][bj][m][1]);
                    *(u32x4*)(X + (size_t)row * D + col) = (u32x4){lo.x, lo.y, hi.x, hi.y}; }
                if (m & 1) asm volatile("" ::: "memory"); }
    }
};
struct EpiMoe1 {
    static constexpr bool PERM = false;
    bf16_t* ACT; const float* b1;
    __device__ __forceinline__ void operator()(const f32x4 (&acc)[2][2][4][2], const Unit& u, int wr, int wc, int fr, int fq) const {
        const int a0 = 128 * u.pn + 32 * wc + 8 * fq; const float* bb = b1 + (size_t)u.e * 1024 + 2 * a0; f32x4 bg[2], bl[2];
#pragma unroll
        for (int bj = 0; bj < 2; ++bj) { const f32x4 p0 = *(const f32x4*)(bb + 8 * bj), p1 = *(const f32x4*)(bb + 8 * bj + 4); bg[bj] = (f32x4){p0[0], p0[2], p1[0], p1[2]}; bl[bj] = (f32x4){p0[1], p0[3], p1[1], p1[3]}; }
#pragma unroll
        for (int ai = 0; ai < 2; ++ai)
#pragma unroll
            for (int m = 0; m < 4; ++m) { const int row = u.pm * BM + ai * HALF + wr * 64 + m * 16 + fr; v2u pk[2];
#pragma unroll
                for (int bj = 0; bj < 2; ++bj) { const f32x4 g = acc[ai][bj][m][0] + bg[bj], li = acc[ai][bj][m][1] + bl[bj]; f32x4 o;
#pragma unroll
                    for (int j = 0; j < 4; ++j) { const float xg = fminf(g[j], 7.0f); const float xl = fminf(fmaxf(li[j], -7.0f), 7.0f); o[j] = xg * fsig(1.702f * xg) * (xl + 1.0f); }
                    pk[bj] = pack4(o); }
                *(u32x4*)(ACT + (size_t)row * FF + a0) = (u32x4){pk[0].x, pk[0].y, pk[1].x, pk[1].y};
                asm volatile("" ::: "memory"); }
    }
};
struct EpiMoe1Q8 {
    static constexpr bool PERM = false;
    bf16_t* ACT; const float* b1; const float* rs; const float* cs;
    __device__ __forceinline__ void operator()(const f32x4 (&acc)[2][2][4][2], const Unit& u, int wr, int wc, int fr, int fq) const {
        const int a0 = 128 * u.pn + 32 * wc + 8 * fq; const float* bb = b1 + (size_t)u.e * 1024 + 2 * a0; const float* sb = cs + (size_t)u.e * 1024 + 2 * a0; f32x4 bg[2], bl[2], sg[2], sl[2];
#pragma unroll
        for (int bj = 0; bj < 2; ++bj) { const f32x4 p0 = *(const f32x4*)(bb + 8 * bj), p1 = *(const f32x4*)(bb + 8 * bj + 4); bg[bj] = (f32x4){p0[0], p0[2], p1[0], p1[2]}; bl[bj] = (f32x4){p0[1], p0[3], p1[1], p1[3]};
            const f32x4 q0 = *(const f32x4*)(sb + 8 * bj), q1 = *(const f32x4*)(sb + 8 * bj + 4); sg[bj] = (f32x4){q0[0], q0[2], q1[0], q1[2]}; sl[bj] = (f32x4){q0[1], q0[3], q1[1], q1[3]};
#pragma unroll
            for (int j = 0; j < 4; ++j) { sg[bj][j] = sg[bj][j] > 0.f ? sg[bj][j] * (1.0f / 127.0f) : 1.0f; sl[bj][j] = sl[bj][j] > 0.f ? sl[bj][j] * (1.0f / 127.0f) : 1.0f; } }
#pragma unroll
        for (int ai = 0; ai < 2; ++ai)
#pragma unroll
            for (int m = 0; m < 4; ++m) { const int row = u.pm * BM + ai * HALF + wr * 64 + m * 16 + fr; const float r = rs[row]; v2u pk[2];
#pragma unroll
                for (int bj = 0; bj < 2; ++bj) { const i32x4 ig = __builtin_bit_cast(i32x4, acc[ai][bj][m][0]), il = __builtin_bit_cast(i32x4, acc[ai][bj][m][1]); f32x4 o;
#pragma unroll
                    for (int j = 0; j < 4; ++j) { const float g = (float)ig[j] * r * sg[bj][j] + bg[bj][j], li = (float)il[j] * r * sl[bj][j] + bl[bj][j];
                        const float xg = fminf(g, 7.0f); const float xl = fminf(fmaxf(li, -7.0f), 7.0f); o[j] = xg * fsig(1.702f * xg) * (xl + 1.0f); }
                    pk[bj] = pack4(o); }
                *(u32x4*)(ACT + (size_t)row * FF + a0) = (u32x4){pk[0].x, pk[0].y, pk[1].x, pk[1].y};
                asm volatile("" ::: "memory"); }
    }
};
struct EpiMoe2 {
    static constexpr bool PERM = true;
    unsigned char* O; float* SC; const float* b2;
    __device__ __forceinline__ void operator()(const f32x4 (&acc)[2][2][4][2], const Unit& u, int wr, int wc, int fr, int fq) const {
        f32x4 bv[2][2];
#pragma unroll
        for (int bj = 0; bj < 2; ++bj)
#pragma unroll
            for (int n = 0; n < 2; ++n) bv[bj][n] = *(const f32x4*)(b2 + (size_t)u.e * D + u.pn * BM + bj * HALF + wc * 32 + 8 * fq + 4 * n);
#pragma unroll
        for (int ai = 0; ai < 2; ++ai)
#pragma unroll
            for (int m = 0; m < 4; ++m) { const int row = u.pm * BM + ai * HALF + wr * 64 + m * 16 + fr;
#pragma unroll
                for (int bj = 0; bj < 2; ++bj) { const int col = u.pn * BM + bj * HALF + wc * 32 + 8 * fq;
                    const f32x4 a = acc[ai][bj][m][0] + bv[bj][0], b = acc[ai][bj][m][1] + bv[bj][1];
                    float mx = fmaxf(fmaxf(fmaxf(fabsf(a[0]), fabsf(a[1])), fmaxf(fabsf(a[2]), fabsf(a[3]))), fmaxf(fmaxf(fabsf(b[0]), fabsf(b[1])), fmaxf(fabsf(b[2]), fabsf(b[3]))));
                    mx = fmaxf(mx, __shfl_xor(mx, 16)); mx = fmaxf(mx, __shfl_xor(mx, 32));
                    const float inv = mx > 0.f ? 127.0f / mx : 0.f; const float MG = 12582912.0f + 128.0f;
                    const unsigned q0 = __float_as_uint(fmaf(a[0], inv, MG)), q1 = __float_as_uint(fmaf(a[1], inv, MG)), q2 = __float_as_uint(fmaf(a[2], inv, MG)), q3 = __float_as_uint(fmaf(a[3], inv, MG));
                    const unsigned q4 = __float_as_uint(fmaf(b[0], inv, MG)), q5 = __float_as_uint(fmaf(b[1], inv, MG)), q6 = __float_as_uint(fmaf(b[2], inv, MG)), q7 = __float_as_uint(fmaf(b[3], inv, MG));
                    const unsigned w0 = __builtin_amdgcn_perm(__builtin_amdgcn_perm(q3, q2, 0x0c0c0400u), __builtin_amdgcn_perm(q1, q0, 0x0c0c0400u), 0x05040100u);
                    const unsigned w1 = __builtin_amdgcn_perm(__builtin_amdgcn_perm(q7, q6, 0x0c0c0400u), __builtin_amdgcn_perm(q5, q4, 0x0c0c0400u), 0x05040100u);
                    *(v2u*)(O + (size_t)row * D + col) = (v2u){w0, w1};
                    if (fq == 0) SC[(size_t)row * 32 + (col >> 5)] = mx * (1.0f / 127.0f); }
                asm volatile("" ::: "memory"); }
    }
};
}

#define XB_TMO      128
#define XB_XCNT(j)  (256  + 64 * (j))
#define XB_XSUB(j)  (1280 + 64 * (j))
#define XB_XGEN(j)  (2304 + 64 * (j))
#define XB_TOP      3328
#define XB_TOPGEN   3392
#define XCD_BAR_WORDS 3456
#define XB_SPIN_CAP (1u << 18)
__device__ __forceinline__ unsigned xb_ld(unsigned* p)              { return __hip_atomic_load(p, __ATOMIC_RELAXED, __HIP_MEMORY_SCOPE_AGENT); }
__device__ __forceinline__ unsigned xb_add(unsigned* p, unsigned v) { return __hip_atomic_fetch_add(p, v, __ATOMIC_RELAXED, __HIP_MEMORY_SCOPE_AGENT); }
__device__ __forceinline__ unsigned xb_xcc_id() { return (unsigned)__builtin_amdgcn_s_getreg((3 << 11) | 20) & 0xFu; }
#define XB_SPIN(cond, bar) do { unsigned _sp = 0; while (cond) { __builtin_amdgcn_s_sleep(1); \
    if ((++_sp & 255u) == 0u) { if (xb_ld(&(bar)[XB_TMO])) break; if (_sp > XB_SPIN_CAP) { atomicAdd(&(bar)[XB_TMO], 1u); break; } } } } while (0)
struct XcdBarrier { unsigned* bar; unsigned x; volatile LAS unsigned* st; };
__device__ __forceinline__ XcdBarrier xcd_barrier_post(unsigned* bar, volatile LAS unsigned* st) {
    XcdBarrier b; b.bar = bar; b.x = xb_xcc_id(); b.st = st;
    if (threadIdx.x == 0) (void)xb_add(&bar[XB_XCNT(b.x)], 1u);
    return b;
}
__device__ __forceinline__ void xcd_barrier_complete(unsigned* bar, unsigned x, unsigned& nloc, unsigned& nx) {
    const unsigned G = gridDim.x * gridDim.y * gridDim.z;
    unsigned sum, cnt, mine, sp = 0u;
    for (;;) {
        sum = 0u; cnt = 0u; mine = 0u;
#pragma unroll
        for (unsigned j = 0; j < 16; ++j) { const unsigned c = xb_ld(&bar[XB_XCNT(j)]); sum += c; cnt += (c > 0u) ? 1u : 0u; mine = (j == x) ? c : mine; }
        if (sum == G) break;
        __builtin_amdgcn_s_sleep(1);
        if ((++sp & 255u) == 0u) { if (xb_ld(&bar[XB_TMO])) break; if (sp > XB_SPIN_CAP) { atomicAdd(&bar[XB_TMO], 1u); break; } }
    }
    nloc = mine > 0u ? mine : 1u; nx = cnt > 0u ? cnt : 1u;
}
__device__ __forceinline__ void xcd_barrier(const XcdBarrier& b, int tid_) {
    asm volatile("s_waitcnt vmcnt(0)" ::: "memory");
    __syncthreads();
    if (tid_ == 0) {
        unsigned* bar = b.bar;
        __builtin_amdgcn_s_waitcnt(0);
        unsigned nloc = b.st[0], nx = b.st[1];
        if (nloc == 0u) { xcd_barrier_complete(bar, b.x, nloc, nx); b.st[0] = nloc; b.st[1] = nx; }
        const unsigned old = xb_add(&bar[XB_XSUB(b.x)], 1u);
        const unsigned gen = old / nloc;
        if (old + 1u == (gen + 1u) * nloc) {
            __builtin_amdgcn_fence(__ATOMIC_RELEASE, "agent");
            asm volatile("s_waitcnt vmcnt(0)" ::: "memory");
            const unsigned og = xb_add(&bar[XB_TOP], 1u);
            const unsigned tg = og / nx;
            if (og + 1u == (tg + 1u) * nx) xb_add(&bar[XB_TOPGEN], 1u);
            else XB_SPIN(xb_ld(&bar[XB_TOPGEN]) == tg, bar);
            __builtin_amdgcn_fence(__ATOMIC_ACQUIRE, "agent");
            xb_add(&bar[XB_XGEN(b.x)], 1u);
            asm volatile("s_waitcnt vmcnt(0)" ::: "memory");
        } else {
            XB_SPIN(xb_ld(&bar[XB_XGEN(b.x)]) == gen, bar);
            __builtin_amdgcn_fence(__ATOMIC_ACQUIRE, "agent");
            asm volatile("s_waitcnt vmcnt(0)" ::: "memory");
        }
    }
    __syncthreads();
}

template <int CM> __device__ __forceinline__ void wconv_item(const float* W, int K, int Nsrc, int N, bf16* WT, LAS float* scr, int item, int lane, int nvalid) {
    const int nblk = N / 32, kb = item / nblk, nb = item % nblk, k0 = 64 * kb, n0 = 32 * nb;
    const int nn = n0 + (lane & 31);
    const int sc = CM == 1 ? win_src_col(nn) : (CM == 2 ? w1_src_col(nn) : (CM == 3 ? (nn < nvalid ? nn : -1) : nn));
    float ld[32];
#pragma unroll
    for (int i = 0; i < 32; ++i) { const int kk = 2 * i + (lane >> 5); ld[i] = sc >= 0 ? W[(size_t)(k0 + kk) * Nsrc + sc] : 0.f; }
#pragma unroll
    for (int i = 0; i < 32; ++i) { const int kk = 2 * i + (lane >> 5); scr[kk * 33 + (lane & 31)] = ld[i]; }
    LDS_WAIT(); asm volatile("" ::: "memory");
    const int cch = lane & 7;
#pragma unroll
    for (int j = 0; j < 4; ++j) { const int n = (lane >> 3) + 8 * j; const LAS float* s = scr + (8 * cch) * 33 + n;
        v4u o; o.x = f2bf_bits(s[0 * 33]) | (f2bf_bits(s[1 * 33]) << 16); o.y = f2bf_bits(s[2 * 33]) | (f2bf_bits(s[3 * 33]) << 16);
        o.z = f2bf_bits(s[4 * 33]) | (f2bf_bits(s[5 * 33]) << 16); o.w = f2bf_bits(s[6 * 33]) | (f2bf_bits(s[7 * 33]) << 16);
        *(v4u*)(WT + (size_t)(n0 + n) * K + k0 + 8 * cch) = o; }
    LDS_WAIT(); asm volatile("" ::: "memory");
}
template <int CM  > __device__ __forceinline__ void wconv_item_q8(const float* W, int K, int Nsrc, int N, signed char* WQ, const float* colscale, LAS float* scr, int item, int lane) {
    const int nblk = N / 32, kb = item / nblk, nb = item % nblk, k0 = 64 * kb, n0 = 32 * nb;
    const int sc = CM == 1 ? win_src_col(n0 + (lane & 31)) : w1_src_col(n0 + (lane & 31));
    float ld[32];
#pragma unroll
    for (int i = 0; i < 32; ++i) { const int kk = 2 * i + (lane >> 5); ld[i] = sc >= 0 ? W[(size_t)(k0 + kk) * Nsrc + sc] : 0.f; }
#pragma unroll
    for (int i = 0; i < 32; ++i) { const int kk = 2 * i + (lane >> 5); scr[kk * 33 + (lane & 31)] = ld[i]; }
    LDS_WAIT(); asm volatile("" ::: "memory");
#pragma unroll
    for (int j = 0; j < 2; ++j) { const int idx = lane + 64 * j, n = idx >> 2, cch = idx & 3; const float cs_ = colscale[CM == 1 ? n0 + n : w1_src_col(n0 + n)]; const float inv = cs_ > 0.f ? 127.0f / cs_ : 1.0f;     const LAS float* sp = scr + (16 * cch) * 33 + n; unsigned o[4];
#pragma unroll
        for (int w4 = 0; w4 < 4; ++w4) { unsigned pk = 0u;
#pragma unroll
            for (int e = 0; e < 4; ++e) { const int q = (int)__builtin_rintf(fminf(fmaxf(sp[(4 * w4 + e) * 33] * inv, -127.f), 127.f)); pk |= ((unsigned)q & 0xffu) << (8 * e); }
            o[w4] = pk; }
        *(v4u*)(WQ + (size_t)(n0 + n) * K + k0 + 16 * cch) = (v4u){o[0], o[1], o[2], o[3]}; }
    LDS_WAIT(); asm volatile("" ::: "memory");
}
template <int CM> __device__ __forceinline__ void wconv_mat(const float* W, int K, int Nsrc, int N, bf16* WT, LAS float* scr, int gw, int ngw, int lane, int nvalid = 0) {
    const int nit = (K / 64) * (N / 32);
    for (int it = gw; it < nit; it += ngw) wconv_item<CM>(W, K, Nsrc, N, WT, scr, it, lane, nvalid);
}

constexpr int NTHR_ = 512;

__device__ __forceinline__ void rk_build(const Ctx& c, LAS unsigned char* lds, int tid, int G, int bid) {
    const int lane = tid & 63, wave = __builtin_amdgcn_readfirstlane(tid >> 6); LAS float* T = (LAS float*)(lds + wave * 8704);
    const float* HF = wsp<float>(c, WS_HF); float* NP_ = wsp<float>(c, WS_NRMP);
    constexpr int NTB = RKT_LAT + RKT_CTX, NTILE = DEPTH * 2 * 2 * 12 * NTB;
    for (int tile = bid * 8 + wave; tile < NTILE; tile += G * 8) { int q = tile; const int tb = q % NTB; q /= NTB; const int cg = q % 12; q /= 12; const int dir = q % 2; q /= 2; const int o = q % 2, l = q / 2;
        const int ls = tb < RKT_LAT ? 0 : 1, tblk = ls ? tb - RKT_LAT : tb, L = ls ? CTXL : SEQ, pb = ls ? SEQ : 0, RKP = ls ? RKP1 : RKP0, t0 = tblk * 64;
        const float* src = HF + ((size_t)l * NPOS + pb + t0) * 1536 + o * 768 + dir * DH + cg * 32;
        { float ld[32];
#pragma unroll
          for (int i = 0; i < 32; ++i) ld[i] = src[(size_t)(2 * i + (lane >> 5)) * 1536 + (lane & 31)];
#pragma unroll
          for (int i = 0; i < 32; ++i) T[(2 * i + (lane >> 5)) * 33 + (lane & 31)] = ld[i]; }
        LDS_WAIT(); asm volatile("" ::: "memory");
        bf16* RK = wsp<bf16>(c, ls ? WS_RK1 : WS_RK0);
        float asum = 0.f;
        if (lane < 32) { for (int tt = 0; tt < 64; ++tt) { const float v = fabsf(T[tt * 33 + lane]); if (!(dir == 1 && t0 + tt == 0)) asum += v; }
            NP_[(((((size_t)l * 2 + ls) * 2 + o) * DH + cg * 32 + lane) * 64) + dir * 32 + tblk] = asum; }
        for (int cc = 0; cc < 32; ++cc) { bf16* row = RK + ((((size_t)l * 2 + o) * DH + cg * 32 + cc) * 2) * RKP;
            const int t = t0 + lane; const float v = T[lane * 33 + cc];
            if (!(dir == 1 && t == 0)) { const int n = dir ? L - 1 + t : L - 1 - t; const bf16 hv = f2bf(v); row[n] = hv; if (n >= 1) row[RKP + n - 1] = hv; } }
        LDS_WAIT(); asm volatile("" ::: "memory"); }
    for (int ls = 0; ls < 2; ++ls) { const int L = ls ? CTXL : SEQ, RKP = ls ? RKP1 : RKP0, ntail = RKP - (2 * L - 2); bf16* RK = wsp<bf16>(c, ls ? WS_RK1 : WS_RK0);
        for (long it = (long)bid * NTHR_ + tid; it < (long)DEPTH * 2 * DH * 2 * ntail; it += (long)G * NTHR_) { const int i = (int)(it % ntail); const long rowi = it / ntail; const int par = (int)(rowi % 2);
            const int idx = 2 * L - 1 - par + i; if (idx < RKP) RK[rowi * RKP + idx] = 0; } }
}
__device__ __forceinline__ void s5gen1_fast(const Ctx& c, int tid, int G, int bid) {
    const float* TAB = wsp<float>(c, WS_S5TAB); float* KD = wsp<float>(c, WS_KD);
    for (int it = bid * 512 + tid; it < DEPTH * S5G * 2 * 256 * 8; it += G * 512) { const int pp = it & 7, r = it >> 3; const int m = r % 16, n = (r / 16) % 16, d = (r / 256) % 2, g = (r / 512) % S5G, l = r / (512 * S5G);
        float acc[S5T];
#pragma unroll
        for (int j = 0; j < S5T; ++j) acc[j] = 0.f;
        { const int p0 = pp * 8; float t0[8], t1[8], t2[8], t3[8], brv[8], biv[8], crv[8], civ[8];
#pragma unroll
            for (int u = 0; u < 8; ++u) { const int p = p0 + u; const float* tb = TAB + ((((size_t)l * 2 + d) * S5G + g) * S5P + p) * 4; t0[u] = tb[0]; t1[u] = tb[1]; t2[u] = tb[2]; t3[u] = tb[3];
                const size_t bi = (((size_t)l * S5G + g) * S5P + p) * S5N + m, ci = (((size_t)l * S5G + g) * S5N + n) * S5P + p;
                brv[u] = c.in[I_BRE][bi]; biv[u] = c.in[I_BIM][bi]; crv[u] = c.in[I_CRE][ci]; civ[u] = c.in[I_CIM][ci]; }
#pragma unroll
            for (int u = 0; u < 8; ++u) { const float bbr = t2[u] * brv[u] - t3[u] * biv[u], bbi = t2[u] * biv[u] + t3[u] * brv[u];
                float zr = crv[u] * bbr - civ[u] * bbi, zi = crv[u] * bbi + civ[u] * bbr;
                const float mg = expf(t0[u]), lbr = mg * cosf(t1[u]), lbi = mg * sinf(t1[u]);
#pragma unroll
                for (int j = 0; j < S5T; ++j) { acc[j] += zr; const float t = zr * lbr - zi * lbi; zi = zr * lbi + zi * lbr; zr = t; } } }
#pragma unroll
        for (int j = 0; j < S5T; ++j) { acc[j] += __shfl_xor(acc[j], 1); acc[j] += __shfl_xor(acc[j], 2); acc[j] += __shfl_xor(acc[j], 4); }
#pragma unroll
        for (int j = 0; j < S5T; ++j) if ((j & 7) == pp) KD[((((size_t)l * S5G + g) * 2 + d) * S5T + j) * 256 + n * 16 + m] = acc[j]; }
}
__device__ __forceinline__ void modp_fast(const Ctx& c, LAS unsigned char* lds, int tid, int G, int bid) {
    const float* SL = wsp<float>(c, WS_SILU); float* MP = wsp<float>(c, WS_MODP); LAS float* S = (LAS float*)lds;
    constexpr int NKS = 16, KS = D / NKS;
    static_assert((DEPTH * 6144) % 512 == 0, "a workgroup's items share the k slice");
    for (int it0 = bid * 512; it0 < NKS * DEPTH * 6144; it0 += G * 512) { const int it = it0 + tid, ks = it0 / (DEPTH * 6144);
        __syncthreads();
        for (int i = tid; i < NMOD * KS; i += 512) { const int m = i / KS, k = i % KS; S[k * NMOD + m] = SL[m * D + ks * KS + k]; }
        __syncthreads();
        const int col = it % 6144, l = (it / 6144) % DEPTH;
        const float* w = c.in[I_ADAW] + ((size_t)l * D + ks * KS) * 6144 + col;
        float acc[NMOD];
#pragma unroll
        for (int m = 0; m < NMOD; ++m) acc[m] = 0.f;
        for (int k0 = 0; k0 < KS; k0 += 32) { float wv[32];
#pragma unroll
            for (int u = 0; u < 32; ++u) wv[u] = w[(size_t)(k0 + u) * 6144];
#pragma unroll
            for (int u = 0; u < 32; ++u)
#pragma unroll
                for (int m = 0; m < NMOD; ++m) acc[m] += S[(k0 + u) * NMOD + m] * wv[u]; }
#pragma unroll
        for (int m = 0; m < NMOD; ++m) MP[(((size_t)ks * DEPTH + l) * NMOD + m) * 6144 + col] = acc[m]; }
    __syncthreads();
}
__device__ __forceinline__ void wmax_part(const Ctx& c, int bid, int G, int tid) {
    unsigned* MX = wsp<unsigned>(c, WS_CTL) + CW_WMX;
    for (int it = bid * 512 + tid; it < DEPTH * 16 * NP; it += G * 512) { const int n = it % NP, kp = (it / NP) % 16, l = it / (16 * NP), sc = win_src_col(n);
        if (sc < 0) continue;
        const float* w = c.in[I_WIN] + (size_t)l * D * NIN + (size_t)(kp * 64) * NIN + sc; float mx = 0.f;
        for (int k0 = 0; k0 < 64; k0 += 16) { float v[16];
#pragma unroll
            for (int u = 0; u < 16; ++u) v[u] = w[(size_t)(k0 + u) * NIN];
#pragma unroll
            for (int u = 0; u < 16; ++u) mx = fmaxf(mx, fabsf(v[u])); }
        atomicMax(MX + l * NP + n, __float_as_uint(mx)); }
}
__device__ __forceinline__ void w1max_part(const Ctx& c, int l, int e0, int rank, int nidle, int tid) {
    unsigned* MX = wsp<unsigned>(c, WS_CTL) + CW_W1MX + ((size_t)l * NE + e0) * 1024; const float* W = c.in[I_W1] + ((size_t)l * NE + e0) * D * 1024;
    for (int it = rank * 512 + tid; it < 16 * 1024 * 16; it += nidle * 512) { const int col = it & 16383, kp = it >> 14, e = col >> 10, n = col & 1023;
        const float* w = W + (size_t)e * D * 1024 + (size_t)(kp * 64) * 1024 + n; float mx = 0.f;
        for (int k0 = 0; k0 < 64; k0 += 16) { float v[16];
#pragma unroll
            for (int u = 0; u < 16; ++u) v[u] = w[(size_t)(k0 + u) * 1024];
#pragma unroll
            for (int u = 0; u < 16; ++u) mx = fmaxf(mx, fabsf(v[u])); }
        atomicMax(MX + col, __float_as_uint(mx)); }
}
__device__ __forceinline__ void w1max_tail(const Ctx& c, int l, int e0, LAS unsigned char* lds, int tid, int G, int bid) {
    const int nblk = ((const LAS int*)(lds + 132096))[0]; int rank = bid, nidle = G; bool part = true;
    if (G == 256) { const int x = bid & 7, j = bid >> 3; nidle = 0; rank = 0;
        for (int xx = 0; xx < 8; ++xx) { const int nbx = (nblk - xx + 7) >> 3, rem = (nbx * 4) & 31, idl = 32 - rem; if (xx < x) rank += idl; if (xx == x) { part = j >= rem; rank += j - rem; } nidle += idl; } }
    if (part) w1max_part(c, l, e0, rank, nidle, tid);
}
__device__ __forceinline__ void moe_wconv(const Ctx& c, int l, LAS float* scr, int lo, int hi, int gw, int ngw, int lane) {
    constexpr int I1 = (D / 64) * (1024 / 32), I2 = (FF / 64) * (D / 32);
    for (int it = lo + gw; it < hi; it += ngw) { const int e = it / (I1 + I2), r = it % (I1 + I2);
        if (r < I1) wconv_item_q8<2>(c.in[I_W1] + ((size_t)l * NE + e) * D * 1024, D, 1024, 1024, wsp<signed char>(c, WS_W1T) + (size_t)e * 1024 * D, wsp<float>(c, WS_CTL) + CW_W1MX + ((size_t)l * NE + e) * 1024, scr, r, lane);
        else wconv_item<0>(c.in[I_W2] + ((size_t)l * NE + e) * FF * D, FF, D, D, wsp<bf16>(c, WS_W2T) + (size_t)e * D * FF, scr, r - I1, lane, 0); }
}
constexpr int MOE_WITEMS = NE * ((D / 64) * (1024 / 32) + (FF / 64) * (D / 32)), MOE_WS0 = 2304, MOE_WS1 = MOE_WS0 + 10240, MOE_WS2 = MOE_WS1 + 5120, MOE_WS3 = MOE_WS2 + 6912;

typedef short bf16x8_t __attribute__((ext_vector_type(8)));
typedef float f32x4_t __attribute__((ext_vector_type(4)));
typedef unsigned v4u_a4 __attribute__((ext_vector_type(4), aligned(4)));
__device__ __forceinline__ void hyf2_mfma(const Ctx& c, int tid, int G, int bid) {
    const int lane = tid & 63, wave = tid >> 6, m = lane & 15, q = lane >> 4;
    const float* HD2 = wsp<float>(c, WS_HD2); float* HF = wsp<float>(c, WS_HF);
    static_assert(NPOS % (16 * 16) == 0 && SEQ % 16 == 0, "position tiles");
    constexpr int NJT = 1536 / 16, NPT = NPOS / 16, PP = 16, TPI = NPT / PP;
    for (int it = bid * 8 + wave; it < DEPTH * NJT * PP; it += G * 8) { const int part = it % PP, jt = (it / PP) % NJT, l = it / (PP * NJT); const int j = 16 * jt + m;
        bf16x8_t Bh[2], Bl[2];
#pragma unroll
        for (int ks = 0; ks < 2; ++ks) { float w[8]; unsigned hb[8], lb[8];
#pragma unroll
            for (int e = 0; e < 8; ++e) w[e] = c.in[I_HW3][(size_t)l * 64 * 1536 + (size_t)(32 * ks + 8 * q + e) * 1536 + j];
#pragma unroll
            for (int e = 0; e < 8; ++e) { hb[e] = f2bf_bits(w[e]); lb[e] = f2bf_bits(w[e] - __uint_as_float(hb[e] << 16)); }
            Bh[ks] = __builtin_bit_cast(bf16x8_t, (v4u){hb[0] | (hb[1] << 16), hb[2] | (hb[3] << 16), hb[4] | (hb[5] << 16), hb[6] | (hb[7] << 16)});
            Bl[ks] = __builtin_bit_cast(bf16x8_t, (v4u){lb[0] | (lb[1] << 16), lb[2] | (lb[3] << 16), lb[4] | (lb[5] << 16), lb[6] | (lb[7] << 16)}); }
        const float b3 = c.in[I_HB3][l * 1536 + j]; const int ch = j % DH;
        const float dmin = -3.0701134573253940f, dmax = -15.350567286626973f;
        const float delta = fabsf(dmin + (float)ch * ((dmax - dmin) / 383.0f));
#pragma unroll 3
        for (int pt = part * TPI; pt < (part + 1) * TPI; ++pt) { const int pos0 = 16 * pt; const float* h = HD2 + ((size_t)l * NPOS + pos0 + m) * 64 + 8 * q;
            f32x4_t acc = (f32x4_t){0.f, 0.f, 0.f, 0.f};
#pragma unroll
            for (int ks = 0; ks < 2; ++ks) { const f32x4_t a0 = *(const f32x4_t*)(h + 32 * ks), a1 = *(const f32x4_t*)(h + 32 * ks + 4); const float av[8] = {a0[0], a0[1], a0[2], a0[3], a1[0], a1[1], a1[2], a1[3]}; unsigned hb[8], lb[8];
#pragma unroll
                for (int e = 0; e < 8; ++e) { hb[e] = f2bf_bits(av[e]); lb[e] = f2bf_bits(av[e] - __uint_as_float(hb[e] << 16)); }
                const bf16x8_t Ah = __builtin_bit_cast(bf16x8_t, (v4u){hb[0] | (hb[1] << 16), hb[2] | (hb[3] << 16), hb[4] | (hb[5] << 16), hb[6] | (hb[7] << 16)});
                const bf16x8_t Al = __builtin_bit_cast(bf16x8_t, (v4u){lb[0] | (lb[1] << 16), lb[2] | (lb[3] << 16), lb[4] | (lb[5] << 16), lb[6] | (lb[7] << 16)});
                acc = __builtin_amdgcn_mfma_f32_16x16x32_bf16(Ah, Bh[ks], acc, 0, 0, 0); acc = __builtin_amdgcn_mfma_f32_16x16x32_bf16(Al, Bh[ks], acc, 0, 0, 0); acc = __builtin_amdgcn_mfma_f32_16x16x32_bf16(Ah, Bl[ks], acc, 0, 0, 0); }
            const int L = pos0 < SEQ ? SEQ : CTXL, t0 = (pos0 < SEQ ? pos0 : pos0 - SEQ) + 4 * q;
#pragma unroll
            for (int jj = 0; jj < 4; ++jj) HF[((size_t)l * NPOS + pos0 + 4 * q + jj) * 1536 + j] = (acc[jj] + b3) * expf(-((float)(t0 + jj) / (float)(L - 1)) * delta); } }
}
constexpr int HP_PITCH = 772;
__device__ __forceinline__ void chan_pos(int r0, int& b, int& pos) { if (r0 < NTL) { b = r0 / SEQ; pos = r0 % SEQ; } else { const int q = r0 - NTL; b = q / CTXL; pos = SEQ + q % CTXL; } }
__device__ __forceinline__ void hy_prep(const Ctx& c, int l, LAS unsigned char* lds, int tid, int G, int bid) {
    const bf16* P = wsp<bf16>(c, WS_P); const int lane = tid & 63, wave = __builtin_amdgcn_readfirstlane(tid >> 6);
    for (int unit = bid; unit < (NT / 128) * 3; unit += G) { const int tile = unit / 3, part = unit % 3, r0 = tile * 128;
        { v4u sv[13];
#pragma unroll
          for (int k = 0; k < 13; ++k) { const int i = tid + k * NTHR_, rr = i / 48, ch = i % 48, r = r0 - 1 + rr; sv[k] = (v4u){0u, 0u, 0u, 0u};
              if (i < 130 * 48 && r >= 0 && r < NT) sv[k] = *(const v4u*)(P + (size_t)r * NP + PC_HY + part * DH + ch * 8); }
#pragma unroll
          for (int k = 0; k < 13; ++k) { const int i = tid + k * NTHR_, rr = i / 48, ch = i % 48;
              if (i < 130 * 48) { LAS unsigned* d = (LAS unsigned*)(lds + rr * HP_PITCH + ch * 16); d[0] = sv[k].x; d[1] = sv[k].y; d[2] = sv[k].z; d[3] = sv[k].w; } } }
        __syncthreads();
        int b, pos0; chan_pos(r0, b, pos0);
        const int ra = r0 + 2 * lane, rb = ra + 1;
        const float hp0 = has_prev(ra) ? 1.f : 0.f, hn0 = has_next(ra) ? 1.f : 0.f, hp1 = has_prev(rb) ? 1.f : 0.f, hn1 = has_next(rb) ? 1.f : 0.f;
        bf16* dst = wsp<bf16>(c, part == 0 ? WS_VT : (part == 1 ? WS_X1T : WS_X2T));
        const float* cw = c.in[I_HYCW] + (size_t)l * 3 * 1152 + part * DH; const float* cb = c.in[I_HYCB] + l * 1152 + part * DH;
        for (int cc = wave; cc < DH; cc += 8) {
            const LAS bf16* col = (const LAS bf16*)(lds + 2 * lane * HP_PITCH + cc * 2);
            const float xm = bf2f(col[0]), x0 = bf2f(col[HP_PITCH / 2]), x1 = bf2f(col[HP_PITCH]), x2 = bf2f(col[3 * (HP_PITCH / 2)]);
            const float w0 = cw[cc], w1 = cw[1152 + cc], w2 = cw[2304 + cc], bb = cb[cc];
            const float y0 = bb + w0 * xm * hp0 + w1 * x0 + w2 * x1 * hn0, y1 = bb + w0 * x0 * hp1 + w1 * x1 + w2 * x2 * hn1;
            *(unsigned*)(dst + ((size_t)cc * NB + b) * NPOS + pos0 + 2 * lane) = f2bf_bits(y0) | (f2bf_bits(y1) << 16); }
        __syncthreads(); }
}
template <int LS> __device__ __forceinline__ void hy_conv_seq(const Ctx& c, int l, int cc, LAS unsigned char* lds, int tid) {
    constexpr int L = LS ? CTXL : SEQ, PB = LS ? SEQ : 0, RKP = LS ? RKP1 : RKP0;
    constexpr int CP = (2 * L + 16) * 2, ZP = (L + 8) * 2, Z_OFF = 8 * CP, NST = L / 32, NTB = L / 128;
    static_assert(Z_OFF + 16 * ZP <= 147200 && (CP % 256) == 32, "hyena LDS map");
    const int lane = tid & 63, wave = __builtin_amdgcn_readfirstlane(tid >> 6), m = lane & 15, q = lane >> 4;
    const bf16* VT = wsp<bf16>(c, WS_VT); const bf16* X1T = wsp<bf16>(c, WS_X1T); const bf16* X2T = wsp<bf16>(c, WS_X2T); bf16* Z1T = wsp<bf16>(c, WS_Z1T); bf16* HYT = wsp<bf16>(c, WS_HYT);
    const size_t rowb = ((size_t)cc * NB) * NPOS + PB;
#pragma unroll 1
    for (int o = 0; o < 2; ++o) {
        const bf16* RK = wsp<bf16>(c, LS ? WS_RK1 : WS_RK0) + ((((size_t)l * 2 + o) * DH + cc) * 2) * RKP;
        const bf16* Zs = o == 0 ? VT : Z1T;
        { constexpr int NF = (8 * (CP / 16) + NTHR_ - 1) / NTHR_, NZ = (16 * (L / 8) + NTHR_ - 1) / NTHR_;
          v4u_a4 fv[NF]; v4u zv[NZ];
#pragma unroll
          for (int u = 0; u < NF; ++u) { const int i = tid + u * NTHR_, j = i / (CP / 16), k = i % (CP / 16); fv[u] = (v4u_a4){0u, 0u, 0u, 0u};
              if (i < 8 * (CP / 16)) fv[u] = *(const v4u_a4*)(RK + (size_t)(j & 1) * RKP + k * 8 + (j & ~1)); }
#pragma unroll
          for (int u = 0; u < NZ; ++u) { const int i = tid + u * NTHR_, b = i / (L / 8), k = i % (L / 8); zv[u] = (v4u){0u, 0u, 0u, 0u};
              if (i < 16 * (L / 8)) zv[u] = *(const v4u*)(Zs + rowb + (size_t)b * NPOS + k * 8); }
#pragma unroll
          for (int u = 0; u < NF; ++u) { const int i = tid + u * NTHR_, j = i / (CP / 16), k = i % (CP / 16); if (i < 8 * (CP / 16)) *(LAS v4u*)(lds + j * CP + k * 16) = (v4u){fv[u].x, fv[u].y, fv[u].z, fv[u].w}; }
#pragma unroll
          for (int u = 0; u < NZ; ++u) { const int i = tid + u * NTHR_, b = i / (L / 8), k = i % (L / 8); if (i < 16 * (L / 8)) *(LAS v4u*)(lds + Z_OFF + b * ZP + k * 16) = zv[u]; } }
        __syncthreads();
        const float bias = c.in[I_HBIAS][(l * 2 + o) * DH + cc];
        float inv; { const float* np = wsp<float>(c, WS_NRMP) + ((((size_t)l * 2 + LS) * 2 + o) * DH + cc) * 64; constexpr int NTBK = LS ? RKT_CTX : RKT_LAT; float sn = 0.f;
            for (int i = 0; i < NTBK; ++i) sn += np[i] + np[32 + i];
            inv = 1.0f / sn; }
        const int jc = (7 - m) & 7;
        for (int tb = wave; tb < NTB; tb += 8) {
            const int abase = jc * CP + 2 * ((m < 8 ? -7 : -15) + L - 1 - 128 * tb) + 16 * q, zbase = Z_OFF + m * ZP + 16 * q;
#define HY_LDA(k) (*(const LAS bf16x8_t*)(lds + abase + 32 * (k)))
            bf16x8_t win[8]; f32x4_t acc[8];
#pragma unroll
            for (int i = 0; i < 8; ++i) acc[i] = (f32x4_t){0.f, 0.f, 0.f, 0.f};
#pragma unroll
            for (int k = -7; k <= -2; ++k) win[(k + 8) & 7] = HY_LDA(k);
#pragma unroll 1
            for (int b4 = 0; b4 < NST / 4; ++b4) {
#pragma unroll
                for (int u = 0; u < 4; ++u) { const int st = 4 * b4 + u;
                    win[(2 * u) & 7] = HY_LDA(2 * st); win[(2 * u + 7) & 7] = HY_LDA(2 * st - 1);
                    const bf16x8_t zf = *(const LAS bf16x8_t*)(lds + zbase + 64 * st);
#pragma unroll
                    for (int i = 0; i < 8; ++i) acc[i] = __builtin_amdgcn_mfma_f32_16x16x32_bf16(win[(2 * u - i + 8) & 7], zf, acc[i], 0, 0, 0); } }
#undef HY_LDA
            const bf16* Xg = (o == 0 ? X1T : X2T) + rowb + (size_t)m * NPOS; bf16* Og = (o == 0 ? Z1T : HYT) + rowb + (size_t)m * NPOS;
#pragma unroll
            for (int i = 0; i < 8; ++i) { const int t = 128 * tb + 16 * i + 4 * q;
                const v2u xg = *(const v2u*)(Xg + t); const v2u zl = *(const LAS v2u*)(lds + Z_OFF + m * ZP + 2 * t);
                const float x0 = __uint_as_float(xg.x << 16), x1 = __uint_as_float(xg.x & 0xffff0000u), x2 = __uint_as_float(xg.y << 16), x3 = __uint_as_float(xg.y & 0xffff0000u);
                const float z0 = __uint_as_float(zl.x << 16), z1 = __uint_as_float(zl.x & 0xffff0000u), z2 = __uint_as_float(zl.y << 16), z3 = __uint_as_float(zl.y & 0xffff0000u);
                v2u w; w.x = f2bf_bits(x0 * (acc[i][0] * inv + bias * z0)) | (f2bf_bits(x1 * (acc[i][1] * inv + bias * z1)) << 16);
                w.y = f2bf_bits(x2 * (acc[i][2] * inv + bias * z2)) | (f2bf_bits(x3 * (acc[i][3] * inv + bias * z3)) << 16);
                *(v2u*)(Og + t) = w; } }
        __syncthreads();
    }
}
__device__ __forceinline__ void hy_conv(const Ctx& c, int l, LAS unsigned char* lds, int tid, int G, int bid) {
    for (int cc = bid; cc < DH; cc += G) { hy_conv_seq<0>(c, l, cc, lds, tid); hy_conv_seq<1>(c, l, cc, lds, tid); }
}
__device__ __forceinline__ void hy_post(const Ctx& c, LAS unsigned char* lds, int tid, int G, int bid) {
    constexpr int TPB = 260;
    const bf16* HYT = wsp<bf16>(c, WS_HYT); bf16* HY = wsp<bf16>(c, WS_HY); const int lane = tid & 63, wave = __builtin_amdgcn_readfirstlane(tid >> 6);
    for (int tile = bid; tile < NT / 128; tile += G) { const int r0 = tile * 128; int b, pos0; chan_pos(r0, b, pos0);
        for (int c0 = wave; c0 < DH; c0 += 8 * 16) { unsigned hv[16];
#pragma unroll
            for (int u = 0; u < 16; ++u) { const int cc = c0 + 8 * u; hv[u] = cc < DH ? *(const unsigned*)(HYT + ((size_t)cc * NB + b) * NPOS + pos0 + 2 * lane) : 0u; }
#pragma unroll
            for (int u = 0; u < 16; ++u) { const int cc = c0 + 8 * u; if (cc < DH) *(LAS unsigned*)(lds + cc * TPB + 4 * lane) = hv[u]; } }
        __syncthreads();
        for (int i = tid; i < 128 * 48; i += NTHR_) { const int t = i % 128, ch = i / 128; const LAS bf16* s0 = (const LAS bf16*)(lds + (ch * 8) * TPB + 2 * t);
            v4u o; o.x = (unsigned)s0[0] | ((unsigned)s0[TPB / 2] << 16); o.y = (unsigned)s0[2 * (TPB / 2)] | ((unsigned)s0[3 * (TPB / 2)] << 16);
            o.z = (unsigned)s0[4 * (TPB / 2)] | ((unsigned)s0[5 * (TPB / 2)] << 16); o.w = (unsigned)s0[6 * (TPB / 2)] | ((unsigned)s0[7 * (TPB / 2)] << 16);
            *(v4u*)(HY + (size_t)(r0 + t) * DH + ch * 8) = o; }
        __syncthreads(); }
}

constexpr int ML_QS = 0, ML_KS = 13312, ML_KT = 26624, ML_VT = 40448, ML_VW = 49664, ML_SP = 58880, ML_CB = 68096, ML_VEC = 81408, ML_DEN = 83968, ML_SCAL = 84224, ML_CW = 84480;
constexpr int ML_P1 = 208, ML_P2 = 144;
__device__ __forceinline__ float fexp(float x) { return __builtin_amdgcn_exp2f(1.4426950408889634f * x); }
__device__ __forceinline__ void ml_prep(const Ctx& c, int l, int tid, int G, int bid) {
    if (tid >= 384) return;
    const int ch = tid % 96, tg = tid / 96; const bf16* P = wsp<bf16>(c, WS_P); bf16* QK = wsp<bf16>(c, WS_QKC);
    float w0[8], w1[8], w2[8], bb[8];
#pragma unroll
    for (int e = 0; e < 8; ++e) { const float* cw = c.in[I_MLCW] + (size_t)l * 3 * 768 + ch * 8 + e; w0[e] = cw[0]; w1[e] = cw[768]; w2[e] = cw[1536]; bb[e] = c.in[I_MLCB][l * 768 + ch * 8 + e]; }
    const float ksc = ch >= 48 ? 0.10206207261596575f : 1.0f;
    for (int g0 = bid; g0 < NT / 4; g0 += 4 * G) {
        v4u x0[4], xm[4], xp[4];
#pragma unroll
        for (int u = 0; u < 4; ++u) { const int grp = g0 + u * G; x0[u] = (v4u){0u, 0u, 0u, 0u}; xm[u] = x0[u]; xp[u] = x0[u];
            if (grp < NT / 4) { const int r = grp * 4 + tg; const bf16* src = P + (size_t)r * NP + PC_Q + ch * 8; x0[u] = *(const v4u*)src;
                if (has_prev(r)) xm[u] = *(const v4u*)(src - NP); if (has_next(r)) xp[u] = *(const v4u*)(src + NP); } }
#pragma unroll
        for (int u = 0; u < 4; ++u) { const int grp = g0 + u * G; if (grp < NT / 4) { const int r = grp * 4 + tg; unsigned o[4];
#pragma unroll
            for (int e2 = 0; e2 < 4; ++e2) { float y[2];
#pragma unroll
                for (int hh = 0; hh < 2; ++hh) { const int e = 2 * e2 + hh; const unsigned um = xm[u][e2], u0 = x0[u][e2], up = xp[u][e2];
                    const float fm = __uint_as_float(hh ? (um & 0xffff0000u) : (um << 16)), f0 = __uint_as_float(hh ? (u0 & 0xffff0000u) : (u0 << 16)), fp = __uint_as_float(hh ? (up & 0xffff0000u) : (up << 16));
                    float v = bb[e] + w0[e] * fm + w1[e] * f0 + w2[e] * fp; y[hh] = v * pg8::fsig(v) * ksc; }
                o[e2] = f2bf_bits(y[0]) | (f2bf_bits(y[1]) << 16); }
            *(v4u*)(QK + (size_t)r * 768 + ch * 8) = (v4u){o[0], o[1], o[2], o[3]}; } } }
}
constexpr int ML_GV = 87552, ML_MP = 133632, ML_DEC = 133776, ML_SC = 133920, ML_NCH = NPOS / 64;
static_assert(ML_SC + ML_NCH * 8 <= 147200, "mLSTM LDS map");
#define ML_BAR() do { asm volatile("s_waitcnt lgkmcnt(0)" ::: "memory"); __builtin_amdgcn_s_barrier(); asm volatile("" ::: "memory"); } while (0)
__device__ __forceinline__ void ml_chain(const Ctx& c, int l, LAS unsigned char* lds, int tid, int unit) {
    const int d = unit >> 7, b = (unit >> 3) & 15, h = (unit >> 1) & 3, half = unit & 1;
    const int lane = tid & 63, wave = __builtin_amdgcn_readfirstlane(tid >> 6), m16 = lane & 15, q = lane >> 4;
    const bf16* P = wsp<bf16>(c, WS_P); const bf16* QK = wsp<bf16>(c, WS_QKC); bf16* HFB = wsp<bf16>(c, WS_HFB) + (size_t)d * NT * DH + h * MLD + half * 48;
    LAS float* GV = (LAS float*)(lds + ML_GV); LAS float* DEN = (LAS float*)(lds + ML_DEN);
    LAS float* MP = (LAS float*)(lds + ML_MP); LAS float* DEC = (LAS float*)(lds + ML_DEC); LAS float* SC = (LAS float*)(lds + ML_SC);
    for (int i = tid; i < 16 * 64; i += NTHR_) { const int row = 48 + i / 64, j = i % 64; ((LAS bf16*)(lds + ML_VT + row * ML_P2))[j] = row == 48 ? (bf16)0x3F80 : (bf16)0; ((LAS bf16*)(lds + ML_VW + row * ML_P2))[j] = 0; }
    for (int i = tid; i < 64 * ML_P1 / 4; i += NTHR_) ((LAS unsigned*)(lds + ML_CB))[i] = 0u;
    const float gbi = c.in[I_MLGB][l * 16 + (2 * d) * 4 + h], gbf = c.in[I_MLGB][l * 16 + (2 * d + 1) * 4 + h];
    for (int ch = wave; ch < ML_NCH; ch += 8) { const int r = seq_tok(d, b, ch * 64 + lane);
        const float gi = bf2f(P[(size_t)r * NP + PC_GT + (2 * d) * 4 + h]) + gbi, gf = logsig(bf2f(P[(size_t)r * NP + PC_GT + (2 * d + 1) * 4 + h]) + gbf);
        float bc = gf;
#pragma unroll
        for (int o = 1; o < 64; o <<= 1) { const float y = __shfl_up(bc, o); if (lane >= o) bc += y; }
        const float a = gi - bc; float pm = a;
#pragma unroll
        for (int o = 1; o < 64; o <<= 1) { const float y = __shfl_up(pm, o); if (lane >= o) pm = fmaxf(pm, y); }
        LAS float* V = GV + ch * 320; V[lane] = a; V[64 + lane] = pm; V[256 + lane] = bc;
        if (lane == 63) { SC[2 * ch] = pm; SC[2 * ch + 1] = bc; } }
    __syncthreads();
    if (wave == 0) { float mp = -1e30f;
        for (int ch = 0; ch < ML_NCH; ++ch) { if (lane == 0) MP[ch] = mp; mp = SC[2 * ch + 1] + fmaxf(mp, SC[2 * ch]); } }
    __syncthreads();
    for (int ch = wave; ch < ML_NCH; ch += 8) { LAS float* V = GV + ch * 320; const float mp = MP[ch], a = V[lane], pm = V[64 + lane], bc = V[256 + lane];
        const float M = fmaxf(mp, pm), M63 = __shfl(M, 63);
        V[64 + lane] = M; V[128 + lane] = fexp(mp - M); V[192 + lane] = fexp(a - M63); V[256 + lane] = fexp(-(bc + M));
        if (lane == 0) DEC[ch] = fexp(mp - M63); }
    f32x4_t accC[3];
#pragma unroll
    for (int i = 0; i < 3; ++i) accC[i] = (f32x4_t){0.f, 0.f, 0.f, 0.f};
    v4u x0[3], xv;
#define ML_LOAD(chn) do { const int t0_ = (chn) * 64; \
        _Pragma("unroll") for (int it = 0; it < 3; ++it) { const int idx = tid + NTHR_ * it, j = idx & 63, c8 = idx >> 6, isk = c8 >= 12 ? 1 : 0, cc = c8 - 12 * isk; \
            const int r = seq_tok(d, b, t0_ + j); x0[it] = *(const v4u*)(QK + (size_t)r * 768 + isk * DH + h * MLD + cc * 8); } \
        if (tid < 384) { const int j = tid & 63, c6 = tid >> 6, r = seq_tok(d, b, t0_ + j); xv = *(const v4u*)(P + (size_t)r * NP + PC_V + h * MLD + half * 48 + c6 * 8); } } while (0)
    xv = (v4u){0u, 0u, 0u, 0u};
    ML_LOAD(0);
    __syncthreads();
    float oval[2][4];
#pragma unroll
    for (int i = 0; i < 2; ++i)
#pragma unroll
        for (int jj = 0; jj < 4; ++jj) oval[i][jj] = 0.f;
#define ML_STORE_PREV(tau_) do { const int tq_ = wave >> 1, dq_ = 2 * (wave & 1); \
        _Pragma("unroll") for (int i = 0; i < 2; ++i) if (dq_ + i < 3) { _Pragma("unroll") for (int jj = 0; jj < 4; ++jj) { const int r_ = seq_tok(d, b, (tau_) + 16 * tq_ + 4 * q + jj); HFB[(size_t)r_ * DH + 16 * (dq_ + i) + m16] = f2bf(oval[i][jj]); } } } while (0)
#pragma unroll 1
    for (int ch = 0; ch < ML_NCH; ++ch) {
        const int tau0 = ch * 64; LAS float* V = GV + ch * 320;
#pragma unroll
        for (int it = 0; it < 3; ++it) { const int idx = tid + NTHR_ * it, j = idx & 63, c8 = idx >> 6, isk = c8 >= 12 ? 1 : 0, cc = c8 - 12 * isk;
            *(LAS v4u*)(lds + (isk ? ML_KS : ML_QS) + j * ML_P1 + cc * 16) = x0[it];
            if (isk) {
#pragma unroll
                for (int e = 0; e < 8; ++e) ((LAS bf16*)(lds + ML_KT + (cc * 8 + e) * ML_P2))[j] = (bf16)((e & 1) ? (x0[it][e >> 1] >> 16) : (x0[it][e >> 1] & 0xffffu)); } }
        if (tid < 384) { const int j = tid & 63, c6 = tid >> 6; const float wj = V[192 + j];
#pragma unroll
            for (int e = 0; e < 8; ++e) { const unsigned u = xv[e >> 1]; const unsigned bits = (e & 1) ? (u >> 16) : (u & 0xffffu);
                ((LAS bf16*)(lds + ML_VT + (c6 * 8 + e) * ML_P2))[j] = (bf16)bits; ((LAS bf16*)(lds + ML_VW + (c6 * 8 + e) * ML_P2))[j] = f2bf(wj * __uint_as_float(bits << 16)); } }
        else if (tid < 448) { const int j = tid - 384; ((LAS bf16*)(lds + ML_VW + 48 * ML_P2))[j] = f2bf(V[192 + j]); }
        if (ch > 0) ML_STORE_PREV(tau0 - 64);
        if (ch + 1 < ML_NCH) ML_LOAD(ch + 1);
        ML_BAR();
        {
            const unsigned long long TS = 0x313210210100ull, TT = 0x203333222110ull;
#pragma unroll
            for (int rep = 0; rep < 2; ++rep) { const int idx = wave + 8 * rep; if (idx < 12) { const int st = (int)((TS >> (4 * idx)) & 15), tt = (int)((TT >> (4 * idx)) & 15);
                f32x4_t acc = (f32x4_t){0.f, 0.f, 0.f, 0.f};
                if (idx < 10) {
#pragma unroll
                    for (int ks = 0; ks < 3; ++ks) { const bf16x8_t a = *(const LAS bf16x8_t*)(lds + ML_KS + (16 * st + m16) * ML_P1 + (ks * 32 + 8 * q) * 2);
                        const bf16x8_t bq = *(const LAS bf16x8_t*)(lds + ML_QS + (16 * tt + m16) * ML_P1 + (ks * 32 + 8 * q) * 2); acc = __builtin_amdgcn_mfma_f32_16x16x32_bf16(a, bq, acc, 0, 0, 0); } }
                const int t = 16 * tt + m16, s0 = 16 * st + 4 * q; const float Mt = V[64 + t]; const f32x4_t a4 = *(const LAS f32x4_t*)(V + s0); float o[4];
#pragma unroll
                for (int jj = 0; jj < 4; ++jj) o[jj] = (idx < 10 && s0 + jj <= t) ? acc[jj] * fexp(a4[jj] - Mt) : 0.f;
                *(LAS v2u*)(lds + ML_SP + t * ML_P2 + s0 * 2) = (v2u){f2bf_bits(o[0]) | (f2bf_bits(o[1]) << 16), f2bf_bits(o[2]) | (f2bf_bits(o[3]) << 16)}; } }
        }
        const int tt = wave >> 1, dt0 = 2 * (wave & 1);
        f32x4_t accB[2], accA[2];
#pragma unroll
        for (int i = 0; i < 2; ++i) { accB[i] = (f32x4_t){0.f, 0.f, 0.f, 0.f}; accA[i] = (f32x4_t){0.f, 0.f, 0.f, 0.f}; }
#pragma unroll
        for (int ks = 0; ks < 3; ++ks) { const bf16x8_t a = *(const LAS bf16x8_t*)(lds + ML_QS + (16 * tt + m16) * ML_P1 + (ks * 32 + 8 * q) * 2);
#pragma unroll
            for (int i = 0; i < 2; ++i) { const bf16x8_t bb = *(const LAS bf16x8_t*)(lds + ML_CB + (16 * (dt0 + i) + m16) * ML_P1 + (ks * 32 + 8 * q) * 2); accB[i] = __builtin_amdgcn_mfma_f32_16x16x32_bf16(a, bb, accB[i], 0, 0, 0); } }
        ML_BAR();
#pragma unroll
        for (int ks = 0; ks < 2; ++ks) if (ks <= (tt >> 1)) { const bf16x8_t a = *(const LAS bf16x8_t*)(lds + ML_SP + (16 * tt + m16) * ML_P2 + (ks * 32 + 8 * q) * 2);
#pragma unroll
            for (int i = 0; i < 2; ++i) { const bf16x8_t bb = *(const LAS bf16x8_t*)(lds + ML_VT + (16 * (dt0 + i) + m16) * ML_P2 + (ks * 32 + 8 * q) * 2); accA[i] = __builtin_amdgcn_mfma_f32_16x16x32_bf16(a, bb, accA[i], 0, 0, 0); } }
        { const f32x4_t wa4 = *(const LAS f32x4_t*)(V + 128 + 16 * tt + 4 * q);
#pragma unroll
          for (int i = 0; i < 2; ++i) accA[i] = accA[i] + wa4 * accB[i];
          if (dt0 == 2 && m16 == 0) *(LAS f32x4_t*)(DEN + 16 * tt + 4 * q) = accA[1]; }
        { const float decay = DEC[ch]; const int dtile = wave >> 1, et0 = 3 * (wave & 1);
#pragma unroll
          for (int i = 0; i < 3; ++i) accC[i] = accC[i] * decay;
#pragma unroll
          for (int ks = 0; ks < 2; ++ks) { const bf16x8_t a = *(const LAS bf16x8_t*)(lds + ML_VW + (16 * dtile + m16) * ML_P2 + (ks * 32 + 8 * q) * 2);
#pragma unroll
              for (int i = 0; i < 3; ++i) { const bf16x8_t bb = *(const LAS bf16x8_t*)(lds + ML_KT + (16 * (et0 + i) + m16) * ML_P2 + (ks * 32 + 8 * q) * 2); accC[i] = __builtin_amdgcn_mfma_f32_16x16x32_bf16(a, bb, accC[i], 0, 0, 0); } }
#pragma unroll
          for (int i = 0; i < 3; ++i)
#pragma unroll
              for (int jj = 0; jj < 4; ++jj) ((LAS bf16*)(lds + ML_CB + (16 * dtile + 4 * q + jj) * ML_P1))[16 * (et0 + i) + m16] = f2bf(accC[i][jj]); }
        ML_BAR();
        { const f32x4_t dn = *(const LAS f32x4_t*)(DEN + 16 * tt + 4 * q), em = *(const LAS f32x4_t*)(V + 256 + 16 * tt + 4 * q);
#pragma unroll
          for (int i = 0; i < 2; ++i)
#pragma unroll
              for (int jj = 0; jj < 4; ++jj) oval[i][jj] = accA[i][jj] / fmaxf(fabsf(dn[jj]), em[jj]); }
    }
    ML_STORE_PREV((ML_NCH - 1) * 64);
#undef ML_LOAD
#undef ML_STORE_PREV
    __syncthreads();
}
constexpr int NR_SS = 0, NR_PL = 1024, NR_LG = 17408;
template <int MODE, bool COMB, bool FROMIN = false> __device__ __forceinline__ void norm_rows(const Ctx& c, int l, int lc, LAS unsigned char* lds, int tid, int G, int bid, int nrows = NT) {
    const int lane = tid & 63, wave = __builtin_amdgcn_readfirstlane(tid >> 6), m = lane & 15, q = lane >> 4;
    bf16* X = wsp<bf16>(c, WS_X); const float* MOD = wsp<float>(c, WS_MOD); bf16* H = wsp<bf16>(c, WS_H); (void)H;
    LAS float* SS = (LAS float*)(lds + NR_SS); LAS float* PL = (LAS float*)(lds + NR_PL); LAS float* LG = (LAS float*)(lds + NR_LG);
    bf16x8_t Bh[4][2], Bl[4][2];
    if (MODE == 1) {
#pragma unroll
        for (int i = 0; i < 4; ++i)
#pragma unroll
            for (int nt = 0; nt < 2; ++nt) { const size_t o = ((size_t)l * NE + 16 * nt + m) * D + 128 * wave + 32 * i + 8 * q;
                Bh[i][nt] = *(const bf16x8_t*)(wsp<bf16>(c, WS_WRH) + o); Bl[i][nt] = *(const bf16x8_t*)(wsp<bf16>(c, WS_WRL) + o); } }
    const int ngrp = (MODE == 2 ? NTL : nrows) / 16; int par = 0; const int kb = 128 * wave + 8 * q;
    f32x4_t xa[4], xb[4]; v4u sl = (v4u){0u, 0u, 0u, 0u}; f32x4_t wk = (f32x4_t){0.f, 0.f, 0.f, 0.f};
#define NR_LOAD(g_) do { const int row_ = (g_) * 16 + m; \
        if (FROMIN) { const float* xs_ = row_ < NTL ? c.in[I_X] + (size_t)row_ * D : c.in[I_CTX] + (size_t)(row_ - NTL) * D; \
            _Pragma("unroll") for (int i = 0; i < 4; ++i) { xa[i] = *(const f32x4_t*)(xs_ + kb + 32 * i); xb[i] = *(const f32x4_t*)(xs_ + kb + 32 * i + 4); } } \
        else { const bf16* xs_ = X + (size_t)row_ * D; \
            _Pragma("unroll") for (int i = 0; i < 4; ++i) { const v4u w_ = *(const v4u*)(xs_ + kb + 32 * i); \
                xa[i] = (f32x4_t){__uint_as_float(w_.x << 16), __uint_as_float(w_.x & 0xffff0000u), __uint_as_float(w_.y << 16), __uint_as_float(w_.y & 0xffff0000u)}; \
                xb[i] = (f32x4_t){__uint_as_float(w_.z << 16), __uint_as_float(w_.z & 0xffff0000u), __uint_as_float(w_.w << 16), __uint_as_float(w_.w & 0xffff0000u)}; } } \
        } while (0)
    v4u sl1 = (v4u){0u, 0u, 0u, 0u}; f32x4_t wk1 = (f32x4_t){0.f, 0.f, 0.f, 0.f}; v2u og[4][4]; float osc[4][4];
#define NR_SLOAD(g_, slv_, wkv_) do { const int row_ = (g_) * 16 + m; slv_ = *(const v4u*)(wsp<int>(c, WS_ASGS) + (size_t)row_ * TOPK); wkv_ = *(const f32x4_t*)(wsp<float>(c, WS_ASGW) + (size_t)row_ * TOPK); } while (0)
#define NR_OLOAD(slv_) do { const unsigned char* O_ = wsp<unsigned char>(c, WS_OUTS); const float* OSC_ = wsp<float>(c, WS_OUTSC); \
        _Pragma("unroll") for (int i = 0; i < 4; ++i) { _Pragma("unroll") for (int kk = 0; kk < TOPK; ++kk) { og[i][kk] = *(const v2u*)(O_ + (size_t)slv_[kk] * D + kb + 32 * i); osc[i][kk] = OSC_[(size_t)slv_[kk] * 32 + 4 * wave + i]; } } } while (0)
    if (bid < ngrp) { NR_LOAD(bid); if (COMB) { NR_SLOAD(bid, sl, wk); if (bid + G < ngrp) NR_SLOAD(bid + G, sl1, wk1); NR_OLOAD(sl); } }
    for (int grp = bid; grp < ngrp; grp += G, par ^= 1) {
        const int r0 = grp * 16, row = r0 + m, mb = r0 < NTL ? r0 / SEQ : NB;
        float xv[4][8];
#pragma unroll
        for (int i = 0; i < 4; ++i) { xv[i][0] = xa[i][0]; xv[i][1] = xa[i][1]; xv[i][2] = xa[i][2]; xv[i][3] = xa[i][3]; xv[i][4] = xb[i][0]; xv[i][5] = xb[i][1]; xv[i][6] = xb[i][2]; xv[i][7] = xb[i][3]; }
        const f32x4_t wkc = wk;
        if (COMB) {
            const float* g2 = MOD + ((size_t)lc * NMOD + mb) * 6144 + 5 * D + kb;
#pragma unroll
            for (int i = 0; i < 4; ++i) { float f[8]; float ssum = 0.f;
#pragma unroll
                for (int e = 0; e < 8; ++e) f[e] = 0.f;
#pragma unroll
                for (int kk = 0; kk < TOPK; ++kk) { const v2u o = og[i][kk]; const float sc = wkc[kk] * osc[i][kk]; ssum += sc;
                    f[0] += sc * (float)(o.x & 0xffu); f[1] += sc * (float)((o.x >> 8) & 0xffu); f[2] += sc * (float)((o.x >> 16) & 0xffu); f[3] += sc * (float)(o.x >> 24);
                    f[4] += sc * (float)(o.y & 0xffu); f[5] += sc * (float)((o.y >> 8) & 0xffu); f[6] += sc * (float)((o.y >> 16) & 0xffu); f[7] += sc * (float)(o.y >> 24); }
#pragma unroll
                for (int e = 0; e < 8; ++e) f[e] -= 128.0f * ssum;
                const f32x4_t ga = *(const f32x4_t*)(g2 + 32 * i), gb = *(const f32x4_t*)(g2 + 32 * i + 4);
#pragma unroll
                for (int e = 0; e < 4; ++e) { xv[i][e] += ga[e] * f[e]; xv[i][4 + e] += gb[e] * f[4 + e]; }
                if (MODE != 2) { *(v4u*)(X + (size_t)row * D + kb + 32 * i) = (v4u){f2bf_bits(xv[i][0]) | (f2bf_bits(xv[i][1]) << 16), f2bf_bits(xv[i][2]) | (f2bf_bits(xv[i][3]) << 16), f2bf_bits(xv[i][4]) | (f2bf_bits(xv[i][5]) << 16), f2bf_bits(xv[i][6]) | (f2bf_bits(xv[i][7]) << 16)};
#pragma unroll
                    for (int e = 0; e < 8; ++e) xv[i][e] = __uint_as_float(f2bf_bits(xv[i][e]) << 16); } }
        }
        if (grp + G < ngrp) { NR_LOAD(grp + G); if (COMB) { sl = sl1; wk = wk1; NR_OLOAD(sl); if (grp + 2 * G < ngrp) NR_SLOAD(grp + 2 * G, sl1, wk1); } }
        float ss = 0.f;
#pragma unroll
        for (int i = 0; i < 4; ++i)
#pragma unroll
            for (int e = 0; e < 8; ++e) ss += xv[i][e] * xv[i][e];
        ss += __shfl_xor(ss, 16); ss += __shfl_xor(ss, 32);
        if (q == 0) SS[par * 128 + wave * 16 + m] = ss;
        ML_BAR();
        float tot = 0.f;
#pragma unroll
        for (int w = 0; w < 8; ++w) tot += SS[par * 128 + w * 16 + m];
        const float rs = 1.0f / sqrtf(tot * (1.0f / D) + EPS);
        if (MODE == 2) { const float* fg = c.in[I_FNG] + kb;
#pragma unroll
            for (int i = 0; i < 4; ++i) { const f32x4_t ga = *(const f32x4_t*)(fg + 32 * i), gb = *(const f32x4_t*)(fg + 32 * i + 4);
                *(f32x4_t*)(c.out + (size_t)row * D + kb + 32 * i) = (f32x4_t){xv[i][0] * rs * ga[0], xv[i][1] * rs * ga[1], xv[i][2] * rs * ga[2], xv[i][3] * rs * ga[3]};
                *(f32x4_t*)(c.out + (size_t)row * D + kb + 32 * i + 4) = (f32x4_t){xv[i][4] * rs * gb[0], xv[i][5] * rs * gb[1], xv[i][6] * rs * gb[2], xv[i][7] * rs * gb[3]}; }
            continue; }
        const float* ng = c.in[MODE == 1 ? I_N2G : I_N1G] + l * D + kb; const float* sh = MOD + ((size_t)l * NMOD + mb) * 6144 + (MODE == 1 ? 3 : 0) * D + kb; const float* sc = sh + D;
        if (MODE == 0) {
            float amax = 0.f;
#pragma unroll
            for (int i = 0; i < 4; ++i)
#pragma unroll
                for (int hh = 0; hh < 2; ++hh) { const f32x4_t g4 = *(const f32x4_t*)(ng + 32 * i + 4 * hh), s4 = *(const f32x4_t*)(sc + 32 * i + 4 * hh), h4 = *(const f32x4_t*)(sh + 32 * i + 4 * hh);
#pragma unroll
                    for (int e = 0; e < 4; ++e) { const float hv = xv[i][4 * hh + e] * rs * g4[e] * (1.0f + s4[e]) + h4[e]; xv[i][4 * hh + e] = hv; amax = fmaxf(amax, fabsf(hv)); } }
            amax = fmaxf(amax, __shfl_xor(amax, 16)); amax = fmaxf(amax, __shfl_xor(amax, 32));
            LAS float* MX = (LAS float*)(lds + 20480);
            if (q == 0) MX[par * 128 + wave * 16 + m] = amax;
            ML_BAR();
            float rmax = 0.f;
#pragma unroll
            for (int w = 0; w < 8; ++w) rmax = fmaxf(rmax, MX[par * 128 + w * 16 + m]);
            const float qs = rmax > 0.f ? rmax * (1.0f / 127.0f) : 1.0f, qi = 1.0f / qs;
            if (wave == 0 && q == 0) wsp<float>(c, WS_HS)[row] = qs;
            signed char* HQ = wsp<signed char>(c, WS_H);
#pragma unroll
            for (int i = 0; i < 4; ++i) { unsigned pk[2];
#pragma unroll
                for (int w2 = 0; w2 < 2; ++w2) { unsigned v = 0u;
#pragma unroll
                    for (int e = 0; e < 4; ++e) { const int qq = (int)__builtin_rintf(xv[i][4 * w2 + e] * qi); v |= ((unsigned)qq & 0xffu) << (8 * e); }
                    pk[w2] = v; }
                *(v2u*)(HQ + (size_t)row * D + kb + 32 * i) = (v2u){pk[0], pk[1]}; }
            continue; }
        f32x4_t accL[2] = {(f32x4_t){0.f, 0.f, 0.f, 0.f}, (f32x4_t){0.f, 0.f, 0.f, 0.f}}; float amax1 = 0.f;
#pragma unroll
        for (int i = 0; i < 4; ++i) { float hv[8];
#pragma unroll
            for (int hh = 0; hh < 2; ++hh) { const f32x4_t g4 = *(const f32x4_t*)(ng + 32 * i + 4 * hh), s4 = *(const f32x4_t*)(sc + 32 * i + 4 * hh), h4 = *(const f32x4_t*)(sh + 32 * i + 4 * hh);
#pragma unroll
                for (int e = 0; e < 4; ++e) { hv[4 * hh + e] = xv[i][4 * hh + e] * rs * g4[e] * (1.0f + s4[e]) + h4[e]; xv[i][4 * hh + e] = hv[4 * hh + e]; amax1 = fmaxf(amax1, fabsf(hv[4 * hh + e])); } }
            unsigned hb[8];
#pragma unroll
            for (int e = 0; e < 8; ++e) hb[e] = f2bf_bits(hv[e]);
            const v4u hp = (v4u){hb[0] | (hb[1] << 16), hb[2] | (hb[3] << 16), hb[4] | (hb[5] << 16), hb[6] | (hb[7] << 16)};
            { unsigned lb[8];
#pragma unroll
                for (int e = 0; e < 8; ++e) lb[e] = f2bf_bits(hv[e] - __uint_as_float(hb[e] << 16));
                const v4u lp = (v4u){lb[0] | (lb[1] << 16), lb[2] | (lb[3] << 16), lb[4] | (lb[5] << 16), lb[6] | (lb[7] << 16)};
                const bf16x8_t Ah = __builtin_bit_cast(bf16x8_t, hp), Al = __builtin_bit_cast(bf16x8_t, lp);
#pragma unroll
                for (int nt = 0; nt < 2; ++nt) { accL[nt] = __builtin_amdgcn_mfma_f32_16x16x32_bf16(Ah, Bh[i][nt], accL[nt], 0, 0, 0);
                    accL[nt] = __builtin_amdgcn_mfma_f32_16x16x32_bf16(Al, Bh[i][nt], accL[nt], 0, 0, 0); accL[nt] = __builtin_amdgcn_mfma_f32_16x16x32_bf16(Ah, Bl[i][nt], accL[nt], 0, 0, 0); } } }
        { amax1 = fmaxf(amax1, __shfl_xor(amax1, 16)); amax1 = fmaxf(amax1, __shfl_xor(amax1, 32)); LAS float* MX = (LAS float*)(lds + 20480); if (q == 0) MX[par * 128 + wave * 16 + m] = amax1; }
        if (MODE == 1) {
#pragma unroll
            for (int nt = 0; nt < 2; ++nt)
#pragma unroll
                for (int j = 0; j < 4; ++j) PL[(wave * 16 + 4 * q + j) * 32 + 16 * nt + m] = accL[nt][j];
            ML_BAR();
            { const LAS float* MX = (const LAS float*)(lds + 20480); float rmax = 0.f;
#pragma unroll
              for (int w = 0; w < 8; ++w) rmax = fmaxf(rmax, MX[par * 128 + w * 16 + m]);
              const float qs = rmax > 0.f ? rmax * (1.0f / 127.0f) : 1.0f, qi = 1.0f / qs;
              if (wave == 0 && q == 0) wsp<float>(c, WS_HS)[row] = qs;
              signed char* HQ = wsp<signed char>(c, WS_H);
#pragma unroll
              for (int i = 0; i < 4; ++i) { unsigned pk[2];
#pragma unroll
                  for (int w2 = 0; w2 < 2; ++w2) { unsigned v = 0u;
#pragma unroll
                      for (int e = 0; e < 4; ++e) { const int qq = (int)__builtin_rintf(xv[i][4 * w2 + e] * qi); v |= ((unsigned)qq & 0xffu) << (8 * e); }
                      pk[w2] = v; }
                  *(v2u*)(HQ + (size_t)row * D + kb + 32 * i) = (v2u){pk[0], pk[1]}; } }
            { const int rr = tid >> 5, e = tid & 31; float v = c.in[I_RB][l * NE + e];
#pragma unroll
              for (int w = 0; w < 8; ++w) v += PL[(w * 16 + rr) * 32 + e];
              LG[rr * 32 + e] = v; }
            ML_BAR();
            if (tid < 16) { const int r = r0 + tid; float lg[NE];
#pragma unroll
                for (int e = 0; e < NE; ++e) lg[e] = LG[tid * 32 + e];
                int sel[TOPK]; float sv[TOPK]; unsigned taken = 0u;
#pragma unroll
                for (int kk = 0; kk < TOPK; ++kk) { float best = -3.0e38f; int bi = 0;
#pragma unroll
                    for (int e = 0; e < NE; ++e) { if (!((taken >> e) & 1u) && lg[e] > best) { best = lg[e]; bi = e; } }
                    sel[kk] = bi; sv[kk] = best; taken |= 1u << bi; }
                float es[TOPK], sum = 0.f;
#pragma unroll
                for (int kk = 0; kk < TOPK; ++kk) { es[kk] = expf(sv[kk] - sv[0]); sum += es[kk]; }
                int* AE = wsp<int>(c, WS_ASGE); int* AP = wsp<int>(c, WS_ASGP); float* AW = wsp<float>(c, WS_ASGW); unsigned* CNT = wsp<unsigned>(c, WS_CTL) + CW_CNT + l * NE;
#pragma unroll
                for (int kk = 0; kk < TOPK; ++kk) { AE[r * TOPK + kk] = sel[kk]; AW[r * TOPK + kk] = es[kk] / sum; AP[r * TOPK + kk] = atomic_inc(CNT + sel[kk]); } } }
    }
#undef NR_LOAD
#undef NR_SLOAD
#undef NR_OLOAD
    __syncthreads();
}

__device__ __forceinline__ void ml_headout(const Ctx& c, int l, int tid, int G, int bid) {
    const int lane = tid & 63, wave = __builtin_amdgcn_readfirstlane(tid >> 6), sub = lane & 7, hd = lane >> 3;
    const bf16* HFB = wsp<bf16>(c, WS_HFB); const bf16* P = wsp<bf16>(c, WS_P); bf16* MLO = wsp<bf16>(c, WS_MLO);
    for (int it = bid * 8 + wave; it < NT * MLH / 8; it += G * 8) { const int th = it * 8 + hd, r = th >> 2, h = th & 3; const size_t o = (size_t)r * DH + h * MLD + sub * 12;
        float v[12];
#pragma unroll
        for (int i = 0; i < 3; ++i) { const v2u a = *(const v2u*)(HFB + o + 4 * i), b = *(const v2u*)(HFB + (size_t)NT * DH + o + 4 * i);
            v[4 * i] = __uint_as_float(a.x << 16) + __uint_as_float(b.x << 16); v[4 * i + 1] = __uint_as_float(a.x & 0xffff0000u) + __uint_as_float(b.x & 0xffff0000u);
            v[4 * i + 2] = __uint_as_float(a.y << 16) + __uint_as_float(b.y << 16); v[4 * i + 3] = __uint_as_float(a.y & 0xffff0000u) + __uint_as_float(b.y & 0xffff0000u); }
        float ss = 0.f;
#pragma unroll
        for (int e = 0; e < 12; ++e) ss += v[e] * v[e];
        ss += __shfl_xor(ss, 1); ss += __shfl_xor(ss, 2); ss += __shfl_xor(ss, 4);
        const float rs = 1.0f / sqrtf(ss * (1.0f / MLD) + EPS); const float* ng = c.in[I_MLNG] + l * DH + h * MLD + sub * 12;
#pragma unroll
        for (int i = 0; i < 3; ++i) { const f32x4_t g4 = *(const f32x4_t*)(ng + 4 * i); const v2u og = *(const v2u*)(P + (size_t)r * NP + PC_O + h * MLD + sub * 12 + 4 * i);
            const float o0 = __uint_as_float(og.x << 16), o1 = __uint_as_float(og.x & 0xffff0000u), o2 = __uint_as_float(og.y << 16), o3 = __uint_as_float(og.y & 0xffff0000u);
            const float y0 = v[4 * i] * rs * g4[0] * pg8::fsig(o0), y1 = v[4 * i + 1] * rs * g4[1] * pg8::fsig(o1), y2 = v[4 * i + 2] * rs * g4[2] * pg8::fsig(o2), y3 = v[4 * i + 3] * rs * g4[3] * pg8::fsig(o3);
            *(v2u*)(MLO + o + 4 * i) = (v2u){f2bf_bits(y0) | (f2bf_bits(y1) << 16), f2bf_bits(y2) | (f2bf_bits(y3) << 16)}; } }
}
__device__ __forceinline__ void moe_dispatch(const Ctx& c, int l, LAS unsigned char* lds, int tid, int G, int bid, int nrows) {
    LAS int* PS = (LAS int*)lds; const unsigned* CNT = wsp<unsigned>(c, WS_CTL) + CW_CNT + l * NE;
    if (tid < NE) { int run = 0; for (int e = 0; e < tid; ++e) run += ((int)CNT[e] + 255) / 256; PS[tid] = run * 256;
        if (bid == 0) { int* TAB = wsp<int>(c, WS_TAB); const int nb = ((int)CNT[tid] + 255) / 256; for (int j = 0; j < nb; ++j) TAB[64 + run + j] = tid; if (tid == NE - 1) TAB[32] = run + nb; } }
    __syncthreads();
    const int* AE = wsp<int>(c, WS_ASGE); const int* AP = wsp<int>(c, WS_ASGP); int* AS_ = wsp<int>(c, WS_ASGS); int* ST = wsp<int>(c, WS_SLTOK); float* SLS = wsp<float>(c, WS_SLS); const float* HS = wsp<float>(c, WS_HS);
    for (long a = (long)bid * NTHR_ + tid; a < (long)nrows * TOPK; a += (long)G * NTHR_) { const int slot = PS[AE[a]] + AP[a]; AS_[a] = slot; ST[slot] = (int)(a / TOPK); SLS[slot] = HS[a / TOPK]; }
    if (bid == 0) for (int e = 0; e < NE; ++e) { const int cnt = (int)CNT[e], pad = ((cnt + 255) / 256) * 256; for (int i = cnt + tid; i < pad; i += NTHR_) { ST[PS[e] + i] = 0; SLS[PS[e] + i] = 0.f; } }
    __syncthreads();
}

constexpr int NWAVES = 8, NTHR = NWAVES * 64;
constexpr int RING_BYTES = 131072, MISC_OFF = 147200, LDS_BYTES = 147456;

struct Args { Ctx c; };
__global__ void __launch_bounds__(NTHR, 2) fwd_kernel(Args args) {
    extern __shared__ __attribute__((aligned(16))) unsigned char lds_raw[];
    LAS unsigned char* lds = (LAS unsigned char*)lds_raw;
    volatile LAS unsigned* MISC = (volatile LAS unsigned*)(lds + MISC_OFF);
    const int wave0_ = __builtin_amdgcn_readfirstlane((int)threadIdx.x >> 6);
    for (int u = threadIdx.x; u < (LDS_BYTES - MISC_OFF) / 4; u += NTHR) ((LAS unsigned*)(lds + MISC_OFF))[u] = 0u;
    __syncthreads();
    unsigned* ctl = (unsigned*)(args.c.ws + WS_CTL);
    const bool multi = (args.c.ph_hi - args.c.ph_lo) > 1;
    XcdBarrier bar; bar.bar = ctl + CW_BAR; bar.x = 0; bar.st = nullptr;
    if (multi) bar = xcd_barrier_post(ctl + CW_BAR, MISC + 8);
    const int lo = args.c.ph_lo, hi = args.c.ph_hi;
#ifndef PH_MASK
#define PH_MASK 0xFFFFFFFFu
#endif
#define PHEN(j) (((PH_MASK) >> (j)) & 1u)
#define IN(k) (lo <= (k) && (k) < hi)
#define SEAM(k) do { if (IN(k) && IN((k) + 1)) { XcdBarrier bq_ = bar; asm volatile("" : "+s"(bq_.bar)); xcd_barrier(bq_, wave0_ * 64 + (int)__builtin_amdgcn_mbcnt_hi(~0u, __builtin_amdgcn_mbcnt_lo(~0u, 0u))); } } while (0)
#define LOADCTX() Ctx c; { int z_ = 0; asm volatile("" : "+s"(z_)); _Pragma("unroll") for (int i_ = 0; i_ < N_INPUTS; ++i_) c.in[i_] = args.c.in[i_ + z_]; c.out = args.c.out; { size_t zo_ = 0; asm volatile("" : "+s"(zo_)); c.ws = args.c.ws + zo_; } c.ph_lo = 0; c.ph_hi = 0; } int tid = wave0_ * 64 + (int)__builtin_amdgcn_mbcnt_hi(~0u, __builtin_amdgcn_mbcnt_lo(~0u, 0u)); asm volatile("" : "+v"(tid)); int bid = blockIdx.x, G = gridDim.x; asm volatile("" : "+s"(bid), "+s"(G)); const long gstride = (long)G * NTHR; const long gt = (long)bid * NTHR + tid; const int lane = tid & 63, wave = __builtin_amdgcn_readfirstlane(tid >> 6); (void)lane; (void)wave;

    if (PHEN(15) && IN(0)) for (int rep_ = 0; rep_ <= (int)((REP_MASK >> 15) & 1u); ++rep_) { if (rep_) __syncthreads(); LOADCTX();
        ph_pre0(c, gt, gstride); ph_s5tab(c, gt, gstride); ph_wr(c, gt, gstride); ph_zt(c, gt, gstride);
        LAS float* scr = (LAS float*)(lds + wave * 16384);
        const int gw = bid * NWAVES + wave, ngw = G * NWAVES;
        { constexpr int IB = (DH / 64) * (D / 32), IO = (D / 64) * (D / 32), IG = (DH / 64) * (512 / 32), IL = 3 * IB + IO + IG;
          for (int it = gw; it < DEPTH * IL; it += ngw) { const int l = it / IL; int r = it % IL;
              if (r < 3 * IB) { const int br = r / IB; const float* wsrc = br == 0 ? c.in[I_WBHY] : (br == 1 ? c.in[I_WBS5] : c.in[I_WBML]); wconv_item<0>(wsrc + (size_t)l * DH * D, DH, D, D, wsp<bf16>(c, WS_WBR) + ((size_t)l * 3 + br) * D * DH, scr, r % IB, lane, 0); continue; } r -= 3 * IB;
              if (r < IO) { wconv_item<0>(c.in[I_WOUT] + (size_t)l * D * D, D, D, D, wsp<bf16>(c, WS_WOUT) + (size_t)l * D * D, scr, r, lane, 0); continue; } r -= IO;
              wconv_item<3>(c.in[I_GLU] + (size_t)l * DH * DH, DH, DH, 512, wsp<bf16>(c, WS_GLU) + (size_t)l * 512 * DH, scr, r, lane, DH); } }
        wmax_part(c, bid, G, tid); w1max_part(c, 0, 0, bid, G, tid); w1max_part(c, 0, 16, bid, G, tid);
    }
    SEAM(0);
    if (PHEN(16) && IN(1)) for (int rep_ = 0; rep_ <= (int)((REP_MASK >> 16) & 1u); ++rep_) { if (rep_) __syncthreads(); LOADCTX(); modp_fast(c, lds, tid, G, bid); ph_hd1(c, gt, gstride); ph_s5pow(c, gt, gstride); s5gen1_fast(c, tid, G, bid);
        { constexpr int IW = (D / 64) * (NP / 32); LAS float* scr = (LAS float*)(lds + wave * 16384); const int gw = bid * NWAVES + wave, ngw = G * NWAVES;
          for (int it = gw; it < DEPTH * IW; it += ngw) { const int l = it / IW;
              wconv_item_q8<1>(c.in[I_WIN] + (size_t)l * D * NIN, D, NIN, NP, wsp<signed char>(c, WS_WIN) + (size_t)l * NP * D, wsp<float>(c, WS_CTL) + CW_WMX + (size_t)l * NP, scr, it % IW, lane); } } }
    SEAM(1);
    if (PHEN(17) && IN(2)) for (int rep_ = 0; rep_ <= (int)((REP_MASK >> 17) & 1u); ++rep_) { if (rep_) __syncthreads(); LOADCTX(); ph_modf(c, gt, gstride); ph_hd2(c, gt, gstride); ph_s5gen2(c, gt, gstride); }
    SEAM(2);
    if (PHEN(18) && IN(3)) for (int rep_ = 0; rep_ <= (int)((REP_MASK >> 18) & 1u); ++rep_) { if (rep_) __syncthreads(); LOADCTX(); hyf2_mfma(c, tid, G, bid); }
    SEAM(3);
    if (PHEN(18) && IN(4)) for (int rep_ = 0; rep_ <= (int)((REP_MASK >> 18) & 1u); ++rep_) { if (rep_) __syncthreads(); LOADCTX(); rk_build(c, lds, tid, G, bid); }
    SEAM(4);

#define MOE_LTAB() do { const int* tb_ = wsp<int>(c, WS_TAB) + 32; for (int i_ = tid; i_ < 704; i_ += NTHR) ((LAS int*)(lds + 132096))[i_] = tb_[i_]; __syncthreads(); } while (0)
#define LAYER_BODY(l) { \
        const int pb = NPRO + l * NLP; const int MR = (l == DEPTH - 1) ? NTL : NT;     \
        if (PHEN(0) && IN(pb + 0)) { LOADCTX(); if (l == 0) norm_rows<0, false, true>(c, l, 0, lds, tid, G, bid); else norm_rows<0, true>(c, l, l - 1, lds, tid, G, bid); } \
        SEAM(pb + 0); \
        if (PHEN(1) && IN(pb + 1)) for (int rep_ = 0; rep_ <= (int)((REP_MASK >> 1) & 1u); ++rep_) { if (rep_) __syncthreads(); LOADCTX(); \
            const pg8::Gemm g = pg8::make_gemm(wsp<bf16>(c, WS_H), wsp<bf16>(c, WS_WIN) + (size_t)l * NP * D / 2, NT, NP, D / 2); pg8::StaticOrder S; S.init(NT, NP, G, bid);     \
            pg8::EpiStoreQ8 E{wsp<bf16>(c, WS_P), NP, wsp<float>(c, WS_HS), wsp<float>(c, WS_CTL) + CW_WMX + (size_t)l * NP}; \
            pg8::gemm_phase<pg8::EpiStoreQ8, pg8::StaticOrder, true, true, true>(lds, g, S, E, tid); \
            if (G == 256 && bid >= 16) { moe_wconv(c, l, (LAS float*)(lds + wave * 16384), 0, MOE_WS0, (bid - 16) * NWAVES + wave, 240 * NWAVES, lane); __syncthreads(); } \
        } \
        SEAM(pb + 1); \
        if (PHEN(2) && IN(pb + 2)) for (int rep_ = 0; rep_ <= (int)((REP_MASK >> 2) & 1u); ++rep_) { if (rep_) __syncthreads(); \
            { LOADCTX(); hy_prep(c, l, lds, tid, G, bid); } \
            { LOADCTX(); ml_prep(c, l, tid, G, bid); } \
            { LOADCTX(); pg8::Gemm g = pg8::make_gemm(wsp<bf16>(c, WS_P) + PC_S5, wsp<bf16>(c, WS_BT1) + (size_t)l * S5G * 768 * 512, S5RP, 768, 512); \
              g.a_row = S5T * NP * 2; g.a_kstep = 4 * NP * 2; g.a_sub = NP * 2; g.a_grp = S5N * 2; g.a_mode = 1; \
              pg8::S5Order S{3, G, (bid + 152) % G}; pg8::EpiS5a E{wsp<float>(c, WS_YS5), wsp<float>(c, WS_SLOC)}; \
              pg8::gemm_phase<pg8::EpiS5a, pg8::S5Order, true, true>(lds, g, S, E, tid); } \
        } \
        SEAM(pb + 2); \
        if (PHEN(3) && IN(pb + 3)) for (int rep_ = 0; rep_ <= (int)((REP_MASK >> 3) & 1u); ++rep_) { if (rep_) __syncthreads(); \
            for (int r2_ = 0; r2_ <= (int)((REP_MASK >> 21) & 1u); ++r2_) { LOADCTX(); for (int u = bid; u < 256; u += G) ml_chain(c, l, lds, tid, u); } \
            for (int r2_ = 0; r2_ <= (int)((REP_MASK >> 22) & 1u); ++r2_) { LOADCTX(); hy_conv(c, l, lds, tid, G, bid); } \
            { LOADCTX(); if (G == 256 && bid >= 128) { moe_wconv(c, l, (LAS float*)(lds + wave * 16384), MOE_WS0, MOE_WS1, (bid - 128) * NWAVES + wave, 128 * NWAVES, lane); __syncthreads(); } } \
            { LOADCTX(); if (G == 256) { if (bid >= 128) ph_s5cscan(c, l, (long)(bid - 128) * NTHR + tid, 128L * NTHR); } else ph_s5cscan(c, l, gt, gstride); } } \
        SEAM(pb + 3); \
        if (PHEN(4) && IN(pb + 4)) for (int rep_ = 0; rep_ <= (int)((REP_MASK >> 4) & 1u); ++rep_) { if (rep_) __syncthreads(); { LOADCTX(); hy_post(c, lds, tid, G, bid); } \
            { LOADCTX(); pg8::Gemm g = pg8::make_gemm(wsp<bf16>(c, WS_XIN), wsp<bf16>(c, WS_BT2) + (size_t)l * S5G * 512 * 256, S5RP, 512, 256); \
              g.a_grp = S5RP * 256 * 2; \
              pg8::S5Order S{2, G, bid}; pg8::EpiS5b E{wsp<float>(c, WS_YS5), wsp<bf16>(c, WS_G)}; \
              pg8::gemm_phase<pg8::EpiS5b, pg8::S5Order, true, true>(lds, g, S, E, tid); } \
            { LOADCTX(); ml_headout(c, l, tid, G, bid); } } \
        SEAM(pb + 4); \
        if (PHEN(5) && IN(pb + 5)) for (int rep_ = 0; rep_ <= (int)((REP_MASK >> 5) & 1u); ++rep_) { if (rep_) __syncthreads(); \
            { LOADCTX(); const pg8::Gemm g = pg8::make_gemm(wsp<bf16>(c, WS_G), wsp<bf16>(c, WS_GLU) + (size_t)l * 512 * DH, MR, 512, DH); pg8::StaticOrder S; S.init(MR, 512, G, (bid + 192) % G);     \
              pg8::EpiGlu E{wsp<bf16>(c, WS_G), wsp<bf16>(c, WS_S5O)}; \
              pg8::gemm_phase<pg8::EpiGlu, pg8::StaticOrder, true, true>(lds, g, S, E, tid); } \
            { LOADCTX(); pg8::StaticOrder S; S.init(MR, D, G, bid); const bf16* wbr = wsp<bf16>(c, WS_WBR) + (size_t)l * 3 * D * DH; \
              { const pg8::Gemm g = pg8::make_gemm(wsp<bf16>(c, WS_HY), wbr, NT, D, DH); pg8::EpiBr<0> E{wsp<bf16>(c, WS_P), PC_MG, wsp<float>(c, WS_YF), wsp<bf16>(c, WS_YB)}; \
                pg8::gemm_phase<pg8::EpiBr<0>, pg8::StaticOrder, true, true>(lds, g, S, E, tid); } \
              { const pg8::Gemm g = pg8::make_gemm(wsp<bf16>(c, WS_MLO), wbr + (size_t)2 * D * DH, NT, D, DH); pg8::EpiBr<1> E{wsp<bf16>(c, WS_P), PC_MG + 2 * D, wsp<float>(c, WS_YF), wsp<bf16>(c, WS_YB)}; \
                pg8::gemm_phase<pg8::EpiBr<1>, pg8::StaticOrder, true, true>(lds, g, S, E, tid); } } \
        } \
        SEAM(pb + 5); \
        if (PHEN(6) && IN(pb + 6)) for (int rep_ = 0; rep_ <= (int)((REP_MASK >> 6) & 1u); ++rep_) { if (rep_) __syncthreads(); LOADCTX(); \
            pg8::StaticOrder S; S.init(MR, D, G, bid); const bf16* wbr = wsp<bf16>(c, WS_WBR) + (size_t)l * 3 * D * DH; \
            const pg8::Gemm g = pg8::make_gemm(wsp<bf16>(c, WS_S5O), wbr + (size_t)D * DH, NT, D, DH); pg8::EpiBr<2> E{wsp<bf16>(c, WS_P), PC_MG + D, wsp<float>(c, WS_YF), wsp<bf16>(c, WS_YB)}; \
            pg8::gemm_phase<pg8::EpiBr<2>, pg8::StaticOrder, true, true>(lds, g, S, E, tid); \
            if (G == 256 && MR == NT && bid >= 64) { moe_wconv(c, l, (LAS float*)(lds + wave * 16384), MOE_WS1, MOE_WS2, (bid - 64) * NWAVES + wave, 192 * NWAVES, lane); __syncthreads(); } \
        } \
        SEAM(pb + 6); \
        if (PHEN(7) && IN(pb + 7)) { LOADCTX(); \
            const pg8::Gemm g = pg8::make_gemm(wsp<bf16>(c, WS_YB), wsp<bf16>(c, WS_WOUT) + (size_t)l * D * D, NT, D, D); pg8::StaticOrder S; S.init(MR, D, G, bid); \
            pg8::EpiOut<(l) == 0> E{wsp<bf16>(c, WS_X), wsp<float>(c, WS_MOD) + (size_t)l * NMOD * 6144, c.in[I_X], c.in[I_CTX]}; \
            pg8::gemm_phase<pg8::EpiOut<(l) == 0>, pg8::StaticOrder, true, true>(lds, g, S, E, tid); \
            if (G == 256 && MR == NT && bid >= 64) { moe_wconv(c, l, (LAS float*)(lds + wave * 16384), MOE_WS2, MOE_WS3, (bid - 64) * NWAVES + wave, 192 * NWAVES, lane); __syncthreads(); } \
        } \
        SEAM(pb + 7); \
        if (PHEN(8) && IN(pb + 8)) { LOADCTX(); \
            norm_rows<1, false>(c, l, 0, lds, tid, G, bid, MR); \
            LAS float* scr = (LAS float*)(lds + wave * 16384); \
            const int gw = bid * NWAVES + wave, ngw = G * NWAVES; \
            for (int rep_ = 0; rep_ <= (int)((REP_MASK >> 14) & 1u); ++rep_) moe_wconv(c, l, scr, (G == 256 ? (MR == NT ? MOE_WS3 : MOE_WS1) : 0), MOE_WITEMS, gw, ngw, lane); \
        } \
        SEAM(pb + 8); \
        if (PHEN(9) && IN(pb + 9)) for (int rep_ = 0; rep_ <= (int)((REP_MASK >> 9) & 1u); ++rep_) { if (rep_) __syncthreads(); LOADCTX(); moe_dispatch(c, l, lds, tid, G, bid, MR); } \
        SEAM(pb + 9); \
        if (PHEN(10) && IN(pb + 10)) for (int rep_ = 0; rep_ <= (int)((REP_MASK >> 10) & 1u); ++rep_) { if (rep_) __syncthreads(); LOADCTX(); \
            pg8::Gemm g = pg8::make_gemm(wsp<bf16>(c, WS_H), wsp<bf16>(c, WS_W1T), NSLOT, 1024, D / 2); g.a_gather = wsp<int>(c, WS_SLTOK);     MOE_LTAB(); pg8::MoeOrderT<true> S{(const LAS int*)(lds + 132096), 4, G, bid}; \
            pg8::EpiMoe1Q8 E{wsp<bf16>(c, WS_ACT), c.in[I_B1] + (size_t)l * NE * 1024, wsp<float>(c, WS_SLS), wsp<float>(c, WS_CTL) + CW_W1MX + (size_t)l * NE * 1024}; \
            pg8::gemm_phase<pg8::EpiMoe1Q8, pg8::MoeOrderT<true>, true, true, true>(lds, g, S, E, tid); \
            if ((l) < DEPTH - 1) w1max_tail(c, (l) + 1, 0, lds, tid, G, bid); \
        } \
        SEAM(pb + 10); \
        if (PHEN(11) && IN(pb + 11)) for (int rep_ = 0; rep_ <= (int)((REP_MASK >> 13) & 1u); ++rep_) { if (rep_) __syncthreads(); LOADCTX(); \
            const pg8::Gemm g = pg8::make_gemm(wsp<bf16>(c, WS_ACT), wsp<bf16>(c, WS_W2T), NSLOT, D, FF); MOE_LTAB(); pg8::MoeOrderT<false> S{(const LAS int*)(lds + 132096), 4, G, bid}; \
            pg8::EpiMoe2 E{wsp<unsigned char>(c, WS_OUTS), wsp<float>(c, WS_OUTSC), c.in[I_B2] + (size_t)l * NE * D}; \
            pg8::gemm_phase<pg8::EpiMoe2, pg8::MoeOrderT<false>, true, true>(lds, g, S, E, tid); \
            if ((l) < DEPTH - 1) w1max_tail(c, (l) + 1, 16, lds, tid, G, bid); \
        } \
        SEAM(pb + 11); \
    }
    LAYER_BODY(0) LAYER_BODY(1) LAYER_BODY(2) LAYER_BODY(3)
    static_assert(DEPTH == 4, "layer bodies written out four times");
    static_assert(MOE_WS3 == MOE_WITEMS, "conversion shares cover every item");
    if (PHEN(19) && IN(NPHASE - 1)) { LOADCTX(); norm_rows<2, true>(c, 0, DEPTH - 1, lds, tid, G, bid); }
#undef IN
#undef SEAM
}

#ifndef N_LAUNCH_MODE
#define N_LAUNCH_MODE 1
#endif
extern "C" void kernel_launch(void* const* d_in, const int* in_sizes, int n_in, void* d_out, int out_size, void* d_ws, size_t ws_size, hipStream_t stream) {
    static int grid = 0;
    if (grid == 0) {
        if (n_in != N_INPUTS || out_size != NTL * D || ws_size < WS_END) { fprintf(stderr, "kernel_launch: shape/workspace mismatch: n_in %d out %d ws %zu (need %zu)\n", n_in, out_size, ws_size, (size_t)WS_END); grid = -1; return; }
        int dev = 0, cus = 0, per_cu = 0;
        if (hipGetDevice(&dev) != hipSuccess || hipDeviceGetAttribute(&cus, hipDeviceAttributeMultiprocessorCount, dev) != hipSuccess) { grid = -1; return; }
        if (hipFuncSetAttribute((const void*)fwd_kernel, hipFuncAttributeMaxDynamicSharedMemorySize, LDS_BYTES) != hipSuccess) { fprintf(stderr, "kernel_launch: hipFuncSetAttribute failed\n"); grid = -1; return; }
        if (hipOccupancyMaxActiveBlocksPerMultiprocessor(&per_cu, (const void*)fwd_kernel, NTHR, LDS_BYTES) != hipSuccess || per_cu < 1) { fprintf(stderr, "kernel_launch: occupancy query says %d\n", per_cu); }
        (void)hipGetLastError();
        grid = cus;
    }
    if (grid < 0) return;
    if (hipMemsetAsync((char*)d_ws + WS_CTL, 0, CTL_BYTES, stream) != hipSuccess) return;
    Args a; std::memset((void*)&a, 0, sizeof(a));
    for (int i = 0; i < N_INPUTS; ++i) a.c.in[i] = (const float*)d_in[i];
    a.c.out = (float*)d_out; a.c.ws = (unsigned char*)d_ws;
    if (N_LAUNCH_MODE == 1) {
        a.c.ph_lo = 0; a.c.ph_hi = NPHASE;
        hipLaunchKernelGGL(fwd_kernel, dim3(grid), dim3(NTHR), LDS_BYTES, stream, a);
    } else {
        for (int p = 0; p < NPHASE; ++p) { a.c.ph_lo = p; a.c.ph_hi = p + 1; hipLaunchKernelGGL(fwd_kernel, dim3(grid), dim3(NTHR), LDS_BYTES, stream, a); }
    }
}
#endif
```

```cpp
#ifdef HOST_TEST
#include <cmath>
#include <cstdio>
#include <cstdlib>
#include <cstring>
#include <cstdint>
#define HD inline
#else
#include <hip/hip_runtime.h>
#include <cstdio>
#include <cstdint>
#include <cstring>
#define HD __host__ __device__ __forceinline__
#endif

#ifndef CFG_BATCH
#define CFG_BATCH 16
#endif
#ifndef CFG_SEQ
#define CFG_SEQ 2048
#endif
#ifndef CFG_CTX
#define CFG_CTX 256
#endif
#ifndef CFG_DEPTH
#define CFG_DEPTH 4
#endif

#ifndef REP_MASK
#define REP_MASK 0u
#endif
typedef unsigned short bf16;
constexpr int D = 1024, NB = CFG_BATCH, SEQ = CFG_SEQ, CTXL = CFG_CTX, DEPTH = CFG_DEPTH, GRIDW = 64;
constexpr int NTL = NB * SEQ, NTC = NB * CTXL, NT = NTL + NTC, NMOD = NB + 1;
constexpr int DH = 384, NPOS = SEQ + CTXL;
constexpr int NP = 6400;
constexpr int PC_S5 = 0, PC_Q = 384, PC_K = 768, PC_V = 1152, PC_HY = 1536, PC_O = 2688, PC_MG = 3072, PC_GT = 6144;
constexpr int NIN = 6160;
constexpr int S5G = 24, S5P = 64, S5N = 16;
constexpr int MLH = 4, MLD = 96;
constexpr int NE = 32, TOPK = 4, FF = 512;
constexpr int NSLOT = ((NT * TOPK + 255) / 256 + NE) * 256;
constexpr float EPS = 1e-6f;

HD int win_src_col(int n) { return n < 1536 ? n : (n < 6144 ? n + 16 : (n < 6160 ? n - 6144 + 1536 : -1)); }
HD int w1_src_col(int n) { const int pn = n >> 8, bj = (n >> 7) & 1, wc = (n >> 5) & 3, nn = (n >> 4) & 1, fq = (n >> 2) & 3, i = n & 3; return 2 * (128 * pn + 32 * wc + 8 * fq + 4 * bj + i) + nn; }

enum { I_X, I_C, I_CTX, I_CCTX, I_ADAW, I_ADAB, I_N1G, I_N2G, I_FNG, I_WIN, I_HYCW, I_HYCB, I_HW1, I_HB1, I_HW2, I_HB2, I_HW3, I_HB3, I_HSF, I_HBIAS,
       I_LRE, I_LIM, I_LDT, I_BRE, I_BIM, I_CRE, I_CIM, I_S5D, I_GLU, I_MLCW, I_MLCB, I_MLGB, I_MLNG, I_WBHY, I_WBS5, I_WBML, I_WOUT,
       I_RW, I_RB, I_W1, I_B1, I_W2, I_B2, N_INPUTS };

constexpr size_t al256(size_t x) { return (x + 255) & ~(size_t)255; }
constexpr size_t WS_CTL = 0, CTL_BYTES = 1u << 20;
constexpr int CW_CNT = 64;
constexpr int CW_W1MX = 131072;
constexpr int CW_WMX = 65536;
constexpr int CW_BAR = 4096;
constexpr size_t WS_MOD = CTL_BYTES;
constexpr size_t WS_SILU = WS_MOD + al256((size_t)DEPTH * NMOD * 6144 * 4);
constexpr size_t WS_HD2 = WS_SILU + al256((size_t)NMOD * D * 4);
constexpr size_t WS_HF = WS_HD2 + al256((size_t)DEPTH * NPOS * 64 * 4);
constexpr size_t WS_NRM = WS_HF + al256((size_t)DEPTH * NPOS * 1536 * 4);
constexpr size_t WS_WIN = WS_NRM + al256((size_t)DEPTH * 2 * 2 * DH * 4);
constexpr size_t WS_WBR = WS_WIN + al256((size_t)DEPTH * NP * D * 2);
constexpr size_t WS_WOUT = WS_WBR + al256((size_t)DEPTH * 3 * D * DH * 2);
constexpr size_t WS_GLU = WS_WOUT + al256((size_t)DEPTH * D * D * 2);
constexpr size_t WS_W1T = WS_GLU + al256((size_t)DEPTH * 512 * DH * 2);
constexpr size_t WS_W2T = WS_W1T + al256((size_t)NE * D * D * 2);
constexpr size_t WS_X = WS_W2T + al256((size_t)NE * D * FF * 2);
constexpr size_t WS_H = WS_X + al256((size_t)NT * D * 4);
constexpr size_t WS_HY = WS_H + al256((size_t)NT * D * 2);
constexpr size_t WS_S5O = WS_HY + al256((size_t)NT * DH * 2);
constexpr size_t WS_MLO = WS_S5O + al256((size_t)NT * DH * 2);
constexpr size_t WS_ASGE = WS_MLO + al256((size_t)NT * DH * 2);
constexpr size_t WS_ASGP = WS_ASGE + al256((size_t)NT * 4 * 4);
constexpr size_t WS_ASGS = WS_ASGP + al256((size_t)NT * 4 * 4);
constexpr size_t WS_ASGW = WS_ASGS + al256((size_t)NT * 4 * 4);
constexpr size_t WS_TAB = WS_ASGW + al256((size_t)NT * 4 * 4);
constexpr size_t WS_SLTOK = WS_TAB + al256(4096 * 4);
constexpr size_t WS_RA = WS_SLTOK + al256((size_t)NSLOT * 4);
constexpr size_t WS_P = WS_RA;
constexpr size_t WS_RB = WS_P + al256((size_t)NT * NP * 2);
constexpr size_t WS_HYC = WS_RB;
constexpr size_t WS_Z1 = WS_HYC + al256((size_t)NT * 1152 * 2);
constexpr size_t WS_QKC = WS_Z1 + al256((size_t)NT * DH * 4);
constexpr size_t WS_GI = WS_QKC + al256((size_t)NT * 768 * 4);
constexpr size_t WS_GF = WS_GI + al256((size_t)2 * NT * 4 * 4);
constexpr size_t WS_CF = WS_GF + al256((size_t)2 * NT * 4 * 4);
constexpr size_t WS_HFB = WS_CF + al256((size_t)2 * NT * 4 * 4);
constexpr size_t WS_YS5 = WS_HFB + al256((size_t)2 * NT * DH * 4);
constexpr size_t WS_G = WS_YS5 + al256((size_t)NT * DH * 4);
constexpr size_t WS_XS = WS_G + al256((size_t)NT * DH * 2);
constexpr size_t WS_YF = WS_XS;
constexpr size_t WS_YB = WS_YF + al256((size_t)NT * D * 4);
constexpr size_t WS_END1 = WS_XS + al256((size_t)NT * S5G * S5P * 8);
constexpr size_t WS_AS = WS_RA;
constexpr size_t WS_ACT = WS_AS + al256((size_t)NSLOT * D * 2);
constexpr size_t WS_OUTS = WS_ACT + al256((size_t)NSLOT * FF * 2);
constexpr size_t WS_OUTSC = WS_OUTS + al256((size_t)NSLOT * D);
constexpr size_t WS_END2 = WS_OUTS + al256((size_t)NSLOT * D * 2);
constexpr size_t WS_END12 = WS_END1 > WS_END2 ? WS_END1 : WS_END2;
constexpr int RKP0 = 2 * SEQ + 24, RKP1 = 2 * CTXL + 24;
constexpr size_t WS_RK0 = WS_END12;
constexpr size_t WS_RK1 = WS_RK0 + al256((size_t)DEPTH * 2 * DH * 2 * RKP0 * 2);
constexpr size_t WS_S5TAB = WS_RK1 + al256((size_t)DEPTH * 2 * DH * 2 * RKP1 * 2);
constexpr size_t WS_KD = WS_S5TAB + al256((size_t)DEPTH * 2 * S5G * S5P * 16);
constexpr size_t WS_BT1 = WS_KD + al256((size_t)DEPTH * S5G * 2 * 32 * 256 * 4);
constexpr size_t WS_BT2 = WS_BT1 + al256((size_t)DEPTH * S5G * 768 * 512 * 2);
constexpr size_t WS_WRH = WS_BT2 + al256((size_t)DEPTH * S5G * 512 * 256 * 2);
constexpr size_t WS_WRL = WS_WRH + al256((size_t)DEPTH * NE * D * 2);
constexpr size_t WS_MODP = WS_WRL + al256((size_t)DEPTH * NE * D * 2);
constexpr size_t WS_HD1 = WS_MODP + al256((size_t)16 * DEPTH * NMOD * 6144 * 4);
constexpr size_t WS_POWT = WS_HD1 + al256((size_t)DEPTH * NPOS * 64 * 4);
constexpr int RKT_LAT = SEQ / 64, RKT_CTX = CTXL / 64;
constexpr size_t WS_NRMP = WS_POWT + al256((size_t)DEPTH * 2 * S5G * S5P * 33 * 8);
constexpr size_t WS_ZT = WS_NRMP + al256((size_t)DEPTH * 2 * 2 * DH * 64 * 4);
constexpr size_t WS_HS = WS_ZT + al256((size_t)NPOS * 33 * 4);
constexpr size_t WS_WSC = WS_HS + al256((size_t)NT * 4);
constexpr size_t WS_W1S = WS_WSC + al256((size_t)DEPTH * NP * 4);
constexpr size_t WS_SLS = WS_W1S + al256((size_t)DEPTH * NE * 1024 * 4);
constexpr size_t WS_END = WS_SLS + al256((size_t)NSLOT * 4);
constexpr int S5T = 32, S5R = NT / S5T, S5RP = ((S5R + 255) / 256) * 256;
constexpr size_t WS_SLOC = WS_YB + al256((size_t)NT * D * 2);
constexpr size_t WS_XIN = WS_SLOC + al256((size_t)S5G * S5RP * 256 * 4);
static_assert(WS_XIN + (size_t)S5G * S5RP * 256 * 2 <= WS_END1, "S5 chunk buffers inside the old XS region");
constexpr size_t WS_VT = WS_HYC, WS_X1T = WS_VT + (size_t)DH * NB * NPOS * 2, WS_X2T = WS_X1T + (size_t)DH * NB * NPOS * 2;
constexpr size_t WS_Z1T = WS_Z1, WS_HYT = WS_Z1T + (size_t)DH * NB * NPOS * 2;
static_assert(WS_X2T + (size_t)DH * NB * NPOS * 2 <= WS_Z1 && WS_HYT + (size_t)DH * NB * NPOS * 2 <= WS_QKC, "hyena channel-major buffers");
static_assert(WS_YB + (size_t)NT * D * 2 <= WS_END1, "YF/YB inside XS");

struct Ctx {
    const float* in[N_INPUTS];
    float* out;
    unsigned char* ws;
    int ph_lo, ph_hi;
};
template <class T> HD T* wsp(const Ctx& c, size_t off) { return (T*)(c.ws + off); }

HD unsigned f2bf_bits(float f) { unsigned u; __builtin_memcpy(&u, &f, 4); return (u + 0x7fffu + ((u >> 16) & 1u)) >> 16; }
HD bf16 f2bf(float f) { return (bf16)f2bf_bits(f); }
HD float bf2f(bf16 b) { unsigned u = ((unsigned)b) << 16; float f; __builtin_memcpy(&f, &u, 4); return f; }
HD float sigm(float x) { return 1.0f / (1.0f + expf(-x)); }
HD float siluf(float x) { return x * sigm(x); }
HD float logsig(float x) { return x >= 0.f ? -log1pf(expf(-x)) : x - log1pf(expf(x)); }
HD float gelu_t(float x) { return 0.5f * x * (1.0f + tanhf(0.7978845608028654f * (x + 0.044715f * x * x * x))); }
HD void tokinfo(int r, int& b, int& t, int& L, int& base, int& mb) {
    if (r < NTL) { b = r / SEQ; t = r % SEQ; L = SEQ; base = b * SEQ; mb = b; }
    else { const int q = r - NTL; b = q / CTXL; t = q % CTXL; L = CTXL; base = NTL + b * CTXL; mb = NB; }
}
HD bool has_prev(int r) { if (r < NTL) return (r % GRIDW) != 0; return ((r - NTL) % CTXL) != 0; }
HD bool has_next(int r) { if (r < NTL) return (r % GRIDW) != GRIDW - 1; return ((r - NTL) % CTXL) != CTXL - 1; }
HD int seq_tok(int d, int b, int tau) {
    if (tau < CTXL) return NTL + b * CTXL + (d ? CTXL - 1 - tau : tau);
    const int t = tau - CTXL; return b * SEQ + (d ? SEQ - 1 - t : t);
}
HD int tok_tau(int d, int r) {
    if (r < NTL) { const int t = r % SEQ; return CTXL + (d ? SEQ - 1 - t : t); }
    const int t = (r - NTL) % CTXL; return d ? CTXL - 1 - t : t;
}

#define GS_LOOP(it, n) for (long it = gtid; it < (long)(n); it += gstride)

HD void ph_pre0(const Ctx& c, long gtid, long gstride) {
    float* SL = wsp<float>(c, WS_SILU);
    GS_LOOP(i, NMOD * D) { const int mb = (int)(i / D), k = (int)(i % D); const float v = mb < NB ? c.in[I_C][mb * D + k] : c.in[I_CCTX][k]; SL[i] = siluf(v); }
}
HD void ph_wmax(const Ctx& c, long gtid, long gstride) {
    float* WSC = wsp<float>(c, WS_WSC);
    GS_LOOP(it, DEPTH * NP) { const int n = (int)(it % NP), l = (int)(it / NP), sc = win_src_col(n); float mx = 0.f;
        if (sc >= 0) { const float* w = c.in[I_WIN] + (size_t)l * D * NIN + sc;
            for (int k0 = 0; k0 < D; k0 += 16) { float v[16];
#pragma unroll
                for (int u = 0; u < 16; ++u) v[u] = w[(size_t)(k0 + u) * NIN];
#pragma unroll
                for (int u = 0; u < 16; ++u) mx = fmaxf(mx, fabsf(v[u])); } }
        WSC[it] = mx > 0.f ? mx * (1.0f / 127.0f) : 1.0f; }
}
HD void ph_w1max(const Ctx& c, long gtid, long gstride) {
    float* W1S = wsp<float>(c, WS_W1S);
    GS_LOOP(it, DEPTH * NE * 1024) { const int n = (int)(it % 1024); const long le = it / 1024; const float* w = c.in[I_W1] + (size_t)le * D * 1024 + n; float mx = 0.f;
        for (int k0 = 0; k0 < D; k0 += 16) { float v[16];
#pragma unroll
            for (int u = 0; u < 16; ++u) v[u] = w[(size_t)(k0 + u) * 1024];
#pragma unroll
            for (int u = 0; u < 16; ++u) mx = fmaxf(mx, fabsf(v[u])); }
        W1S[it] = mx > 0.f ? mx * (1.0f / 127.0f) : 1.0f; }
}
HD void ph_modp(const Ctx& c, long gtid, long gstride) {
    const float* SL = wsp<float>(c, WS_SILU); float* MP = wsp<float>(c, WS_MODP);
    GS_LOOP(it, 8 * DEPTH * 6144) { const int col = (int)(it % 6144), l = (int)((it / 6144) % DEPTH), ks = (int)(it / (6144 * DEPTH));
        float acc[NMOD];
#pragma unroll
        for (int m = 0; m < NMOD; ++m) acc[m] = 0.f;
        const float* w = c.in[I_ADAW] + ((size_t)l * D + ks * 128) * 6144 + col;
        for (int k = 0; k < 128; ++k) { const float wv = w[(size_t)k * 6144];
#pragma unroll
            for (int m = 0; m < NMOD; ++m) acc[m] += SL[m * D + ks * 128 + k] * wv; }
#pragma unroll
        for (int m = 0; m < NMOD; ++m) MP[(((size_t)ks * DEPTH + l) * NMOD + m) * 6144 + col] = acc[m]; }
}
HD void ph_modf(const Ctx& c, long gtid, long gstride) {
    const float* MP = wsp<float>(c, WS_MODP); float* MOD = wsp<float>(c, WS_MOD);
    GS_LOOP(it, DEPTH * NMOD * 6144) { const int col = (int)(it % 6144), l = (int)(it / ((long)NMOD * 6144)); float v = c.in[I_ADAB][l * 6144 + col];
#pragma unroll
        for (int ks = 0; ks < 16; ++ks) v += MP[(size_t)ks * DEPTH * NMOD * 6144 + it];
        MOD[it] = v; }
}
HD void ph_zt(const Ctx& c, long gtid, long gstride) {
    float* ZT = wsp<float>(c, WS_ZT);
    GS_LOOP(it, NPOS * 33) { const int e = (int)(it % 33), pidx = (int)(it / 33); const int L = pidx < SEQ ? SEQ : CTXL, t = pidx < SEQ ? pidx : pidx - SEQ;
        const float w = 6.283185307179586f * (float)t / (float)L; float v;
        if (e == 0) v = (float)t / (float)(L - 1);
        else { const int j = (e - 1) & 15; const float f = 1e-4f + (float)j * ((15.0f - 1e-4f) / 15.0f); v = e <= 16 ? cosf(f * w) : -sinf(f * w); }
        ZT[it] = v; }
}
HD void ph_hd1(const Ctx& c, long gtid, long gstride) {
    float* HD1 = wsp<float>(c, WS_HD1); const float* ZT = wsp<float>(c, WS_ZT);
    GS_LOOP(it, (long)DEPTH * NPOS * 64) { const int k = (int)(it % 64); const long q = it / 64; const int pidx = (int)(q % NPOS), l = (int)(q / NPOS);
        const float* w1 = c.in[I_HW1] + (size_t)l * 33 * 64 + k; const float* z = ZT + pidx * 33; float a1 = c.in[I_HB1][l * 64 + k];
#pragma unroll
        for (int e = 0; e < 33; ++e) a1 += z[e] * w1[e * 64];
        HD1[it] = sinf(c.in[I_HSF][l * 128 + k] * a1); }
}
HD void ph_hd2(const Ctx& c, long gtid, long gstride) {
    const float* HD1 = wsp<float>(c, WS_HD1); float* HD2 = wsp<float>(c, WS_HD2);
    GS_LOOP(it, (long)DEPTH * NPOS * 64) { const int i = (int)(it % 64); const long q = it / 64; const int l = (int)(q / NPOS);
        const float* h = HD1 + q * 64; const float* w2 = c.in[I_HW2] + (size_t)l * 64 * 64 + i; float a2 = c.in[I_HB2][l * 64 + i];
        float wv[64];
#pragma unroll
        for (int k = 0; k < 64; ++k) wv[k] = w2[k * 64];
#pragma unroll
        for (int k = 0; k < 64; ++k) a2 += h[k] * wv[k];
        HD2[it] = sinf(c.in[I_HSF][l * 128 + 64 + i] * a2); }
}
HD void ph_hyf2(const Ctx& c, long gtid, long gstride) {
    const float* HD2 = wsp<float>(c, WS_HD2); float* HF = wsp<float>(c, WS_HF);
    static_assert(NPOS % 4 == 0, "four positions per item");
    GS_LOOP(it, (long)DEPTH * (NPOS / 4) * 1536) { const int j = (int)(it % 1536); const long q4 = it / 1536; const int p4 = (int)(q4 % (NPOS / 4)), l = (int)(q4 / (NPOS / 4));
        const float* w3 = c.in[I_HW3] + (size_t)l * 64 * 1536 + j; float w[64];
#pragma unroll
        for (int i = 0; i < 64; ++i) w[i] = w3[(size_t)i * 1536];
        const float b3 = c.in[I_HB3][l * 1536 + j]; const int ch = j % DH;
        const float dmin = -3.0701134573253940f, dmax = -15.350567286626973f;
        const float delta = fabsf(dmin + (float)ch * ((dmax - dmin) / 383.0f));
#pragma unroll
        for (int u = 0; u < 4; ++u) { const int pidx = p4 * 4 + u; const int L = pidx < SEQ ? SEQ : CTXL, t = pidx < SEQ ? pidx : pidx - SEQ;
            const float* h = HD2 + ((size_t)l * NPOS + pidx) * 64; float a = b3;
#pragma unroll
            for (int i = 0; i < 64; ++i) a += h[i] * w[i];
            HF[((size_t)l * NPOS + pidx) * 1536 + j] = a * expf(-((float)t / (float)(L - 1)) * delta); } }
}
HD float hy_tap(const float* HFl, int pb, int o, int ch, int lag) {
    return lag >= 0 ? HFl[(size_t)(pb + lag) * 1536 + o * 768 + ch] : HFl[(size_t)(pb - lag) * 1536 + o * 768 + DH + ch];
}
HD void ph_s5tab(const Ctx& c, long gtid, long gstride) {
    float* TAB = wsp<float>(c, WS_S5TAB);
    GS_LOOP(it, DEPTH * 2 * S5G * S5P) { const int p = (int)(it % S5P), g = (int)((it / S5P) % S5G), d = (int)((it / (S5P * S5G)) % 2), l = (int)(it / (S5P * S5G * 2));
        const size_t li = ((size_t)(l * 2 + d) * S5G + g) * S5P + p;
        const float lre = c.in[I_LRE][li], lim = c.in[I_LIM][li], dt = expf(c.in[I_LDT][(l * 2 + d) * S5G + g]);
        const float mag = expf(lre * dt), lbr = mag * cosf(lim * dt), lbi = mag * sinf(lim * dt);
        const float nr = lbr - 1.0f, ni = lbi, den = lre * lre + lim * lim;
        TAB[it * 4 + 0] = lre * dt; TAB[it * 4 + 1] = lim * dt; TAB[it * 4 + 2] = (nr * lre + ni * lim) / den; TAB[it * 4 + 3] = (ni * lre - nr * lim) / den; }
}
HD void s5_pow(const float* tab, float e, float& pr, float& pi) { const float mg = expf(e * tab[0]); pr = mg * cosf(e * tab[1]); pi = mg * sinf(e * tab[1]); }
HD void ph_s5pow(const Ctx& c, long gtid, long gstride) {
    const float* TAB = wsp<float>(c, WS_S5TAB); float* PW = wsp<float>(c, WS_POWT);
    GS_LOOP(it, (long)DEPTH * 2 * S5G * S5P * 33) { const int e = (int)(it % 33); const long q = it / 33; float pr, pi; s5_pow(TAB + q * 4, (float)e, pr, pi); PW[it * 2] = pr; PW[it * 2 + 1] = pi; }
}
HD void ph_s5gen1(const Ctx& c, long gtid, long gstride) {
    const float* TAB = wsp<float>(c, WS_S5TAB); float* KD = wsp<float>(c, WS_KD);
    GS_LOOP(it, DEPTH * S5G * 2 * 256) { const int m = (int)(it % 16), n = (int)((it / 16) % 16), d = (int)((it / 256) % 2), g = (int)((it / 512) % S5G), l = (int)(it / (512 * S5G));
        float acc[S5T];
#pragma unroll
        for (int j = 0; j < S5T; ++j) acc[j] = 0.f;
        for (int p0 = 0; p0 < S5P; p0 += 8) { float t0[8], t1[8], t2[8], t3[8], brv[8], biv[8], crv[8], civ[8];
#pragma unroll
            for (int u = 0; u < 8; ++u) { const int p = p0 + u; const float* tb = TAB + ((((size_t)l * 2 + d) * S5G + g) * S5P + p) * 4; t0[u] = tb[0]; t1[u] = tb[1]; t2[u] = tb[2]; t3[u] = tb[3];
                const size_t bi = (((size_t)l * S5G + g) * S5P + p) * S5N + m, ci = (((size_t)l * S5G + g) * S5N + n) * S5P + p;
                brv[u] = c.in[I_BRE][bi]; biv[u] = c.in[I_BIM][bi]; crv[u] = c.in[I_CRE][ci]; civ[u] = c.in[I_CIM][ci]; }
#pragma unroll
            for (int u = 0; u < 8; ++u) { const float bbr = t2[u] * brv[u] - t3[u] * biv[u], bbi = t2[u] * biv[u] + t3[u] * brv[u];
                float zr = crv[u] * bbr - civ[u] * bbi, zi = crv[u] * bbi + civ[u] * bbr;
                const float mg = expf(t0[u]), lbr = mg * cosf(t1[u]), lbi = mg * sinf(t1[u]);
#pragma unroll
                for (int j = 0; j < S5T; ++j) { acc[j] += zr; const float t = zr * lbr - zi * lbi; zi = zr * lbi + zi * lbr; zr = t; } } }
#pragma unroll
        for (int j = 0; j < S5T; ++j) KD[((((size_t)l * S5G + g) * 2 + d) * S5T + j) * 256 + n * 16 + m] = acc[j]; }
}
HD void ph_s5gen2(const Ctx& c, long gtid, long gstride) {
    const float* TAB = wsp<float>(c, WS_S5TAB); const float* KD = wsp<float>(c, WS_KD); bf16* BT1 = wsp<bf16>(c, WS_BT1); bf16* BT2 = wsp<bf16>(c, WS_BT2); const float* PW = wsp<float>(c, WS_POWT);
    GS_LOOP(it16, (long)DEPTH * S5G * 768 * 32) { const long it = it16 * 16; const int s = (int)(it16 % 32), n1 = (int)((it16 / 32) % 768); const long lg = it16 / (32 * 768); const int g = (int)(lg % S5G), l = (int)(lg / S5G);
        float v[16];
        if (n1 < 512) { const int t = n1 / 16, n = n1 % 16; const float* kd = KD + (((size_t)l * S5G + g) * 2) * S5T * 256 + n * 16;
            if (t != s) { const float* q = kd + (size_t)(t > s ? t - s : S5T + s - t) * 256;
#pragma unroll
                for (int u = 0; u < 16; ++u) v[u] = q[u]; }
            else { const float* q = kd + (size_t)S5T * 256; const float dd = c.in[I_S5D][l * DH + g * S5N + n];
#pragma unroll
                for (int u = 0; u < 16; ++u) v[u] = kd[u] + q[u] + (n == u ? dd : 0.f); } }
        else { const int idx = n1 - 512, d = idx / 128, p = (idx % 128) / 2, cc = idx % 2; const float* tb = TAB + ((((size_t)l * 2 + d) * S5G + g) * S5P + p) * 4;
            const size_t bi = (((size_t)l * S5G + g) * S5P + p) * S5N; const float t2 = tb[2], t3 = tb[3];
            const float* pw = PW + (((((size_t)l * 2 + d) * S5G + g) * S5P + p) * 33 + (d == 0 ? S5T - 1 - s : s)) * 2; const float pr = pw[0], pi = pw[1];
            float br[16], bim[16];
#pragma unroll
            for (int u = 0; u < 16; ++u) { br[u] = c.in[I_BRE][bi + u]; bim[u] = c.in[I_BIM][bi + u]; }
#pragma unroll
            for (int u = 0; u < 16; ++u) { const float bbr = t2 * br[u] - t3 * bim[u], bbi = t2 * bim[u] + t3 * br[u]; v[u] = cc == 0 ? pr * bbr - pi * bbi : pr * bbi + pi * bbr; } }
#pragma unroll
        for (int u = 0; u < 16; ++u) BT1[it + u] = f2bf(v[u]); }
    GS_LOOP(it16, (long)DEPTH * S5G * 512 * 16) { const long it = it16 * 16; const int k16 = (int)(it16 % 16), n2 = (int)((it16 / 16) % 512); const long lg = it16 / (16 * 512); const int g = (int)(lg % S5G), l = (int)(lg / S5G);
        const int t = n2 / 16, n = n2 % 16, d = k16 / 8, p0 = (k16 % 8) * 8; float cr[8], cim[8], pr[8], pi[8];
        const size_t ci = (((size_t)l * S5G + g) * S5N + n) * S5P + p0;
#pragma unroll
        for (int u = 0; u < 8; ++u) { cr[u] = c.in[I_CRE][ci + u]; cim[u] = c.in[I_CIM][ci + u];
            const float* pw = PW + (((((size_t)l * 2 + d) * S5G + g) * S5P + p0 + u) * 33 + (d == 0 ? t + 1 : S5T - t)) * 2; pr[u] = pw[0]; pi[u] = pw[1]; }
#pragma unroll
        for (int u = 0; u < 8; ++u) { BT2[it + 2 * u] = f2bf(cr[u] * pr[u] - cim[u] * pi[u]); BT2[it + 2 * u + 1] = f2bf(-(cr[u] * pi[u] + cim[u] * pr[u])); } }
}
HD int s5_row(int d, int b, int step) {
    constexpr int NCC = CTXL / S5T, NCL = SEQ / S5T;
    if (step < NCC) return NTL / S5T + b * NCC + (d ? NCC - 1 - step : step);
    const int i = step - NCC; return b * NCL + (d ? NCL - 1 - i : i);
}
HD void ph_s5cscan(const Ctx& c, int l, long gtid, long gstride) {
    const float* TAB = wsp<float>(c, WS_S5TAB); const float* SL = wsp<float>(c, WS_SLOC); bf16* XI = wsp<bf16>(c, WS_XIN);
    GS_LOOP(it, NB * S5G * 2 * S5P) { const int p = (int)(it % S5P), d = (int)((it / S5P) % 2), g = (int)((it / (2 * S5P)) % S5G), b = (int)(it / (2 * S5P * S5G));
        const float* tb = TAB + ((((size_t)l * 2 + d) * S5G + g) * S5P + p) * 4; float lr, li; s5_pow(tb, (float)S5T, lr, li);
        float xr = 0.f, xi = 0.f;
        for (int st0 = 0; st0 < NPOS / S5T; st0 += 8) { float sr[8], si[8]; size_t o[8];
#pragma unroll
            for (int k = 0; k < 8; ++k) { o[k] = ((size_t)g * S5RP + s5_row(d, b, st0 + k)) * 256 + d * 128 + 2 * p; sr[k] = SL[o[k]]; si[k] = SL[o[k] + 1]; }
#pragma unroll
            for (int k = 0; k < 8; ++k) { XI[o[k]] = f2bf(xr); XI[o[k] + 1] = f2bf(xi); const float t = lr * xr - li * xi + sr[k]; xi = lr * xi + li * xr + si[k]; xr = t; } } }
}
HD void ph_wr(const Ctx& c, long gtid, long gstride) {
    bf16* WH = wsp<bf16>(c, WS_WRH); bf16* WL = wsp<bf16>(c, WS_WRL);
    GS_LOOP(it, DEPTH * NE * D) { const int k = (int)(it % D), e = (int)((it / D) % NE), l = (int)(it / (D * NE)); const float w = c.in[I_RW][((size_t)l * D + k) * NE + e];
        const bf16 hi = f2bf(w); WH[it] = hi; WL[it] = f2bf(w - bf2f(hi)); }
}
HD void ph_norm1(const Ctx& c, int l, long gtid, long gstride) {
    const float* X = wsp<float>(c, WS_X); bf16* H = wsp<bf16>(c, WS_H); const float* MOD = wsp<float>(c, WS_MOD);
    GS_LOOP(r, NT) { int b, t, L, base, mb; tokinfo((int)r, b, t, L, base, mb);
        const float* x = X + (size_t)r * D; float ss = 0.f;
        for (int k = 0; k < D; ++k) ss += x[k] * x[k];
        const float rs = 1.0f / sqrtf(ss / D + EPS);
        const float* g = c.in[I_N1G] + l * D; const float* sh = MOD + ((size_t)l * NMOD + mb) * 6144; const float* sc = sh + D;
        for (int k = 0; k < D; ++k) H[(size_t)r * D + k] = f2bf(x[k] * rs * g[k] * (1.0f + sc[k]) + sh[k]); }
}
HD float conv3(const bf16* P, int r, int col, const float* w, const float* b, int wpitch, int j) {
    float y = b[j] + bf2f(P[(size_t)r * NP + col]) * w[wpitch + j];
    if (has_prev(r)) y += bf2f(P[(size_t)(r - 1) * NP + col]) * w[j];
    if (has_next(r)) y += bf2f(P[(size_t)(r + 1) * NP + col]) * w[2 * wpitch + j];
    return y;
}
HD void ph_s5scan(const Ctx& c, int l, int d, long gtid, long gstride) {
    const bf16* P = wsp<bf16>(c, WS_P); float* XS = wsp<float>(c, WS_XS);
    GS_LOOP(it, NB * S5G * S5P) { const int p = (int)(it % S5P), g = (int)((it / S5P) % S5G), b = (int)(it / (S5P * S5G));
        const size_t li = ((size_t)(l * 2 + d) * S5G + g) * S5P + p;
        const float lre = c.in[I_LRE][li], lim = c.in[I_LIM][li], dt = expf(c.in[I_LDT][(l * 2 + d) * S5G + g]);
        const float mag = expf(lre * dt), lbr = mag * cosf(lim * dt), lbi = mag * sinf(lim * dt);
        const float nr = lbr - 1.0f, ni = lbi, den = lre * lre + lim * lim;
        const float rr = (nr * lre + ni * lim) / den, ri = (ni * lre - nr * lim) / den;
        float bbr[S5N], bbi[S5N];
#pragma unroll
        for (int n = 0; n < S5N; ++n) { const size_t bi = (((size_t)l * S5G + g) * S5P + p) * S5N + n; const float br = c.in[I_BRE][bi], bim = c.in[I_BIM][bi];
            bbr[n] = rr * br - ri * bim; bbi[n] = rr * bim + ri * br; }
        float xr = 0.f, xi = 0.f;
        for (int tau = 0; tau < NPOS; ++tau) { const int r = seq_tok(d, b, tau); const bf16* u = P + (size_t)r * NP + PC_S5 + g * S5N;
            float ur = 0.f, ui = 0.f;
#pragma unroll
            for (int n = 0; n < S5N; ++n) { const float uv = bf2f(u[n]); ur += bbr[n] * uv; ui += bbi[n] * uv; }
            const float nxr = lbr * xr - lbi * xi + ur, nxi = lbr * xi + lbi * xr + ui; xr = nxr; xi = nxi;
            float* o = XS + (((size_t)r * S5G + g) * S5P + p) * 2; o[0] = xr; o[1] = xi; } }
}
HD void ph_mixA(const Ctx& c, int l, long gtid, long gstride) {
    const bf16* P = wsp<bf16>(c, WS_P);
}
HD void ph_s5proj(const Ctx& c, int l, int d, long gtid, long gstride) {
    const bf16* P = wsp<bf16>(c, WS_P); const float* XS = wsp<float>(c, WS_XS); float* YS = wsp<float>(c, WS_YS5); bf16* G = wsp<bf16>(c, WS_G);
    GS_LOOP(it, (long)NT * DH) { const int n = (int)(it % S5N), g = (int)((it / S5N) % S5G), r = (int)(it / DH);
        const float* cr = c.in[I_CRE] + (((size_t)l * S5G + g) * S5N + n) * S5P; const float* ci = c.in[I_CIM] + (((size_t)l * S5G + g) * S5N + n) * S5P;
        const float* xs = XS + ((size_t)r * S5G + g) * S5P * 2; float a = 0.f;
        for (int p = 0; p < S5P; ++p) a += xs[2 * p] * cr[p] - xs[2 * p + 1] * ci[p];
        if (d == 0) YS[it] = c.in[I_S5D][l * DH + g * S5N + n] * bf2f(P[(size_t)r * NP + PC_S5 + g * S5N + n]) + a;
        else G[it] = f2bf(gelu_t(YS[it] + a)); }
}
HD void ph_mixB(const Ctx& c, int l, long gtid, long gstride) {
}
HD void ph_mixC(const Ctx& c, int l, long gtid, long gstride) {
}
HD void ph_mixD(const Ctx& c, int l, long gtid, long gstride) {
    const bf16* P = wsp<bf16>(c, WS_P); const float* HFB = wsp<float>(c, WS_HFB); bf16* MLO = wsp<bf16>(c, WS_MLO);
    GS_LOOP(it, (long)NT * MLH) { const int h = (int)(it % MLH), r = (int)(it / MLH);
        const float* a = HFB + (size_t)r * DH + h * MLD; const float* bq = HFB + ((size_t)NT + r) * DH + h * MLD; float ss = 0.f;
        for (int e = 0; e < MLD; ++e) { const float v = a[e] + bq[e]; ss += v * v; }
        const float rs = 1.0f / sqrtf(ss / MLD + EPS);
        for (int e = 0; e < MLD; ++e) { const float v = (a[e] + bq[e]) * rs * c.in[I_MLNG][l * DH + h * MLD + e];
            MLO[(size_t)r * DH + h * MLD + e] = f2bf(v * sigm(bf2f(P[(size_t)r * NP + PC_O + h * MLD + e]))); } }
}
#ifdef HOST_TEST
HD int atomic_inc(unsigned* p) { return (int)((*p)++); }
#else
__device__ __forceinline__ int atomic_inc(unsigned* p) { return (int)__hip_atomic_fetch_add(p, 1u, __ATOMIC_RELAXED, __HIP_MEMORY_SCOPE_AGENT); }
#endif
HD void ph_route(const Ctx& c, int l, long gtid, long gstride) {
    const float* X = wsp<float>(c, WS_X); bf16* H = wsp<bf16>(c, WS_H); const float* MOD = wsp<float>(c, WS_MOD);
    int* AE = wsp<int>(c, WS_ASGE); int* AP = wsp<int>(c, WS_ASGP); float* AW = wsp<float>(c, WS_ASGW); unsigned* CNT = wsp<unsigned>(c, WS_CTL) + CW_CNT + l * NE;
    GS_LOOP(r, NT) { int b, t, L, base, mb; tokinfo((int)r, b, t, L, base, mb);
        const float* x = X + (size_t)r * D; float ss = 0.f;
        for (int k = 0; k < D; ++k) ss += x[k] * x[k];
        const float rs = 1.0f / sqrtf(ss / D + EPS);
        const float* g = c.in[I_N2G] + l * D; const float* sh = MOD + ((size_t)l * NMOD + mb) * 6144 + 3 * D; const float* sc = sh + D;
        const float* rw = c.in[I_RW] + (size_t)l * D * NE;
        float lg[NE];
#pragma unroll
        for (int e = 0; e < NE; ++e) lg[e] = c.in[I_RB][l * NE + e];
        for (int k = 0; k < D; ++k) { const float hv = x[k] * rs * g[k] * (1.0f + sc[k]) + sh[k]; H[(size_t)r * D + k] = f2bf(hv);
#pragma unroll
            for (int e = 0; e < NE; ++e) lg[e] += hv * rw[k * NE + e]; }
        int sel[TOPK]; float sv[TOPK]; unsigned taken = 0u;
#pragma unroll
        for (int kk = 0; kk < TOPK; ++kk) { float best = -3.0e38f; int bi = 0;
#pragma unroll
            for (int e = 0; e < NE; ++e) { if (!((taken >> e) & 1u) && lg[e] > best) { best = lg[e]; bi = e; } }
            sel[kk] = bi; sv[kk] = best; taken |= 1u << bi; }
        float es[TOPK], sum = 0.f;
#pragma unroll
        for (int kk = 0; kk < TOPK; ++kk) { es[kk] = expf(sv[kk] - sv[0]); sum += es[kk]; }
#pragma unroll
        for (int kk = 0; kk < TOPK; ++kk) { AE[r * TOPK + kk] = sel[kk]; AW[r * TOPK + kk] = es[kk] / sum; AP[r * TOPK + kk] = atomic_inc(CNT + sel[kk]); } }
}
HD void ph_offs(const Ctx& c, int l, long gtid, long gstride) {
    if (gtid != 0) return;
    const unsigned* CNT = wsp<unsigned>(c, WS_CTL) + CW_CNT + l * NE; int* TAB = wsp<int>(c, WS_TAB); int run = 0;
    for (int e = 0; e < NE; ++e) { TAB[e] = run * 256; const int nb = ((int)CNT[e] + 255) / 256; for (int j = 0; j < nb; ++j) TAB[64 + run + j] = e; run += nb; }
    TAB[32] = run;
}
HD void ph_dispatch(const Ctx& c, int l, long gtid, long gstride) {
    const int* AE = wsp<int>(c, WS_ASGE); const int* AP = wsp<int>(c, WS_ASGP); int* AS_ = wsp<int>(c, WS_ASGS); const int* TAB = wsp<int>(c, WS_TAB);
    const uint4* H = wsp<uint4>(c, WS_H); uint4* A = wsp<uint4>(c, WS_AS);
    GS_LOOP(it, (long)NT * TOPK * 128) { const int ch = (int)(it % 128); const long a = it / 128; const int r = (int)(a / TOPK);
        const int slot = TAB[AE[a]] + AP[a]; A[(size_t)slot * 128 + ch] = H[(size_t)r * 128 + ch]; if (ch == 0) AS_[a] = slot; }
}
HD void ph_combine(const Ctx& c, int l, long gtid, long gstride) {
    const int* AS_ = wsp<int>(c, WS_ASGS); const float* AW = wsp<float>(c, WS_ASGW); const bf16* O = wsp<bf16>(c, WS_OUTS); float* X = wsp<float>(c, WS_X); const float* MOD = wsp<float>(c, WS_MOD);
    GS_LOOP(it, (long)NT * D) { const int col = (int)(it % D), r = (int)(it / D); int b, t, L, base, mb; tokinfo(r, b, t, L, base, mb); float f = 0.f;
#pragma unroll
        for (int kk = 0; kk < TOPK; ++kk) f += AW[r * TOPK + kk] * bf2f(O[(size_t)AS_[r * TOPK + kk] * D + col]);
        X[it] += MOD[((size_t)l * NMOD + mb) * 6144 + 5 * D + col] * f; }
}
HD void ph_final(const Ctx& c, long gtid, long gstride) {
    const float* X = wsp<float>(c, WS_X);
    GS_LOOP(r, NTL) { const float* x = X + (size_t)r * D; float ss = 0.f;
        for (int k = 0; k < D; ++k) ss += x[k] * x[k];
        const float rs = 1.0f / sqrtf(ss / D + EPS);
        for (int k = 0; k < D; ++k) c.out[(size_t)r * D + k] = x[k] * rs * c.in[I_FNG][k]; }
}

constexpr int NPRO = 5, NLP = 12, NPHASE = NPRO + DEPTH * NLP + 1;

#ifndef HOST_TEST
#define LAS __attribute__((address_space(3)))
#define GAS __attribute__((address_space(1)))
typedef unsigned v4u __attribute__((ext_vector_type(4)));
typedef unsigned v2u __attribute__((ext_vector_type(2)));
#define LDS_WAIT() asm volatile("s_waitcnt lgkmcnt(0)" ::: "memory")

namespace pg8 {
#define PG8_LAS __attribute__((address_space(3)))
typedef unsigned short bf16_t;
typedef short bf16x8 __attribute__((ext_vector_type(8)));
typedef float f32x4 __attribute__((ext_vector_type(4)));
typedef unsigned u32x4 __attribute__((ext_vector_type(4)));
constexpr int BM = 256, BK = 64, HALF = 128, HTB = HALF * BK * 2, STAGE_BYTES = 8 * HTB, NXCD = 8, WGM = 8;
__host__ __device__ __forceinline__ int lds_byte(int r, int c) { const int st = (r >> 4) * 2 + (c >> 5), rr = r & 15, cc = c & 31, ob = rr * 64 + cc * 2; return st * 1024 + (ob ^ (((ob >> 9) & 1) << 5)); }
__host__ __device__ __forceinline__ void stage_rc(int b, int& R, int& C) { const int st = b / 1024, sb = b % 1024, swz = sb ^ (((sb >> 9) & 1) << 5); R = (st >> 1) * 16 + swz / 64; C = (st & 1) * 32 + (swz % 64) / 2; }
__host__ __device__ __forceinline__ int perm32(int rho) { const int n = rho >> 4, i = rho & 15; return 8 * (i >> 2) + 4 * n + (i & 3); }

struct Unit { int pm, pn, pb, e; };
struct Gemm { const bf16_t* A; const bf16_t* Bt; int M, N, K; unsigned a_row, a_kstep, a_sub, a_grp; int a_mode; const int* a_gather; };
__host__ __device__ __forceinline__ Gemm make_gemm(const bf16_t* A, const bf16_t* Bt, int M, int N, int K) { Gemm g; g.A = A; g.Bt = Bt; g.M = M; g.N = N; g.K = K; g.a_row = (unsigned)K * 2u; g.a_kstep = BK * 2; g.a_sub = 0; g.a_grp = 0; g.a_mode = 0; g.a_gather = nullptr; return g; }

struct StaticOrder {
    static constexpr bool GATHER = false;
    int nM, nN, nwg, G, c;
    __host__ __device__ void init(int M, int N, int G_, int c_) { nM = M / BM; nN = N / BM; nwg = nM * nN; G = G_; c = c_; }
    __host__ __device__ bool next(int i, Unit& u) const {
        const long L = (long)i * G + c; if (L >= nwg) return false;
        int wgid = (int)L; { const int q = nwg / NXCD, r = nwg % NXCD, xcd = wgid % NXCD, off = wgid / NXCD; wgid = (xcd < r ? xcd * (q + 1) : r * (q + 1) + (xcd - r) * q) + off; }
        const int nig = WGM * nN, gid = wgid / nig, fm = gid * WGM, gsz = (nM - fm) < WGM ? (nM - fm) : WGM;
        u.pm = fm + ((wgid % nig) % gsz); u.pn = (wgid % nig) / gsz; u.pb = u.pn; u.e = 0; return true;
    }
    __device__ __forceinline__ void a_ready(const Unit&) const {}
    __device__ __forceinline__ void done(const Unit&) const {}
};
template <bool GATH> struct MoeOrderT {
    static constexpr bool GATHER = GATH;
    const PG8_LAS int* tab; int nN, G, c;
    __device__ bool next(int i, Unit& u) const {
        const int nblk = tab[0]; int blk, pn;
        if ((G & 7) == 0) { const int x = c & 7, j = c >> 3, uu = i * (G >> 3) + j; blk = (uu / nN) * 8 + x; pn = uu % nN; }
        else { const long L = (long)i * G + c; blk = (int)(L / nN); pn = (int)(L % nN); }
        if (blk >= nblk) return false;
        u.pm = blk; u.pn = pn; u.e = tab[32 + blk]; u.pb = u.e * nN + pn; return true;
    }
    __device__ __forceinline__ void a_ready(const Unit&) const {}
    __device__ __forceinline__ void done(const Unit&) const {}
};

struct S5Order {
    static constexpr bool GATHER = false;
    int nN, G, c;
    __device__ bool next(int i, Unit& u) const {
        constexpr int nM = S5RP / BM; const long L = (long)i * G + c; if (L >= (long)S5G * nM * nN) return false;
        u.pn = (int)(L % nN); u.pm = (int)((L / nN) % nM); u.e = (int)(L / (nN * nM)); u.pb = u.e * nN + u.pn; return true;
    }
    __device__ __forceinline__ void a_ready(const Unit&) const {}
    __device__ __forceinline__ void done(const Unit&) const {}
};
typedef int i32x4 __attribute__((ext_vector_type(4)));
template <class Epi, class Sched, bool ALIGN_EPI = false, bool SP2 = false, bool I8 = false>
__device__ __forceinline__ void gemm_phase(PG8_LAS unsigned char* lds, const Gemm g, const Sched& S, const Epi& E, int tid_in) {
    int tid = tid_in; asm volatile("" : "+v"(tid));
    const int wid = __builtin_amdgcn_readfirstlane(tid >> 6), lane = tid & 63, wr = wid >> 2, wc = wid & 3, fr = lane & 15, fq = lane >> 4;
    const int K = g.K, nt = K / BK;
    unsigned voffA[2], voffB[2];
#pragma unroll
    for (int i = 0; i < 2; ++i) { int R, C; stage_rc(tid * 16 + i * 8192, R, C); const int Rb = Epi::PERM ? ((R & ~31) + perm32(R & 31)) : R;
        voffA[i] = (unsigned)R * g.a_row + (g.a_mode ? (unsigned)(C >> 4) * g.a_sub + (unsigned)(C & 15) * 2u : (unsigned)C * 2u); voffB[i] = (unsigned)(Rb * K + C) * 2u; }
    const size_t kstep = (size_t)(BK * 2), kstepA = g.a_kstep;
    const size_t hstep = (size_t)HALF * K * 2, hstepA = (size_t)HALF * g.a_row;
    const size_t tstep = 2 * hstep, tstepA = 2 * hstepA;
    const unsigned ldsw = (unsigned)wid * 1024u;
    const int aoff = lds_byte(wr * 64 + fr, fq * 8), boff = lds_byte(wc * 32 + fr, fq * 8);
#define PG8_SA(b, h) (((b) * 2 + (h)) * HTB)
#define PG8_SB(b, h) ((4 + (b) * 2 + (h)) * HTB)
#define PG8_STAGE(bufoff, gbase, voff) do { _Pragma("unroll") for (int _i = 0; _i < 2; ++_i) \
        __builtin_amdgcn_global_load_lds((const unsigned*)((const char*)(gbase) + (voff)[_i]), (PG8_LAS unsigned*)(lds + (bufoff) + ldsw + _i * 8192), 16, 0, 0); } while (0)
#define PG8_LDA(dst, b, h) do { _Pragma("unroll") for (int m = 0; m < 4; ++m) _Pragma("unroll") for (int k = 0; k < 2; ++k) dst[m][k] = *(const PG8_LAS bf16x8*)(lds + PG8_SA(b, h) + aoff + m * 2048 + k * 1024); } while (0)
#define PG8_LDB(dst, b, h) do { _Pragma("unroll") for (int n = 0; n < 2; ++n) _Pragma("unroll") for (int k = 0; k < 2; ++k) dst[n][k] = *(const PG8_LAS bf16x8*)(lds + PG8_SB(b, h) + boff + n * 2048 + k * 1024); } while (0)
#define PG8_MMA(ai, bj, At, Bt) do { __builtin_amdgcn_s_setprio(1); _Pragma("unroll") for (int m = 0; m < 4; ++m) _Pragma("unroll") for (int n = 0; n < 2; ++n) _Pragma("unroll") for (int k = 0; k < 2; ++k) \
        { if constexpr (I8) acc[ai][bj][m][n] = __builtin_bit_cast(f32x4, __builtin_amdgcn_mfma_i32_16x16x64_i8(__builtin_bit_cast(i32x4, Bt[n][k]), __builtin_bit_cast(i32x4, At[m][k]), __builtin_bit_cast(i32x4, acc[ai][bj][m][n]), 0, 0, 0)); \
          else acc[ai][bj][m][n] = __builtin_amdgcn_mfma_f32_16x16x32_bf16(Bt[n][k], At[m][k], acc[ai][bj][m][n], 0, 0, 0); } __builtin_amdgcn_s_setprio(0); } while (0)
#define PG8_WAIT_V(n) asm volatile("s_waitcnt vmcnt(" #n ")" ::: "memory")
#define PG8_WAIT_L(n) asm volatile("s_waitcnt lgkmcnt(" #n ")" ::: "memory")
#define PG8_BAR __builtin_amdgcn_s_barrier()
#define PG8_SCHED __builtin_amdgcn_sched_barrier(0)
    Unit cur, nxt; int ui = 0;
    if (!S.next(0, cur)) return;
    f32x4 acc[2][2][4][2];
#pragma unroll
    for (int a = 0; a < 2; ++a)
#pragma unroll
        for (int b = 0; b < 2; ++b)
#pragma unroll
            for (int m = 0; m < 4; ++m)
#pragma unroll
                for (int n = 0; n < 2; ++n) acc[a][b][m][n] = (f32x4){0.f, 0.f, 0.f, 0.f};
    bf16x8 At[4][2], B0[2][2], B1[2][2];
    const char* cA = Sched::GATHER ? (const char*)g.A : (const char*)g.A + (size_t)cur.pm * tstepA + (size_t)cur.e * g.a_grp; const char* cB = (const char*)g.Bt + (size_t)cur.pb * tstep;
    int Rg[2], Cg[2]; unsigned vg0[2] = {0u, 0u}, vg1[2] = {0u, 0u}, vn0[2] = {0u, 0u}, vn1[2] = {0u, 0u};
    if constexpr (Sched::GATHER) {
#pragma unroll
        for (int i = 0; i < 2; ++i) { stage_rc(tid * 16 + i * 8192, Rg[i], Cg[i]);
            vg0[i] = (unsigned)g.a_gather[cur.pm * BM + Rg[i]] * g.a_row + (unsigned)Cg[i] * 2u; vg1[i] = (unsigned)g.a_gather[cur.pm * BM + HALF + Rg[i]] * g.a_row + (unsigned)Cg[i] * 2u; } }
#define PG8_STAGE_A(bufoff, gbase, half, nx) do { if constexpr (Sched::GATHER) { _Pragma("unroll") for (int _i = 0; _i < 2; ++_i) { const unsigned _v = (nx) ? ((half) ? vn1[_i] : vn0[_i]) : ((half) ? vg1[_i] : vg0[_i]); \
        __builtin_amdgcn_global_load_lds((const unsigned*)((const char*)(gbase) + _v), (PG8_LAS unsigned*)(lds + (bufoff) + ldsw + _i * 8192), 16, 0, 0); } } \
        else { PG8_STAGE(bufoff, (gbase) + ((half) ? hstepA : 0), voffA); } } while (0)
    S.a_ready(cur);
    if constexpr (SP2) {
        PG8_STAGE(PG8_SB(0, 0), cB, voffB); PG8_STAGE(PG8_SB(0, 1), cB + hstep, voffB); PG8_STAGE_A(PG8_SA(0, 0), cA, 0, false); PG8_STAGE_A(PG8_SA(0, 1), cA, 1, false);
        if (wr == 1) PG8_BAR;
        PG8_WAIT_V(2); PG8_BAR;
        PG8_STAGE(PG8_SB(1, 0), cB + kstep, voffB); PG8_STAGE_A(PG8_SA(1, 0), cA + kstepA, 0, false); PG8_STAGE(PG8_SB(1, 1), cB + hstep + kstep, voffB);
        PG8_WAIT_V(6); PG8_BAR;
    } else {
        PG8_STAGE(PG8_SB(0, 0), cB, voffB); PG8_STAGE_A(PG8_SA(0, 0), cA, 0, false); PG8_STAGE(PG8_SB(0, 1), cB + hstep, voffB); PG8_STAGE_A(PG8_SA(0, 1), cA, 1, false);
        if (wr == 1) PG8_BAR;
        PG8_WAIT_V(4); PG8_BAR;
        PG8_STAGE(PG8_SB(1, 0), cB + kstep, voffB); PG8_STAGE_A(PG8_SA(1, 0), cA + kstepA, 0, false); PG8_STAGE(PG8_SB(1, 1), cB + hstep + kstep, voffB);
        PG8_WAIT_V(6); PG8_BAR;
    }
    for (;;) {
        const bool has_next = S.next(ui + 1, nxt);
        const char* nA = Sched::GATHER ? (const char*)g.A : (has_next ? (const char*)g.A + (size_t)nxt.pm * tstepA + (size_t)nxt.e * g.a_grp : cA); const char* nB = has_next ? (const char*)g.Bt + (size_t)nxt.pb * tstep : cB;
        if constexpr (Sched::GATHER) { const int npm = has_next ? nxt.pm : cur.pm;
#pragma unroll
            for (int i = 0; i < 2; ++i) { vn0[i] = (unsigned)g.a_gather[npm * BM + Rg[i]] * g.a_row + (unsigned)Cg[i] * 2u; vn1[i] = (unsigned)g.a_gather[npm * BM + HALF + Rg[i]] * g.a_row + (unsigned)Cg[i] * 2u; } }
#pragma unroll 1
        for (int t = 0; t < nt; t += 2) {
            const bool last = (t == nt - 2);
            const char* a1 = cA + (size_t)(t + 1) * kstepA;
            const char* a2 = last ? nA : cA + (size_t)(t + 2) * kstepA; const char* b2 = last ? nB : cB + (size_t)(t + 2) * kstep;
            const char* a3 = a2 + kstepA; const char* b3 = b2 + kstep;
            if (last && has_next) S.a_ready(nxt);
            if constexpr (SP2) {
            PG8_LDB(B0, 0, 0); PG8_LDB(B1, 0, 1); PG8_SCHED; PG8_LDA(At, 0, 0); PG8_STAGE_A(PG8_SA(1, 1), a1, 1, false);
            PG8_WAIT_V(8); PG8_WAIT_L(0); PG8_BAR; PG8_MMA(0, 0, At, B0); PG8_MMA(0, 1, At, B1); PG8_BAR; PG8_SCHED;
            PG8_LDA(At, 0, 1); PG8_STAGE(PG8_SB(0, 0), b2, voffB); PG8_STAGE(PG8_SB(0, 1), b2 + hstep, voffB); PG8_STAGE_A(PG8_SA(0, 0), a2, 0, last);
            PG8_WAIT_V(8); PG8_WAIT_L(0); PG8_BAR; PG8_MMA(1, 0, At, B0); PG8_MMA(1, 1, At, B1); PG8_BAR; PG8_SCHED;
            PG8_LDB(B0, 1, 0); PG8_LDB(B1, 1, 1); PG8_SCHED; PG8_LDA(At, 1, 0); PG8_STAGE_A(PG8_SA(0, 1), a2, 1, last);
            PG8_WAIT_V(8); PG8_WAIT_L(0); PG8_BAR; PG8_MMA(0, 0, At, B0); PG8_MMA(0, 1, At, B1); PG8_BAR; PG8_SCHED;
            PG8_LDA(At, 1, 1); PG8_STAGE(PG8_SB(1, 0), b3, voffB); PG8_STAGE(PG8_SB(1, 1), b3 + hstep, voffB); PG8_STAGE_A(PG8_SA(1, 0), a3, 0, last);
            PG8_WAIT_V(8); PG8_WAIT_L(0); PG8_BAR; PG8_MMA(1, 0, At, B0); PG8_MMA(1, 1, At, B1); PG8_BAR; PG8_SCHED;
            } else {
            PG8_LDB(B0, 0, 0); PG8_SCHED; PG8_LDA(At, 0, 0); PG8_STAGE_A(PG8_SA(1, 1), a1, 1, false);
            PG8_WAIT_L(8); PG8_BAR; PG8_WAIT_L(0); PG8_MMA(0, 0, At, B0); PG8_BAR; PG8_SCHED;
            PG8_LDB(B1, 0, 1); PG8_STAGE(PG8_SB(0, 0), b2, voffB);
            PG8_BAR; PG8_WAIT_L(0); PG8_MMA(0, 1, At, B1); PG8_BAR;
            PG8_LDA(At, 0, 1); PG8_STAGE_A(PG8_SA(0, 0), a2, 0, last);
            PG8_BAR; PG8_WAIT_L(0); PG8_MMA(1, 0, At, B0); PG8_BAR; PG8_SCHED;
            PG8_STAGE(PG8_SB(0, 1), b2 + hstep, voffB);
            PG8_WAIT_V(6); PG8_BAR; PG8_MMA(1, 1, At, B1); PG8_BAR;
            PG8_LDB(B0, 1, 0); PG8_SCHED; PG8_LDA(At, 1, 0); PG8_STAGE_A(PG8_SA(0, 1), a2, 1, last);
            PG8_WAIT_L(8); PG8_BAR; PG8_WAIT_L(0); PG8_MMA(0, 0, At, B0); PG8_BAR; PG8_SCHED;
            PG8_LDB(B1, 1, 1); PG8_STAGE(PG8_SB(1, 0), b3, voffB);
            PG8_BAR; PG8_WAIT_L(0); PG8_MMA(0, 1, At, B1); PG8_BAR;
            PG8_LDA(At, 1, 1); PG8_STAGE_A(PG8_SA(1, 0), a3, 0, last);
            PG8_BAR; PG8_WAIT_L(0); PG8_MMA(1, 0, At, B0); PG8_BAR; PG8_SCHED;
            PG8_STAGE(PG8_SB(1, 1), b3 + hstep, voffB);
            PG8_WAIT_V(6); PG8_BAR; PG8_MMA(1, 1, At, B1); PG8_BAR;
            }
        }
        if constexpr (ALIGN_EPI) { if (wr == 0) PG8_BAR; }
        E(acc, cur, wr, wc, fr, fq); S.done(cur);
        if (!has_next) break;
#pragma unroll
        for (int a = 0; a < 2; ++a)
#pragma unroll
            for (int b = 0; b < 2; ++b)
#pragma unroll
                for (int m = 0; m < 4; ++m)
#pragma unroll
                    for (int n = 0; n < 2; ++n) acc[a][b][m][n] = (f32x4){0.f, 0.f, 0.f, 0.f};
        cur = nxt; cA = nA; cB = nB; ++ui;
        if constexpr (Sched::GATHER) {
#pragma unroll
            for (int i = 0; i < 2; ++i) { vg0[i] = vn0[i]; vg1[i] = vn1[i]; } }
        if constexpr (ALIGN_EPI) { if (wr == 1) PG8_BAR; }
    }
    PG8_WAIT_V(0);
    if constexpr (!ALIGN_EPI) { if (wr == 0) PG8_BAR; }
    PG8_BAR;
#undef PG8_SA
#undef PG8_SB
#undef PG8_STAGE
#undef PG8_STAGE_A
#undef PG8_LDA
#undef PG8_LDB
#undef PG8_MMA
#undef PG8_WAIT_V
#undef PG8_WAIT_L
#undef PG8_BAR
#undef PG8_SCHED
}

__device__ __forceinline__ float fsig(float x) { return __builtin_amdgcn_rcpf(1.0f + __builtin_amdgcn_exp2f(-1.4426950408889634f * x)); }
#define EPI_LOOP(BODY) \
    _Pragma("unroll") for (int ai = 0; ai < 2; ++ai) _Pragma("unroll") for (int m = 0; m < 4; ++m) { const int row = u.pm * BM + ai * HALF + wr * 64 + m * 16 + fr; \
    _Pragma("unroll") for (int bj = 0; bj < 2; ++bj) _Pragma("unroll") for (int n = 0; n < 2; ++n) { const int col = u.pn * BM + bj * HALF + wc * 32 + n * 16 + 4 * fq; const f32x4 a = acc[ai][bj][m][n]; BODY } \
    asm volatile("" ::: "memory"); }
#define EPI_LOOP2(BODY) \
    _Pragma("unroll") for (int ai = 0; ai < 2; ++ai) _Pragma("unroll") for (int m = 0; m < 4; ++m) { const int row = u.pm * BM + ai * HALF + wr * 64 + m * 16 + fr; \
    _Pragma("unroll") for (int bj = 0; bj < 2; ++bj) _Pragma("unroll") for (int n = 0; n < 2; ++n) { const int col = u.pn * BM + bj * HALF + wc * 32 + n * 16 + 4 * fq; const f32x4 a = acc[ai][bj][m][n]; BODY } \
    if (m & 1) asm volatile("" ::: "memory"); }
__device__ __forceinline__ v2u pack4(f32x4 v) { v2u w; w.x = f2bf_bits(v[0]) | (f2bf_bits(v[1]) << 16); w.y = f2bf_bits(v[2]) | (f2bf_bits(v[3]) << 16); return w; }
__device__ __forceinline__ f32x4 unpack4(v2u w) { f32x4 v; v[0] = __uint_as_float(w.x << 16); v[1] = __uint_as_float(w.x & 0xffff0000u); v[2] = __uint_as_float(w.y << 16); v[3] = __uint_as_float(w.y & 0xffff0000u); return v; }

struct EpiStoreBf16 {
    static constexpr bool PERM = true;
    bf16_t* O; int ldc;
    __device__ __forceinline__ void operator()(const f32x4 (&acc)[2][2][4][2], const Unit& u, int wr, int wc, int fr, int fq) const {
#pragma unroll
        for (int ai = 0; ai < 2; ++ai)
#pragma unroll
            for (int m = 0; m < 4; ++m) { const int row = u.pm * BM + ai * HALF + wr * 64 + m * 16 + fr;
#pragma unroll
                for (int bj = 0; bj < 2; ++bj) { const int col = u.pn * BM + bj * HALF + wc * 32 + 8 * fq; const v2u lo = pack4(acc[ai][bj][m][0]), hi = pack4(acc[ai][bj][m][1]);
                    *(u32x4*)(O + (size_t)row * ldc + col) = (u32x4){lo.x, lo.y, hi.x, hi.y}; }
                asm volatile("" ::: "memory"); }
    }
};
struct EpiStoreQ8 {
    static constexpr bool PERM = true;
    bf16_t* O; int ldc; const float* rs; const float* cs;
    __device__ __forceinline__ void operator()(const f32x4 (&acc)[2][2][4][2], const Unit& u, int wr, int wc, int fr, int fq) const {
        f32x4 cv[2][2];
#pragma unroll
        for (int bj = 0; bj < 2; ++bj)
#pragma unroll
            for (int n = 0; n < 2; ++n) { cv[bj][n] = *(const f32x4*)(cs + u.pn * BM + bj * HALF + wc * 32 + 8 * fq + 4 * n);
#pragma unroll
                for (int j = 0; j < 4; ++j) cv[bj][n][j] = cv[bj][n][j] > 0.f ? cv[bj][n][j] * (1.0f / 127.0f) : 1.0f; }
#pragma unroll
        for (int ai = 0; ai < 2; ++ai)
#pragma unroll
            for (int m = 0; m < 4; ++m) { const int row = u.pm * BM + ai * HALF + wr * 64 + m * 16 + fr; const float r = rs[row];
#pragma unroll
                for (int bj = 0; bj < 2; ++bj) { const int col = u.pn * BM + bj * HALF + wc * 32 + 8 * fq; f32x4 v0, v1;
                    const i32x4 a0 = __builtin_bit_cast(i32x4, acc[ai][bj][m][0]), a1 = __builtin_bit_cast(i32x4, acc[ai][bj][m][1]);
#pragma unroll
                    for (int j = 0; j < 4; ++j) { v0[j] = (float)a0[j] * r * cv[bj][0][j]; v1[j] = (float)a1[j] * r * cv[bj][1][j]; }
                    const v2u lo = pack4(v0), hi = pack4(v1); *(u32x4*)(O + (size_t)row * ldc + col) = (u32x4){lo.x, lo.y, hi.x, hi.y}; }
                asm volatile("" ::: "memory"); }
    }
};
struct EpiS5a {
    static constexpr bool PERM = false;
    float* YS; float* SL;
    __device__ __forceinline__ void operator()(const f32x4 (&acc)[2][2][4][2], const Unit& u, int wr, int wc, int fr, int fq) const {
        EPI_LOOP({ if (row < S5R) { if (col < 512) *(f32x4*)(YS + (size_t)(row * S5T + (col >> 4)) * DH + u.e * S5N + (col & 15)) = a;
                                    else *(f32x4*)(SL + ((size_t)u.e * S5RP + row) * 256 + (col - 512)) = a; } })
    }
};
struct EpiS5b {
    static constexpr bool PERM = true;
    const float* YS; bf16_t* Gd;
    __device__ __forceinline__ void operator()(const f32x4 (&acc)[2][2][4][2], const Unit& u, int wr, int wc, int fr, int fq) const {
#pragma unroll
        for (int ai = 0; ai < 2; ++ai)
#pragma unroll
            for (int m = 0; m < 4; ++m) { const int row = u.pm * BM + ai * HALF + wr * 64 + m * 16 + fr;
                if (row < S5R) {
#pragma unroll
                    for (int bj = 0; bj < 2; ++bj) { const int col = u.pn * BM + bj * HALF + wc * 32 + 8 * fq; const size_t o = (size_t)(row * S5T + (col >> 4)) * DH + u.e * S5N + (col & 15);
                        const f32x4 y0 = *(const f32x4*)(YS + o) + acc[ai][bj][m][0], y1 = *(const f32x4*)(YS + o + 4) + acc[ai][bj][m][1]; f32x4 r0, r1;
#pragma unroll
                        for (int j = 0; j < 4; ++j) { r0[j] = y0[j] * fsig(1.5957691216057308f * (y0[j] + 0.044715f * y0[j] * y0[j] * y0[j])); r1[j] = y1[j] * fsig(1.5957691216057308f * (y1[j] + 0.044715f * y1[j] * y1[j] * y1[j])); }
                        const v2u lo = pack4(r0), hi = pack4(r1); *(u32x4*)(Gd + o) = (u32x4){lo.x, lo.y, hi.x, hi.y}; } }
                if (m & 1) asm volatile("" ::: "memory"); }
    }
};
struct EpiGlu {
    static constexpr bool PERM = true;
    const bf16_t* G; bf16_t* O;
    __device__ __forceinline__ void operator()(const f32x4 (&acc)[2][2][4][2], const Unit& u, int wr, int wc, int fr, int fq) const {
#pragma unroll
        for (int ai = 0; ai < 2; ++ai)
#pragma unroll
            for (int m = 0; m < 4; ++m) { const int row = u.pm * BM + ai * HALF + wr * 64 + m * 16 + fr;
#pragma unroll
                for (int bj = 0; bj < 2; ++bj) { const int col = u.pn * BM + bj * HALF + wc * 32 + 8 * fq;
                    if (col < DH) { const u32x4 gp = *(const u32x4*)(G + (size_t)row * DH + col); const f32x4 g0 = unpack4((v2u){gp.x, gp.y}), g1 = unpack4((v2u){gp.z, gp.w}); f32x4 o0, o1;
#pragma unroll
                        for (int j = 0; j < 4; ++j) { o0[j] = g0[j] * fsig(acc[ai][bj][m][0][j]); o1[j] = g1[j] * fsig(acc[ai][bj][m][1][j]); }
                        const v2u lo = pack4(o0), hi = pack4(o1); *(u32x4*)(O + (size_t)row * DH + col) = (u32x4){lo.x, lo.y, hi.x, hi.y}; } }
                if (m & 1) asm volatile("" ::: "memory"); }
    }
};
template <int MODE> struct EpiBr {
    static constexpr bool PERM = true;
    const bf16_t* P; int gcol; float* YF; bf16_t* YB;
    __device__ __forceinline__ void operator()(const f32x4 (&acc)[2][2][4][2], const Unit& u, int wr, int wc, int fr, int fq) const {
#pragma unroll
        for (int ai = 0; ai < 2; ++ai)
#pragma unroll
            for (int m = 0; m < 4; ++m) { const int row = u.pm * BM + ai * HALF + wr * 64 + m * 16 + fr;
#pragma unroll
                for (int bj = 0; bj < 2; ++bj) { const int col = u.pn * BM + bj * HALF + wc * 32 + 8 * fq;
                    const u32x4 mgp = *(const u32x4*)(P + (size_t)row * NP + gcol + col); bf16_t* yp = YB + (size_t)row * D + col;
                    const f32x4 g0 = unpack4((v2u){mgp.x, mgp.y}), g1 = unpack4((v2u){mgp.z, mgp.w}); f32x4 v0, v1;
#pragma unroll
                    for (int j = 0; j < 4; ++j) { v0[j] = fsig(g0[j]) * acc[ai][bj][m][0][j]; v1[j] = fsig(g1[j]) * acc[ai][bj][m][1][j]; }
                    if (MODE != 0) { const u32x4 yo = *(const u32x4*)yp; v0 = v0 + unpack4((v2u){yo.x, yo.y}); v1 = v1 + unpack4((v2u){yo.z, yo.w}); }
                    const v2u lo = pack4(v0), hi = pack4(v1); *(u32x4*)yp = (u32x4){lo.x, lo.y, hi.x, hi.y}; }
                if (m & 1) asm volatile("" ::: "memory"); }
    }
};
template <bool SRC32> struct EpiOut {
    static constexpr bool PERM = true;
    bf16_t* X; const float* modl; const float* xl; const float* xc;
    __device__ __forceinline__ void operator()(const f32x4 (&acc)[2][2][4][2], const Unit& u, int wr, int wc, int fr, int fq) const {
        const int row0 = u.pm * BM, mb = row0 < NTL ? row0 / SEQ : NB; f32x4 gv[2][2];
#pragma unroll
        for (int bj = 0; bj < 2; ++bj)
#pragma unroll
            for (int n = 0; n < 2; ++n) gv[bj][n] = *(const f32x4*)(modl + (size_t)mb * 6144 + 2 * D + u.pn * BM + bj * HALF + wc * 32 + 8 * fq + 4 * n);
#pragma unroll
        for (int ai = 0; ai < 2; ++ai)
#pragma unroll
            for (int m = 0; m < 4; ++m) { const int row = u.pm * BM + ai * HALF + wr * 64 + m * 16 + fr;
#pragma unroll
                for (int bj = 0; bj < 2; ++bj) { const int col = u.pn * BM + bj * HALF + wc * 32 + 8 * fq; f32x4 s0, s1;
                    if (SRC32) { const float* sp = (row < NTL ? xl + (size_t)row * D : xc + (size_t)(row - NTL) * D) + col; s0 = *(const f32x4*)sp; s1 = *(const f32x4*)(sp + 4); }
                    else { const u32x4 xo = *(const u32x4*)(X + (size_t)row * D + col); s0 = unpack4((v2u){xo.x, xo.y}); s1 = unpack4((v2u){xo.z, xo.w}); }
                    const v2u lo = pack4(s0 + gv[bj][0] * acc[ai][bj][m][0]), hi = pack4(s1 + gv[bj][1] * acc[ai][bj][m][1]);
                    *(u32x4*)(X + (size_t)row * D + col) = (u32x4){lo.x, lo.y, hi.x, hi.y}; }
                if (m & 1) asm volatile("" ::: "memory"); }
    }
};
struct EpiMoe1 {
    static constexpr bool PERM = false;
    bf16_t* ACT; const float* b1;
    __device__ __forceinline__ void operator()(const f32x4 (&acc)[2][2][4][2], const Unit& u, int wr, int wc, int fr, int fq) const {
        const int a0 = 128 * u.pn + 32 * wc + 8 * fq; const float* bb = b1 + (size_t)u.e * 1024 + 2 * a0; f32x4 bg[2], bl[2];
#pragma unroll
        for (int bj = 0; bj < 2; ++bj) { const f32x4 p0 = *(const f32x4*)(bb + 8 * bj), p1 = *(const f32x4*)(bb + 8 * bj + 4); bg[bj] = (f32x4){p0[0], p0[2], p1[0], p1[2]}; bl[bj] = (f32x4){p0[1], p0[3], p1[1], p1[3]}; }
#pragma unroll
        for (int ai = 0; ai < 2; ++ai)
#pragma unroll
            for (int m = 0; m < 4; ++m) { const int row = u.pm * BM + ai * HALF + wr * 64 + m * 16 + fr; v2u pk[2];
#pragma unroll
                for (int bj = 0; bj < 2; ++bj) { const f32x4 g = acc[ai][bj][m][0] + bg[bj], li = acc[ai][bj][m][1] + bl[bj]; f32x4 o;
#pragma unroll
                    for (int j = 0; j < 4; ++j) { const float xg = fminf(g[j], 7.0f); const float xl = fminf(fmaxf(li[j], -7.0f), 7.0f); o[j] = xg * fsig(1.702f * xg) * (xl + 1.0f); }
                    pk[bj] = pack4(o); }
                *(u32x4*)(ACT + (size_t)row * FF + a0) = (u32x4){pk[0].x, pk[0].y, pk[1].x, pk[1].y};
                asm volatile("" ::: "memory"); }
    }
};
struct EpiMoe1Q8 {
    static constexpr bool PERM = false;
    bf16_t* ACT; const float* b1; const float* rs; const float* cs;
    __device__ __forceinline__ void operator()(const f32x4 (&acc)[2][2][4][2], const Unit& u, int wr, int wc, int fr, int fq) const {
        const int a0 = 128 * u.pn + 32 * wc + 8 * fq; const float* bb = b1 + (size_t)u.e * 1024 + 2 * a0; const float* sb = cs + (size_t)u.e * 1024 + 2 * a0; f32x4 bg[2], bl[2], sg[2], sl[2];
#pragma unroll
        for (int bj = 0; bj < 2; ++bj) { const f32x4 p0 = *(const f32x4*)(bb + 8 * bj), p1 = *(const f32x4*)(bb + 8 * bj + 4); bg[bj] = (f32x4){p0[0], p0[2], p1[0], p1[2]}; bl[bj] = (f32x4){p0[1], p0[3], p1[1], p1[3]};
            const f32x4 q0 = *(const f32x4*)(sb + 8 * bj), q1 = *(const f32x4*)(sb + 8 * bj + 4); sg[bj] = (f32x4){q0[0], q0[2], q1[0], q1[2]}; sl[bj] = (f32x4){q0[1], q0[3], q1[1], q1[3]};
#pragma unroll
            for (int j = 0; j < 4; ++j) { sg[bj][j] = sg[bj][j] > 0.f ? sg[bj][j] * (1.0f / 127.0f) : 1.0f; sl[bj][j] = sl[bj][j] > 0.f ? sl[bj][j] * (1.0f / 127.0f) : 1.0f; } }
#pragma unroll
        for (int ai = 0; ai < 2; ++ai)
#pragma unroll
            for (int m = 0; m < 4; ++m) { const int row = u.pm * BM + ai * HALF + wr * 64 + m * 16 + fr; const float r = rs[row]; v2u pk[2];
#pragma unroll
                for (int bj = 0; bj < 2; ++bj) { const i32x4 ig = __builtin_bit_cast(i32x4, acc[ai][bj][m][0]), il = __builtin_bit_cast(i32x4, acc[ai][bj][m][1]); f32x4 o;
#pragma unroll
                    for (int j = 0; j < 4; ++j) { const float g = (float)ig[j] * r * sg[bj][j] + bg[bj][j], li = (float)il[j] * r * sl[bj][j] + bl[bj][j];
                        const float xg = fminf(g, 7.0f); const float xl = fminf(fmaxf(li, -7.0f), 7.0f); o[j] = xg * fsig(1.702f * xg) * (xl + 1.0f); }
                    pk[bj] = pack4(o); }
                *(u32x4*)(ACT + (size_t)row * FF + a0) = (u32x4){pk[0].x, pk[0].y, pk[1].x, pk[1].y};
                asm volatile("" ::: "memory"); }
    }
};
struct EpiMoe2 {
    static constexpr bool PERM = true;
    unsigned char* O; float* SC; const float* b2;
    __device__ __forceinline__ void operator()(const f32x4 (&acc)[2][2][4][2], const Unit& u, int wr, int wc, int fr, int fq) const {
        f32x4 bv[2][2];
#pragma unroll
        for (int bj = 0; bj < 2; ++bj)
#pragma unroll
            for (int n = 0; n < 2; ++n) bv[bj][n] = *(const f32x4*)(b2 + (size_t)u.e * D + u.pn * BM + bj * HALF + wc * 32 + 8 * fq + 4 * n);
#pragma unroll
        for (int ai = 0; ai < 2; ++ai)
#pragma unroll
            for (int m = 0; m < 4; ++m) { const int row = u.pm * BM + ai * HALF + wr * 64 + m * 16 + fr;
#pragma unroll
                for (int bj = 0; bj < 2; ++bj) { const int col = u.pn * BM + bj * HALF + wc * 32 + 8 * fq;
                    const f32x4 a = acc[ai][bj][m][0] + bv[bj][0], b = acc[ai][bj][m][1] + bv[bj][1];
                    float mx = fmaxf(fmaxf(fmaxf(fabsf(a[0]), fabsf(a[1])), fmaxf(fabsf(a[2]), fabsf(a[3]))), fmaxf(fmaxf(fabsf(b[0]), fabsf(b[1])), fmaxf(fabsf(b[2]), fabsf(b[3]))));
                    mx = fmaxf(mx, __shfl_xor(mx, 16)); mx = fmaxf(mx, __shfl_xor(mx, 32));
                    const float inv = mx > 0.f ? 127.0f / mx : 0.f; const float MG = 12582912.0f + 128.0f;
                    const unsigned q0 = __float_as_uint(fmaf(a[0], inv, MG)), q1 = __float_as_uint(fmaf(a[1], inv, MG)), q2 = __float_as_uint(fmaf(a[2], inv, MG)), q3 = __float_as_uint(fmaf(a[3], inv, MG));
                    const unsigned q4 = __float_as_uint(fmaf(b[0], inv, MG)), q5 = __float_as_uint(fmaf(b[1], inv, MG)), q6 = __float_as_uint(fmaf(b[2], inv, MG)), q7 = __float_as_uint(fmaf(b[3], inv, MG));
                    const unsigned w0 = __builtin_amdgcn_perm(__builtin_amdgcn_perm(q3, q2, 0x0c0c0400u), __builtin_amdgcn_perm(q1, q0, 0x0c0c0400u), 0x05040100u);
                    const unsigned w1 = __builtin_amdgcn_perm(__builtin_amdgcn_perm(q7, q6, 0x0c0c0400u), __builtin_amdgcn_perm(q5, q4, 0x0c0c0400u), 0x05040100u);
                    *(v2u*)(O + (size_t)row * D + col) = (v2u){w0, w1};
                    if (fq == 0) SC[(size_t)row * 32 + (col >> 5)] = mx * (1.0f / 127.0f); }
                asm volatile("" ::: "memory"); }
    }
};
}

#define XB_TMO      128
#define XB_XCNT(j)  (256  + 64 * (j))
#define XB_XSUB(j)  (1280 + 64 * (j))
#define XB_XGEN(j)  (2304 + 64 * (j))
#define XB_TOP      3328
#define XB_TOPGEN   3392
#define XCD_BAR_WORDS 3456
#define XB_SPIN_CAP (1u << 18)
__device__ __forceinline__ unsigned xb_ld(unsigned* p)              { return __hip_atomic_load(p, __ATOMIC_RELAXED, __HIP_MEMORY_SCOPE_AGENT); }
__device__ __forceinline__ unsigned xb_add(unsigned* p, unsigned v) { return __hip_atomic_fetch_add(p, v, __ATOMIC_RELAXED, __HIP_MEMORY_SCOPE_AGENT); }
__device__ __forceinline__ unsigned xb_xcc_id() { return (unsigned)__builtin_amdgcn_s_getreg((3 << 11) | 20) & 0xFu; }
#define XB_SPIN(cond, bar) do { unsigned _sp = 0; while (cond) { __builtin_amdgcn_s_sleep(1); \
    if ((++_sp & 255u) == 0u) { if (xb_ld(&(bar)[XB_TMO])) break; if (_sp > XB_SPIN_CAP) { atomicAdd(&(bar)[XB_TMO], 1u); break; } } } } while (0)
struct XcdBarrier { unsigned* bar; unsigned x; volatile LAS unsigned* st; };
__device__ __forceinline__ XcdBarrier xcd_barrier_post(unsigned* bar, volatile LAS unsigned* st) {
    XcdBarrier b; b.bar = bar; b.x = xb_xcc_id(); b.st = st;
    if (threadIdx.x == 0) (void)xb_add(&bar[XB_XCNT(b.x)], 1u);
    return b;
}
__device__ __forceinline__ void xcd_barrier_complete(unsigned* bar, unsigned x, unsigned& nloc, unsigned& nx) {
    const unsigned G = gridDim.x * gridDim.y * gridDim.z;
    unsigned sum, cnt, mine, sp = 0u;
    for (;;) {
        sum = 0u; cnt = 0u; mine = 0u;
#pragma unroll
        for (unsigned j = 0; j < 16; ++j) { const unsigned c = xb_ld(&bar[XB_XCNT(j)]); sum += c; cnt += (c > 0u) ? 1u : 0u; mine = (j == x) ? c : mine; }
        if (sum == G) break;
        __builtin_amdgcn_s_sleep(1);
        if ((++sp & 255u) == 0u) { if (xb_ld(&bar[XB_TMO])) break; if (sp > XB_SPIN_CAP) { atomicAdd(&bar[XB_TMO], 1u); break; } }
    }
    nloc = mine > 0u ? mine : 1u; nx = cnt > 0u ? cnt : 1u;
}
__device__ __forceinline__ void xcd_barrier(const XcdBarrier& b, int tid_) {
    asm volatile("s_waitcnt vmcnt(0)" ::: "memory");
    __syncthreads();
    if (tid_ == 0) {
        unsigned* bar = b.bar;
        __builtin_amdgcn_s_waitcnt(0);
        unsigned nloc = b.st[0], nx = b.st[1];
        if (nloc == 0u) { xcd_barrier_complete(bar, b.x, nloc, nx); b.st[0] = nloc; b.st[1] = nx; }
        const unsigned old = xb_add(&bar[XB_XSUB(b.x)], 1u);
        const unsigned gen = old / nloc;
        if (old + 1u == (gen + 1u) * nloc) {
            __builtin_amdgcn_fence(__ATOMIC_RELEASE, "agent");
            asm volatile("s_waitcnt vmcnt(0)" ::: "memory");
            const unsigned og = xb_add(&bar[XB_TOP], 1u);
            const unsigned tg = og / nx;
            if (og + 1u == (tg + 1u) * nx) xb_add(&bar[XB_TOPGEN], 1u);
            else XB_SPIN(xb_ld(&bar[XB_TOPGEN]) == tg, bar);
            __builtin_amdgcn_fence(__ATOMIC_ACQUIRE, "agent");
            xb_add(&bar[XB_XGEN(b.x)], 1u);
            asm volatile("s_waitcnt vmcnt(0)" ::: "memory");
        } else {
            XB_SPIN(xb_ld(&bar[XB_XGEN(b.x)]) == gen, bar);
            __builtin_amdgcn_fence(__ATOMIC_ACQUIRE, "agent");
            asm volatile("s_waitcnt vmcnt(0)" ::: "memory");
        }
    }
    __syncthreads();
}

template <int CM> __device__ __forceinline__ void wconv_item(const float* W, int K, int Nsrc, int N, bf16* WT, LAS float* scr, int item, int lane, int nvalid) {
    const int nblk = N / 32, kb = item / nblk, nb = item % nblk, k0 = 64 * kb, n0 = 32 * nb;
    const int nn = n0 + (lane & 31);
    const int sc = CM == 1 ? win_src_col(nn) : (CM == 2 ? w1_src_col(nn) : (CM == 3 ? (nn < nvalid ? nn : -1) : nn));
    float ld[32];
#pragma unroll
    for (int i = 0; i < 32; ++i) { const int kk = 2 * i + (lane >> 5); ld[i] = sc >= 0 ? W[(size_t)(k0 + kk) * Nsrc + sc] : 0.f; }
#pragma unroll
    for (int i = 0; i < 32; ++i) { const int kk = 2 * i + (lane >> 5); scr[kk * 33 + (lane & 31)] = ld[i]; }
    LDS_WAIT(); asm volatile("" ::: "memory");
    const int cch = lane & 7;
#pragma unroll
    for (int j = 0; j < 4; ++j) { const int n = (lane >> 3) + 8 * j; const LAS float* s = scr + (8 * cch) * 33 + n;
        v4u o; o.x = f2bf_bits(s[0 * 33]) | (f2bf_bits(s[1 * 33]) << 16); o.y = f2bf_bits(s[2 * 33]) | (f2bf_bits(s[3 * 33]) << 16);
        o.z = f2bf_bits(s[4 * 33]) | (f2bf_bits(s[5 * 33]) << 16); o.w = f2bf_bits(s[6 * 33]) | (f2bf_bits(s[7 * 33]) << 16);
        *(v4u*)(WT + (size_t)(n0 + n) * K + k0 + 8 * cch) = o; }
    LDS_WAIT(); asm volatile("" ::: "memory");
}
template <int CM  > __device__ __forceinline__ void wconv_item_q8(const float* W, int K, int Nsrc, int N, signed char* WQ, const float* colscale, LAS float* scr, int item, int lane) {
    const int nblk = N / 32, kb = item / nblk, nb = item % nblk, k0 = 64 * kb, n0 = 32 * nb;
    const int sc = CM == 1 ? win_src_col(n0 + (lane & 31)) : w1_src_col(n0 + (lane & 31));
    float ld[32];
#pragma unroll
    for (int i = 0; i < 32; ++i) { const int kk = 2 * i + (lane >> 5); ld[i] = sc >= 0 ? W[(size_t)(k0 + kk) * Nsrc + sc] : 0.f; }
#pragma unroll
    for (int i = 0; i < 32; ++i) { const int kk = 2 * i + (lane >> 5); scr[kk * 33 + (lane & 31)] = ld[i]; }
    LDS_WAIT(); asm volatile("" ::: "memory");
#pragma unroll
    for (int j = 0; j < 2; ++j) { const int idx = lane + 64 * j, n = idx >> 2, cch = idx & 3; const float cs_ = colscale[CM == 1 ? n0 + n : w1_src_col(n0 + n)]; const float inv = cs_ > 0.f ? 127.0f / cs_ : 1.0f;     const LAS float* sp = scr + (16 * cch) * 33 + n; unsigned o[4];
#pragma unroll
        for (int w4 = 0; w4 < 4; ++w4) { unsigned pk = 0u;
#pragma unroll
            for (int e = 0; e < 4; ++e) { const int q = (int)__builtin_rintf(fminf(fmaxf(sp[(4 * w4 + e) * 33] * inv, -127.f), 127.f)); pk |= ((unsigned)q & 0xffu) << (8 * e); }
            o[w4] = pk; }
        *(v4u*)(WQ + (size_t)(n0 + n) * K + k0 + 16 * cch) = (v4u){o[0], o[1], o[2], o[3]}; }
    LDS_WAIT(); asm volatile("" ::: "memory");
}
template <int CM> __device__ __forceinline__ void wconv_mat(const float* W, int K, int Nsrc, int N, bf16* WT, LAS float* scr, int gw, int ngw, int lane, int nvalid = 0) {
    const int nit = (K / 64) * (N / 32);
    for (int it = gw; it < nit; it += ngw) wconv_item<CM>(W, K, Nsrc, N, WT, scr, it, lane, nvalid);
}

constexpr int NTHR_ = 512;

__device__ __forceinline__ void rk_build(const Ctx& c, LAS unsigned char* lds, int tid, int G, int bid) {
    const int lane = tid & 63, wave = __builtin_amdgcn_readfirstlane(tid >> 6); LAS float* T = (LAS float*)(lds + wave * 8704);
    const float* HF = wsp<float>(c, WS_HF); float* NP_ = wsp<float>(c, WS_NRMP);
    constexpr int NTB = RKT_LAT + RKT_CTX, NTILE = DEPTH * 2 * 2 * 12 * NTB;
    for (int tile = bid * 8 + wave; tile < NTILE; tile += G * 8) { int q = tile; const int tb = q % NTB; q /= NTB; const int cg = q % 12; q /= 12; const int dir = q % 2; q /= 2; const int o = q % 2, l = q / 2;
        const int ls = tb < RKT_LAT ? 0 : 1, tblk = ls ? tb - RKT_LAT : tb, L = ls ? CTXL : SEQ, pb = ls ? SEQ : 0, RKP = ls ? RKP1 : RKP0, t0 = tblk * 64;
        const float* src = HF + ((size_t)l * NPOS + pb + t0) * 1536 + o * 768 + dir * DH + cg * 32;
        { float ld[32];
#pragma unroll
          for (int i = 0; i < 32; ++i) ld[i] = src[(size_t)(2 * i + (lane >> 5)) * 1536 + (lane & 31)];
#pragma unroll
          for (int i = 0; i < 32; ++i) T[(2 * i + (lane >> 5)) * 33 + (lane & 31)] = ld[i]; }
        LDS_WAIT(); asm volatile("" ::: "memory");
        bf16* RK = wsp<bf16>(c, ls ? WS_RK1 : WS_RK0);
        float asum = 0.f;
        if (lane < 32) { for (int tt = 0; tt < 64; ++tt) { const float v = fabsf(T[tt * 33 + lane]); if (!(dir == 1 && t0 + tt == 0)) asum += v; }
            NP_[(((((size_t)l * 2 + ls) * 2 + o) * DH + cg * 32 + lane) * 64) + dir * 32 + tblk] = asum; }
        for (int cc = 0; cc < 32; ++cc) { bf16* row = RK + ((((size_t)l * 2 + o) * DH + cg * 32 + cc) * 2) * RKP;
            const int t = t0 + lane; const float v = T[lane * 33 + cc];
            if (!(dir == 1 && t == 0)) { const int n = dir ? L - 1 + t : L - 1 - t; const bf16 hv = f2bf(v); row[n] = hv; if (n >= 1) row[RKP + n - 1] = hv; } }
        LDS_WAIT(); asm volatile("" ::: "memory"); }
    for (int ls = 0; ls < 2; ++ls) { const int L = ls ? CTXL : SEQ, RKP = ls ? RKP1 : RKP0, ntail = RKP - (2 * L - 2); bf16* RK = wsp<bf16>(c, ls ? WS_RK1 : WS_RK0);
        for (long it = (long)bid * NTHR_ + tid; it < (long)DEPTH * 2 * DH * 2 * ntail; it += (long)G * NTHR_) { const int i = (int)(it % ntail); const long rowi = it / ntail; const int par = (int)(rowi % 2);
            const int idx = 2 * L - 1 - par + i; if (idx < RKP) RK[rowi * RKP + idx] = 0; } }
}
__device__ __forceinline__ void s5gen1_fast(const Ctx& c, int tid, int G, int bid) {
    const float* TAB = wsp<float>(c, WS_S5TAB); float* KD = wsp<float>(c, WS_KD);
    for (int it = bid * 512 + tid; it < DEPTH * S5G * 2 * 256 * 8; it += G * 512) { const int pp = it & 7, r = it >> 3; const int m = r % 16, n = (r / 16) % 16, d = (r / 256) % 2, g = (r / 512) % S5G, l = r / (512 * S5G);
        float acc[S5T];
#pragma unroll
        for (int j = 0; j < S5T; ++j) acc[j] = 0.f;
        { const int p0 = pp * 8; float t0[8], t1[8], t2[8], t3[8], brv[8], biv[8], crv[8], civ[8];
#pragma unroll
            for (int u = 0; u < 8; ++u) { const int p = p0 + u; const float* tb = TAB + ((((size_t)l * 2 + d) * S5G + g) * S5P + p) * 4; t0[u] = tb[0]; t1[u] = tb[1]; t2[u] = tb[2]; t3[u] = tb[3];
                const size_t bi = (((size_t)l * S5G + g) * S5P + p) * S5N + m, ci = (((size_t)l * S5G + g) * S5N + n) * S5P + p;
                brv[u] = c.in[I_BRE][bi]; biv[u] = c.in[I_BIM][bi]; crv[u] = c.in[I_CRE][ci]; civ[u] = c.in[I_CIM][ci]; }
#pragma unroll
            for (int u = 0; u < 8; ++u) { const float bbr = t2[u] * brv[u] - t3[u] * biv[u], bbi = t2[u] * biv[u] + t3[u] * brv[u];
                float zr = crv[u] * bbr - civ[u] * bbi, zi = crv[u] * bbi + civ[u] * bbr;
                const float mg = expf(t0[u]), lbr = mg * cosf(t1[u]), lbi = mg * sinf(t1[u]);
#pragma unroll
                for (int j = 0; j < S5T; ++j) { acc[j] += zr; const float t = zr * lbr - zi * lbi; zi = zr * lbi + zi * lbr; zr = t; } } }
#pragma unroll
        for (int j = 0; j < S5T; ++j) { acc[j] += __shfl_xor(acc[j], 1); acc[j] += __shfl_xor(acc[j], 2); acc[j] += __shfl_xor(acc[j], 4); }
#pragma unroll
        for (int j = 0; j < S5T; ++j) if ((j & 7) == pp) KD[((((size_t)l * S5G + g) * 2 + d) * S5T + j) * 256 + n * 16 + m] = acc[j]; }
}
__device__ __forceinline__ void modp_fast(const Ctx& c, LAS unsigned char* lds, int tid, int G, int bid) {
    const float* SL = wsp<float>(c, WS_SILU); float* MP = wsp<float>(c, WS_MODP); LAS float* S = (LAS float*)lds;
    constexpr int NKS = 16, KS = D / NKS;
    static_assert((DEPTH * 6144) % 512 == 0, "a workgroup's items share the k slice");
    for (int it0 = bid * 512; it0 < NKS * DEPTH * 6144; it0 += G * 512) { const int it = it0 + tid, ks = it0 / (DEPTH * 6144);
        __syncthreads();
        for (int i = tid; i < NMOD * KS; i += 512) { const int m = i / KS, k = i % KS; S[k * NMOD + m] = SL[m * D + ks * KS + k]; }
        __syncthreads();
        const int col = it % 6144, l = (it / 6144) % DEPTH;
        const float* w = c.in[I_ADAW] + ((size_t)l * D + ks * KS) * 6144 + col;
        float acc[NMOD];
#pragma unroll
        for (int m = 0; m < NMOD; ++m) acc[m] = 0.f;
        for (int k0 = 0; k0 < KS; k0 += 32) { float wv[32];
#pragma unroll
            for (int u = 0; u < 32; ++u) wv[u] = w[(size_t)(k0 + u) * 6144];
#pragma unroll
            for (int u = 0; u < 32; ++u)
#pragma unroll
                for (int m = 0; m < NMOD; ++m) acc[m] += S[(k0 + u) * NMOD + m] * wv[u]; }
#pragma unroll
        for (int m = 0; m < NMOD; ++m) MP[(((size_t)ks * DEPTH + l) * NMOD + m) * 6144 + col] = acc[m]; }
    __syncthreads();
}
__device__ __forceinline__ void wmax_part(const Ctx& c, int bid, int G, int tid) {
    unsigned* MX = wsp<unsigned>(c, WS_CTL) + CW_WMX;
    for (int it = bid * 512 + tid; it < DEPTH * 16 * NP; it += G * 512) { const int n = it % NP, kp = (it / NP) % 16, l = it / (16 * NP), sc = win_src_col(n);
        if (sc < 0) continue;
        const float* w = c.in[I_WIN] + (size_t)l * D * NIN + (size_t)(kp * 64) * NIN + sc; float mx = 0.f;
        for (int k0 = 0; k0 < 64; k0 += 16) { float v[16];
#pragma unroll
            for (int u = 0; u < 16; ++u) v[u] = w[(size_t)(k0 + u) * NIN];
#pragma unroll
            for (int u = 0; u < 16; ++u) mx = fmaxf(mx, fabsf(v[u])); }
        atomicMax(MX + l * NP + n, __float_as_uint(mx)); }
}
__device__ __forceinline__ void w1max_part(const Ctx& c, int l, int e0, int rank, int nidle, int tid) {
    unsigned* MX = wsp<unsigned>(c, WS_CTL) + CW_W1MX + ((size_t)l * NE + e0) * 1024; const float* W = c.in[I_W1] + ((size_t)l * NE + e0) * D * 1024;
    for (int it = rank * 512 + tid; it < 16 * 1024 * 16; it += nidle * 512) { const int col = it & 16383, kp = it >> 14, e = col >> 10, n = col & 1023;
        const float* w = W + (size_t)e * D * 1024 + (size_t)(kp * 64) * 1024 + n; float mx = 0.f;
        for (int k0 = 0; k0 < 64; k0 += 16) { float v[16];
#pragma unroll
            for (int u = 0; u < 16; ++u) v[u] = w[(size_t)(k0 + u) * 1024];
#pragma unroll
            for (int u = 0; u < 16; ++u) mx = fmaxf(mx, fabsf(v[u])); }
        atomicMax(MX + col, __float_as_uint(mx)); }
}
__device__ __forceinline__ void w1max_tail(const Ctx& c, int l, int e0, LAS unsigned char* lds, int tid, int G, int bid) {
    const int nblk = ((const LAS int*)(lds + 132096))[0]; int rank = bid, nidle = G; bool part = true;
    if (G == 256) { const int x = bid & 7, j = bid >> 3; nidle = 0; rank = 0;
        for (int xx = 0; xx < 8; ++xx) { const int nbx = (nblk - xx + 7) >> 3, rem = (nbx * 4) & 31, idl = 32 - rem; if (xx < x) rank += idl; if (xx == x) { part = j >= rem; rank += j - rem; } nidle += idl; } }
    if (part) w1max_part(c, l, e0, rank, nidle, tid);
}
__device__ __forceinline__ void moe_wconv(const Ctx& c, int l, LAS float* scr, int lo, int hi, int gw, int ngw, int lane) {
    constexpr int I1 = (D / 64) * (1024 / 32), I2 = (FF / 64) * (D / 32);
    for (int it = lo + gw; it < hi; it += ngw) { const int e = it / (I1 + I2), r = it % (I1 + I2);
        if (r < I1) wconv_item_q8<2>(c.in[I_W1] + ((size_t)l * NE + e) * D * 1024, D, 1024, 1024, wsp<signed char>(c, WS_W1T) + (size_t)e * 1024 * D, wsp<float>(c, WS_CTL) + CW_W1MX + ((size_t)l * NE + e) * 1024, scr, r, lane);
        else wconv_item<0>(c.in[I_W2] + ((size_t)l * NE + e) * FF * D, FF, D, D, wsp<bf16>(c, WS_W2T) + (size_t)e * D * FF, scr, r - I1, lane, 0); }
}
constexpr int MOE_WITEMS = NE * ((D / 64) * (1024 / 32) + (FF / 64) * (D / 32)), MOE_WS0 = 2304, MOE_WS1 = MOE_WS0 + 10240, MOE_WS2 = MOE_WS1 + 5120, MOE_WS3 = MOE_WS2 + 6912;

typedef short bf16x8_t __attribute__((ext_vector_type(8)));
typedef float f32x4_t __attribute__((ext_vector_type(4)));
typedef unsigned v4u_a4 __attribute__((ext_vector_type(4), aligned(4)));
__device__ __forceinline__ void hyf2_mfma(const Ctx& c, int tid, int G, int bid) {
    const int lane = tid & 63, wave = tid >> 6, m = lane & 15, q = lane >> 4;
    const float* HD2 = wsp<float>(c, WS_HD2); float* HF = wsp<float>(c, WS_HF);
    static_assert(NPOS % (16 * 16) == 0 && SEQ % 16 == 0, "position tiles");
    constexpr int NJT = 1536 / 16, NPT = NPOS / 16, PP = 16, TPI = NPT / PP;
    for (int it = bid * 8 + wave; it < DEPTH * NJT * PP; it += G * 8) { const int part = it % PP, jt = (it / PP) % NJT, l = it / (PP * NJT); const int j = 16 * jt + m;
        bf16x8_t Bh[2], Bl[2];
#pragma unroll
        for (int ks = 0; ks < 2; ++ks) { float w[8]; unsigned hb[8], lb[8];
#pragma unroll
            for (int e = 0; e < 8; ++e) w[e] = c.in[I_HW3][(size_t)l * 64 * 1536 + (size_t)(32 * ks + 8 * q + e) * 1536 + j];
#pragma unroll
            for (int e = 0; e < 8; ++e) { hb[e] = f2bf_bits(w[e]); lb[e] = f2bf_bits(w[e] - __uint_as_float(hb[e] << 16)); }
            Bh[ks] = __builtin_bit_cast(bf16x8_t, (v4u){hb[0] | (hb[1] << 16), hb[2] | (hb[3] << 16), hb[4] | (hb[5] << 16), hb[6] | (hb[7] << 16)});
            Bl[ks] = __builtin_bit_cast(bf16x8_t, (v4u){lb[0] | (lb[1] << 16), lb[2] | (lb[3] << 16), lb[4] | (lb[5] << 16), lb[6] | (lb[7] << 16)}); }
        const float b3 = c.in[I_HB3][l * 1536 + j]; const int ch = j % DH;
        const float dmin = -3.0701134573253940f, dmax = -15.350567286626973f;
        const float delta = fabsf(dmin + (float)ch * ((dmax - dmin) / 383.0f));
#pragma unroll 3
        for (int pt = part * TPI; pt < (part + 1) * TPI; ++pt) { const int pos0 = 16 * pt; const float* h = HD2 + ((size_t)l * NPOS + pos0 + m) * 64 + 8 * q;
            f32x4_t acc = (f32x4_t){0.f, 0.f, 0.f, 0.f};
#pragma unroll
            for (int ks = 0; ks < 2; ++ks) { const f32x4_t a0 = *(const f32x4_t*)(h + 32 * ks), a1 = *(const f32x4_t*)(h + 32 * ks + 4); const float av[8] = {a0[0], a0[1], a0[2], a0[3], a1[0], a1[1], a1[2], a1[3]}; unsigned hb[8], lb[8];
#pragma unroll
                for (int e = 0; e < 8; ++e) { hb[e] = f2bf_bits(av[e]); lb[e] = f2bf_bits(av[e] - __uint_as_float(hb[e] << 16)); }
                const bf16x8_t Ah = __builtin_bit_cast(bf16x8_t, (v4u){hb[0] | (hb[1] << 16), hb[2] | (hb[3] << 16), hb[4] | (hb[5] << 16), hb[6] | (hb[7] << 16)});
                const bf16x8_t Al = __builtin_bit_cast(bf16x8_t, (v4u){lb[0] | (lb[1] << 16), lb[2] | (lb[3] << 16), lb[4] | (lb[5] << 16), lb[6] | (lb[7] << 16)});
                acc = __builtin_amdgcn_mfma_f32_16x16x32_bf16(Ah, Bh[ks], acc, 0, 0, 0); acc = __builtin_amdgcn_mfma_f32_16x16x32_bf16(Al, Bh[ks], acc, 0, 0, 0); acc = __builtin_amdgcn_mfma_f32_16x16x32_bf16(Ah, Bl[ks], acc, 0, 0, 0); }
            const int L = pos0 < SEQ ? SEQ : CTXL, t0 = (pos0 < SEQ ? pos0 : pos0 - SEQ) + 4 * q;
#pragma unroll
            for (int jj = 0; jj < 4; ++jj) HF[((size_t)l * NPOS + pos0 + 4 * q + jj) * 1536 + j] = (acc[jj] + b3) * expf(-((float)(t0 + jj) / (float)(L - 1)) * delta); } }
}
constexpr int HP_PITCH = 772;
__device__ __forceinline__ void chan_pos(int r0, int& b, int& pos) { if (r0 < NTL) { b = r0 / SEQ; pos = r0 % SEQ; } else { const int q = r0 - NTL; b = q / CTXL; pos = SEQ + q % CTXL; } }
__device__ __forceinline__ void hy_prep(const Ctx& c, int l, LAS unsigned char* lds, int tid, int G, int bid) {
    const bf16* P = wsp<bf16>(c, WS_P); const int lane = tid & 63, wave = __builtin_amdgcn_readfirstlane(tid >> 6);
    for (int unit = bid; unit < (NT / 128) * 3; unit += G) { const int tile = unit / 3, part = unit % 3, r0 = tile * 128;
        { v4u sv[13];
#pragma unroll
          for (int k = 0; k < 13; ++k) { const int i = tid + k * NTHR_, rr = i / 48, ch = i % 48, r = r0 - 1 + rr; sv[k] = (v4u){0u, 0u, 0u, 0u};
              if (i < 130 * 48 && r >= 0 && r < NT) sv[k] = *(const v4u*)(P + (size_t)r * NP + PC_HY + part * DH + ch * 8); }
#pragma unroll
          for (int k = 0; k < 13; ++k) { const int i = tid + k * NTHR_, rr = i / 48, ch = i % 48;
              if (i < 130 * 48) { LAS unsigned* d = (LAS unsigned*)(lds + rr * HP_PITCH + ch * 16); d[0] = sv[k].x; d[1] = sv[k].y; d[2] = sv[k].z; d[3] = sv[k].w; } } }
        __syncthreads();
        int b, pos0; chan_pos(r0, b, pos0);
        const int ra = r0 + 2 * lane, rb = ra + 1;
        const float hp0 = has_prev(ra) ? 1.f : 0.f, hn0 = has_next(ra) ? 1.f : 0.f, hp1 = has_prev(rb) ? 1.f : 0.f, hn1 = has_next(rb) ? 1.f : 0.f;
        bf16* dst = wsp<bf16>(c, part == 0 ? WS_VT : (part == 1 ? WS_X1T : WS_X2T));
        const float* cw = c.in[I_HYCW] + (size_t)l * 3 * 1152 + part * DH; const float* cb = c.in[I_HYCB] + l * 1152 + part * DH;
        for (int cc = wave; cc < DH; cc += 8) {
            const LAS bf16* col = (const LAS bf16*)(lds + 2 * lane * HP_PITCH + cc * 2);
            const float xm = bf2f(col[0]), x0 = bf2f(col[HP_PITCH / 2]), x1 = bf2f(col[HP_PITCH]), x2 = bf2f(col[3 * (HP_PITCH / 2)]);
            const float w0 = cw[cc], w1 = cw[1152 + cc], w2 = cw[2304 + cc], bb = cb[cc];
            const float y0 = bb + w0 * xm * hp0 + w1 * x0 + w2 * x1 * hn0, y1 = bb + w0 * x0 * hp1 + w1 * x1 + w2 * x2 * hn1;
            *(unsigned*)(dst + ((size_t)cc * NB + b) * NPOS + pos0 + 2 * lane) = f2bf_bits(y0) | (f2bf_bits(y1) << 16); }
        __syncthreads(); }
}
template <int LS> __device__ __forceinline__ void hy_conv_seq(const Ctx& c, int l, int cc, LAS unsigned char* lds, int tid) {
    constexpr int L = LS ? CTXL : SEQ, PB = LS ? SEQ : 0, RKP = LS ? RKP1 : RKP0;
    constexpr int CP = (2 * L + 16) * 2, ZP = (L + 8) * 2, Z_OFF = 8 * CP, NST = L / 32, NTB = L / 128;
    static_assert(Z_OFF + 16 * ZP <= 147200 && (CP % 256) == 32, "hyena LDS map");
    const int lane = tid & 63, wave = __builtin_amdgcn_readfirstlane(tid >> 6), m = lane & 15, q = lane >> 4;
    const bf16* VT = wsp<bf16>(c, WS_VT); const bf16* X1T = wsp<bf16>(c, WS_X1T); const bf16* X2T = wsp<bf16>(c, WS_X2T); bf16* Z1T = wsp<bf16>(c, WS_Z1T); bf16* HYT = wsp<bf16>(c, WS_HYT);
    const size_t rowb = ((size_t)cc * NB) * NPOS + PB;
#pragma unroll 1
    for (int o = 0; o < 2; ++o) {
        const bf16* RK = wsp<bf16>(c, LS ? WS_RK1 : WS_RK0) + ((((size_t)l * 2 + o) * DH + cc) * 2) * RKP;
        const bf16* Zs = o == 0 ? VT : Z1T;
        { constexpr int NF = (8 * (CP / 16) + NTHR_ - 1) / NTHR_, NZ = (16 * (L / 8) + NTHR_ - 1) / NTHR_;
          v4u_a4 fv[NF]; v4u zv[NZ];
#pragma unroll
          for (int u = 0; u < NF; ++u) { const int i = tid + u * NTHR_, j = i / (CP / 16), k = i % (CP / 16); fv[u] = (v4u_a4){0u, 0u, 0u, 0u};
              if (i < 8 * (CP / 16)) fv[u] = *(const v4u_a4*)(RK + (size_t)(j & 1) * RKP + k * 8 + (j & ~1)); }
#pragma unroll
          for (int u = 0; u < NZ; ++u) { const int i = tid + u * NTHR_, b = i / (L / 8), k = i % (L / 8); zv[u] = (v4u){0u, 0u, 0u, 0u};
              if (i < 16 * (L / 8)) zv[u] = *(const v4u*)(Zs + rowb + (size_t)b * NPOS + k * 8); }
#pragma unroll
          for (int u = 0; u < NF; ++u) { const int i = tid + u * NTHR_, j = i / (CP / 16), k = i % (CP / 16); if (i < 8 * (CP / 16)) *(LAS v4u*)(lds + j * CP + k * 16) = (v4u){fv[u].x, fv[u].y, fv[u].z, fv[u].w}; }
#pragma unroll
          for (int u = 0; u < NZ; ++u) { const int i = tid + u * NTHR_, b = i / (L / 8), k = i % (L / 8); if (i < 16 * (L / 8)) *(LAS v4u*)(lds + Z_OFF + b * ZP + k * 16) = zv[u]; } }
        __syncthreads();
        const float bias = c.in[I_HBIAS][(l * 2 + o) * DH + cc];
        float inv; { const float* np = wsp<float>(c, WS_NRMP) + ((((size_t)l * 2 + LS) * 2 + o) * DH + cc) * 64; constexpr int NTBK = LS ? RKT_CTX : RKT_LAT; float sn = 0.f;
            for (int i = 0; i < NTBK; ++i) sn += np[i] + np[32 + i];
            inv = 1.0f / sn; }
        const int jc = (7 - m) & 7;
        for (int tb = wave; tb < NTB; tb += 8) {
            const int abase = jc * CP + 2 * ((m < 8 ? -7 : -15) + L - 1 - 128 * tb) + 16 * q, zbase = Z_OFF + m * ZP + 16 * q;
#define HY_LDA(k) (*(const LAS bf16x8_t*)(lds + abase + 32 * (k)))
            bf16x8_t win[8]; f32x4_t acc[8];
#pragma unroll
            for (int i = 0; i < 8; ++i) acc[i] = (f32x4_t){0.f, 0.f, 0.f, 0.f};
#pragma unroll
            for (int k = -7; k <= -2; ++k) win[(k + 8) & 7] = HY_LDA(k);
#pragma unroll 1
            for (int b4 = 0; b4 < NST / 4; ++b4) {
#pragma unroll
                for (int u = 0; u < 4; ++u) { const int st = 4 * b4 + u;
                    win[(2 * u) & 7] = HY_LDA(2 * st); win[(2 * u + 7) & 7] = HY_LDA(2 * st - 1);
                    const bf16x8_t zf = *(const LAS bf16x8_t*)(lds + zbase + 64 * st);
#pragma unroll
                    for (int i = 0; i < 8; ++i) acc[i] = __builtin_amdgcn_mfma_f32_16x16x32_bf16(win[(2 * u - i + 8) & 7], zf, acc[i], 0, 0, 0); } }
#undef HY_LDA
            const bf16* Xg = (o == 0 ? X1T : X2T) + rowb + (size_t)m * NPOS; bf16* Og = (o == 0 ? Z1T : HYT) + rowb + (size_t)m * NPOS;
#pragma unroll
            for (int i = 0; i < 8; ++i) { const int t = 128 * tb + 16 * i + 4 * q;
                const v2u xg = *(const v2u*)(Xg + t); const v2u zl = *(const LAS v2u*)(lds + Z_OFF + m * ZP + 2 * t);
                const float x0 = __uint_as_float(xg.x << 16), x1 = __uint_as_float(xg.x & 0xffff0000u), x2 = __uint_as_float(xg.y << 16), x3 = __uint_as_float(xg.y & 0xffff0000u);
                const float z0 = __uint_as_float(zl.x << 16), z1 = __uint_as_float(zl.x & 0xffff0000u), z2 = __uint_as_float(zl.y << 16), z3 = __uint_as_float(zl.y & 0xffff0000u);
                v2u w; w.x = f2bf_bits(x0 * (acc[i][0] * inv + bias * z0)) | (f2bf_bits(x1 * (acc[i][1] * inv + bias * z1)) << 16);
                w.y = f2bf_bits(x2 * (acc[i][2] * inv + bias * z2)) | (f2bf_bits(x3 * (acc[i][3] * inv + bias * z3)) << 16);
                *(v2u*)(Og + t) = w; } }
        __syncthreads();
    }
}
__device__ __forceinline__ void hy_conv(const Ctx& c, int l, LAS unsigned char* lds, int tid, int G, int bid) {
    for (int cc = bid; cc < DH; cc += G) { hy_conv_seq<0>(c, l, cc, lds, tid); hy_conv_seq<1>(c, l, cc, lds, tid); }
}
__device__ __forceinline__ void hy_post(const Ctx& c, LAS unsigned char* lds, int tid, int G, int bid) {
    constexpr int TPB = 260;
    const bf16* HYT = wsp<bf16>(c, WS_HYT); bf16* HY = wsp<bf16>(c, WS_HY); const int lane = tid & 63, wave = __builtin_amdgcn_readfirstlane(tid >> 6);
    for (int tile = bid; tile < NT / 128; tile += G) { const int r0 = tile * 128; int b, pos0; chan_pos(r0, b, pos0);
        for (int c0 = wave; c0 < DH; c0 += 8 * 16) { unsigned hv[16];
#pragma unroll
            for (int u = 0; u < 16; ++u) { const int cc = c0 + 8 * u; hv[u] = cc < DH ? *(const unsigned*)(HYT + ((size_t)cc * NB + b) * NPOS + pos0 + 2 * lane) : 0u; }
#pragma unroll
            for (int u = 0; u < 16; ++u) { const int cc = c0 + 8 * u; if (cc < DH) *(LAS unsigned*)(lds + cc * TPB + 4 * lane) = hv[u]; } }
        __syncthreads();
        for (int i = tid; i < 128 * 48; i += NTHR_) { const int t = i % 128, ch = i / 128; const LAS bf16* s0 = (const LAS bf16*)(lds + (ch * 8) * TPB + 2 * t);
            v4u o; o.x = (unsigned)s0[0] | ((unsigned)s0[TPB / 2] << 16); o.y = (unsigned)s0[2 * (TPB / 2)] | ((unsigned)s0[3 * (TPB / 2)] << 16);
            o.z = (unsigned)s0[4 * (TPB / 2)] | ((unsigned)s0[5 * (TPB / 2)] << 16); o.w = (unsigned)s0[6 * (TPB / 2)] | ((unsigned)s0[7 * (TPB / 2)] << 16);
            *(v4u*)(HY + (size_t)(r0 + t) * DH + ch * 8) = o; }
        __syncthreads(); }
}

constexpr int ML_QS = 0, ML_KS = 13312, ML_KT = 26624, ML_VT = 40448, ML_VW = 49664, ML_SP = 58880, ML_CB = 68096, ML_VEC = 81408, ML_DEN = 83968, ML_SCAL = 84224, ML_CW = 84480;
constexpr int ML_P1 = 208, ML_P2 = 144;
__device__ __forceinline__ float fexp(float x) { return __builtin_amdgcn_exp2f(1.4426950408889634f * x); }
__device__ __forceinline__ void ml_prep(const Ctx& c, int l, int tid, int G, int bid) {
    if (tid >= 384) return;
    const int ch = tid % 96, tg = tid / 96; const bf16* P = wsp<bf16>(c, WS_P); bf16* QK = wsp<bf16>(c, WS_QKC);
    float w0[8], w1[8], w2[8], bb[8];
#pragma unroll
    for (int e = 0; e < 8; ++e) { const float* cw = c.in[I_MLCW] + (size_t)l * 3 * 768 + ch * 8 + e; w0[e] = cw[0]; w1[e] = cw[768]; w2[e] = cw[1536]; bb[e] = c.in[I_MLCB][l * 768 + ch * 8 + e]; }
    const float ksc = ch >= 48 ? 0.10206207261596575f : 1.0f;
    for (int g0 = bid; g0 < NT / 4; g0 += 4 * G) {
        v4u x0[4], xm[4], xp[4];
#pragma unroll
        for (int u = 0; u < 4; ++u) { const int grp = g0 + u * G; x0[u] = (v4u){0u, 0u, 0u, 0u}; xm[u] = x0[u]; xp[u] = x0[u];
            if (grp < NT / 4) { const int r = grp * 4 + tg; const bf16* src = P + (size_t)r * NP + PC_Q + ch * 8; x0[u] = *(const v4u*)src;
                if (has_prev(r)) xm[u] = *(const v4u*)(src - NP); if (has_next(r)) xp[u] = *(const v4u*)(src + NP); } }
#pragma unroll
        for (int u = 0; u < 4; ++u) { const int grp = g0 + u * G; if (grp < NT / 4) { const int r = grp * 4 + tg; unsigned o[4];
#pragma unroll
            for (int e2 = 0; e2 < 4; ++e2) { float y[2];
#pragma unroll
                for (int hh = 0; hh < 2; ++hh) { const int e = 2 * e2 + hh; const unsigned um = xm[u][e2], u0 = x0[u][e2], up = xp[u][e2];
                    const float fm = __uint_as_float(hh ? (um & 0xffff0000u) : (um << 16)), f0 = __uint_as_float(hh ? (u0 & 0xffff0000u) : (u0 << 16)), fp = __uint_as_float(hh ? (up & 0xffff0000u) : (up << 16));
                    float v = bb[e] + w0[e] * fm + w1[e] * f0 + w2[e] * fp; y[hh] = v * pg8::fsig(v) * ksc; }
                o[e2] = f2bf_bits(y[0]) | (f2bf_bits(y[1]) << 16); }
            *(v4u*)(QK + (size_t)r * 768 + ch * 8) = (v4u){o[0], o[1], o[2], o[3]}; } } }
}
constexpr int ML_GV = 87552, ML_MP = 133632, ML_DEC = 133776, ML_SC = 133920, ML_NCH = NPOS / 64;
static_assert(ML_SC + ML_NCH * 8 <= 147200, "mLSTM LDS map");
#define ML_BAR() do { asm volatile("s_waitcnt lgkmcnt(0)" ::: "memory"); __builtin_amdgcn_s_barrier(); asm volatile("" ::: "memory"); } while (0)
__device__ __forceinline__ void ml_chain(const Ctx& c, int l, LAS unsigned char* lds, int tid, int unit) {
    const int d = unit >> 7, b = (unit >> 3) & 15, h = (unit >> 1) & 3, half = unit & 1;
    const int lane = tid & 63, wave = __builtin_amdgcn_readfirstlane(tid >> 6), m16 = lane & 15, q = lane >> 4;
    const bf16* P = wsp<bf16>(c, WS_P); const bf16* QK = wsp<bf16>(c, WS_QKC); bf16* HFB = wsp<bf16>(c, WS_HFB) + (size_t)d * NT * DH + h * MLD + half * 48;
    LAS float* GV = (LAS float*)(lds + ML_GV); LAS float* DEN = (LAS float*)(lds + ML_DEN);
    LAS float* MP = (LAS float*)(lds + ML_MP); LAS float* DEC = (LAS float*)(lds + ML_DEC); LAS float* SC = (LAS float*)(lds + ML_SC);
    for (int i = tid; i < 16 * 64; i += NTHR_) { const int row = 48 + i / 64, j = i % 64; ((LAS bf16*)(lds + ML_VT + row * ML_P2))[j] = row == 48 ? (bf16)0x3F80 : (bf16)0; ((LAS bf16*)(lds + ML_VW + row * ML_P2))[j] = 0; }
    for (int i = tid; i < 64 * ML_P1 / 4; i += NTHR_) ((LAS unsigned*)(lds + ML_CB))[i] = 0u;
    const float gbi = c.in[I_MLGB][l * 16 + (2 * d) * 4 + h], gbf = c.in[I_MLGB][l * 16 + (2 * d + 1) * 4 + h];
    for (int ch = wave; ch < ML_NCH; ch += 8) { const int r = seq_tok(d, b, ch * 64 + lane);
        const float gi = bf2f(P[(size_t)r * NP + PC_GT + (2 * d) * 4 + h]) + gbi, gf = logsig(bf2f(P[(size_t)r * NP + PC_GT + (2 * d + 1) * 4 + h]) + gbf);
        float bc = gf;
#pragma unroll
        for (int o = 1; o < 64; o <<= 1) { const float y = __shfl_up(bc, o); if (lane >= o) bc += y; }
        const float a = gi - bc; float pm = a;
#pragma unroll
        for (int o = 1; o < 64; o <<= 1) { const float y = __shfl_up(pm, o); if (lane >= o) pm = fmaxf(pm, y); }
        LAS float* V = GV + ch * 320; V[lane] = a; V[64 + lane] = pm; V[256 + lane] = bc;
        if (lane == 63) { SC[2 * ch] = pm; SC[2 * ch + 1] = bc; } }
    __syncthreads();
    if (wave == 0) { float mp = -1e30f;
        for (int ch = 0; ch < ML_NCH; ++ch) { if (lane == 0) MP[ch] = mp; mp = SC[2 * ch + 1] + fmaxf(mp, SC[2 * ch]); } }
    __syncthreads();
    for (int ch = wave; ch < ML_NCH; ch += 8) { LAS float* V = GV + ch * 320; const float mp = MP[ch], a = V[lane], pm = V[64 + lane], bc = V[256 + lane];
        const float M = fmaxf(mp, pm), M63 = __shfl(M, 63);
        V[64 + lane] = M; V[128 + lane] = fexp(mp - M); V[192 + lane] = fexp(a - M63); V[256 + lane] = fexp(-(bc + M));
        if (lane == 0) DEC[ch] = fexp(mp - M63); }
    f32x4_t accC[3];
#pragma unroll
    for (int i = 0; i < 3; ++i) accC[i] = (f32x4_t){0.f, 0.f, 0.f, 0.f};
    v4u x0[3], xv;
#define ML_LOAD(chn) do { const int t0_ = (chn) * 64; \
        _Pragma("unroll") for (int it = 0; it < 3; ++it) { const int idx = tid + NTHR_ * it, j = idx & 63, c8 = idx >> 6, isk = c8 >= 12 ? 1 : 0, cc = c8 - 12 * isk; \
            const int r = seq_tok(d, b, t0_ + j); x0[it] = *(const v4u*)(QK + (size_t)r * 768 + isk * DH + h * MLD + cc * 8); } \
        if (tid < 384) { const int j = tid & 63, c6 = tid >> 6, r = seq_tok(d, b, t0_ + j); xv = *(const v4u*)(P + (size_t)r * NP + PC_V + h * MLD + half * 48 + c6 * 8); } } while (0)
    xv = (v4u){0u, 0u, 0u, 0u};
    ML_LOAD(0);
    __syncthreads();
    float oval[2][4];
#pragma unroll
    for (int i = 0; i < 2; ++i)
#pragma unroll
        for (int jj = 0; jj < 4; ++jj) oval[i][jj] = 0.f;
#define ML_STORE_PREV(tau_) do { const int tq_ = wave >> 1, dq_ = 2 * (wave & 1); \
        _Pragma("unroll") for (int i = 0; i < 2; ++i) if (dq_ + i < 3) { _Pragma("unroll") for (int jj = 0; jj < 4; ++jj) { const int r_ = seq_tok(d, b, (tau_) + 16 * tq_ + 4 * q + jj); HFB[(size_t)r_ * DH + 16 * (dq_ + i) + m16] = f2bf(oval[i][jj]); } } } while (0)
#pragma unroll 1
    for (int ch = 0; ch < ML_NCH; ++ch) {
        const int tau0 = ch * 64; LAS float* V = GV + ch * 320;
#pragma unroll
        for (int it = 0; it < 3; ++it) { const int idx = tid + NTHR_ * it, j = idx & 63, c8 = idx >> 6, isk = c8 >= 12 ? 1 : 0, cc = c8 - 12 * isk;
            *(LAS v4u*)(lds + (isk ? ML_KS : ML_QS) + j * ML_P1 + cc * 16) = x0[it];
            if (isk) {
#pragma unroll
                for (int e = 0; e < 8; ++e) ((LAS bf16*)(lds + ML_KT + (cc * 8 + e) * ML_P2))[j] = (bf16)((e & 1) ? (x0[it][e >> 1] >> 16) : (x0[it][e >> 1] & 0xffffu)); } }
        if (tid < 384) { const int j = tid & 63, c6 = tid >> 6; const float wj = V[192 + j];
#pragma unroll
            for (int e = 0; e < 8; ++e) { const unsigned u = xv[e >> 1]; const unsigned bits = (e & 1) ? (u >> 16) : (u & 0xffffu);
                ((LAS bf16*)(lds + ML_VT + (c6 * 8 + e) * ML_P2))[j] = (bf16)bits; ((LAS bf16*)(lds + ML_VW + (c6 * 8 + e) * ML_P2))[j] = f2bf(wj * __uint_as_float(bits << 16)); } }
        else if (tid < 448) { const int j = tid - 384; ((LAS bf16*)(lds + ML_VW + 48 * ML_P2))[j] = f2bf(V[192 + j]); }
        if (ch > 0) ML_STORE_PREV(tau0 - 64);
        if (ch + 1 < ML_NCH) ML_LOAD(ch + 1);
        ML_BAR();
        {
            const unsigned long long TS = 0x313210210100ull, TT = 0x203333222110ull;
#pragma unroll
            for (int rep = 0; rep < 2; ++rep) { const int idx = wave + 8 * rep; if (idx < 12) { const int st = (int)((TS >> (4 * idx)) & 15), tt = (int)((TT >> (4 * idx)) & 15);
                f32x4_t acc = (f32x4_t){0.f, 0.f, 0.f, 0.f};
                if (idx < 10) {
#pragma unroll
                    for (int ks = 0; ks < 3; ++ks) { const bf16x8_t a = *(const LAS bf16x8_t*)(lds + ML_KS + (16 * st + m16) * ML_P1 + (ks * 32 + 8 * q) * 2);
                        const bf16x8_t bq = *(const LAS bf16x8_t*)(lds + ML_QS + (16 * tt + m16) * ML_P1 + (ks * 32 + 8 * q) * 2); acc = __builtin_amdgcn_mfma_f32_16x16x32_bf16(a, bq, acc, 0, 0, 0); } }
                const int t = 16 * tt + m16, s0 = 16 * st + 4 * q; const float Mt = V[64 + t]; const f32x4_t a4 = *(const LAS f32x4_t*)(V + s0); float o[4];
#pragma unroll
                for (int jj = 0; jj < 4; ++jj) o[jj] = (idx < 10 && s0 + jj <= t) ? acc[jj] * fexp(a4[jj] - Mt) : 0.f;
                *(LAS v2u*)(lds + ML_SP + t * ML_P2 + s0 * 2) = (v2u){f2bf_bits(o[0]) | (f2bf_bits(o[1]) << 16), f2bf_bits(o[2]) | (f2bf_bits(o[3]) << 16)}; } }
        }
        const int tt = wave >> 1, dt0 = 2 * (wave & 1);
        f32x4_t accB[2], accA[2];
#pragma unroll
        for (int i = 0; i < 2; ++i) { accB[i] = (f32x4_t){0.f, 0.f, 0.f, 0.f}; accA[i] = (f32x4_t){0.f, 0.f, 0.f, 0.f}; }
#pragma unroll
        for (int ks = 0; ks < 3; ++ks) { const bf16x8_t a = *(const LAS bf16x8_t*)(lds + ML_QS + (16 * tt + m16) * ML_P1 + (ks * 32 + 8 * q) * 2);
#pragma unroll
            for (int i = 0; i < 2; ++i) { const bf16x8_t bb = *(const LAS bf16x8_t*)(lds + ML_CB + (16 * (dt0 + i) + m16) * ML_P1 + (ks * 32 + 8 * q) * 2); accB[i] = __builtin_amdgcn_mfma_f32_16x16x32_bf16(a, bb, accB[i], 0, 0, 0); } }
        ML_BAR();
#pragma unroll
        for (int ks = 0; ks < 2; ++ks) if (ks <= (tt >> 1)) { const bf16x8_t a = *(const LAS bf16x8_t*)(lds + ML_SP + (16 * tt + m16) * ML_P2 + (ks * 32 + 8 * q) * 2);
#pragma unroll
            for (int i = 0; i < 2; ++i) { const bf16x8_t bb = *(const LAS bf16x8_t*)(lds + ML_VT + (16 * (dt0 + i) + m16) * ML_P2 + (ks * 32 + 8 * q) * 2); accA[i] = __builtin_amdgcn_mfma_f32_16x16x32_bf16(a, bb, accA[i], 0, 0, 0); } }
        { const f32x4_t wa4 = *(const LAS f32x4_t*)(V + 128 + 16 * tt + 4 * q);
#pragma unroll
          for (int i = 0; i < 2; ++i) accA[i] = accA[i] + wa4 * accB[i];
          if (dt0 == 2 && m16 == 0) *(LAS f32x4_t*)(DEN + 16 * tt + 4 * q) = accA[1]; }
        { const float decay = DEC[ch]; const int dtile = wave >> 1, et0 = 3 * (wave & 1);
#pragma unroll
          for (int i = 0; i < 3; ++i) accC[i] = accC[i] * decay;
#pragma unroll
          for (int ks = 0; ks < 2; ++ks) { const bf16x8_t a = *(const LAS bf16x8_t*)(lds + ML_VW + (16 * dtile + m16) * ML_P2 + (ks * 32 + 8 * q) * 2);
#pragma unroll
              for (int i = 0; i < 3; ++i) { const bf16x8_t bb = *(const LAS bf16x8_t*)(lds + ML_KT + (16 * (et0 + i) + m16) * ML_P2 + (ks * 32 + 8 * q) * 2); accC[i] = __builtin_amdgcn_mfma_f32_16x16x32_bf16(a, bb, accC[i], 0, 0, 0); } }
#pragma unroll
          for (int i = 0; i < 3; ++i)
#pragma unroll
              for (int jj = 0; jj < 4; ++jj) ((LAS bf16*)(lds + ML_CB + (16 * dtile + 4 * q + jj) * ML_P1))[16 * (et0 + i) + m16] = f2bf(accC[i][jj]); }
        ML_BAR();
        { const f32x4_t dn = *(const LAS f32x4_t*)(DEN + 16 * tt + 4 * q), em = *(const LAS f32x4_t*)(V + 256 + 16 * tt + 4 * q);
#pragma unroll
          for (int i = 0; i < 2; ++i)
#pragma unroll
              for (int jj = 0; jj < 4; ++jj) oval[i][jj] = accA[i][jj] / fmaxf(fabsf(dn[jj]), em[jj]); }
    }
    ML_STORE_PREV((ML_NCH - 1) * 64);
#undef ML_LOAD
#undef ML_STORE_PREV
    __syncthreads();
}
constexpr int NR_SS = 0, NR_PL = 1024, NR_LG = 17408;
template <int MODE, bool COMB, bool FROMIN = false> __device__ __forceinline__ void norm_rows(const Ctx& c, int l, int lc, LAS unsigned char* lds, int tid, int G, int bid, int nrows = NT) {
    const int lane = tid & 63, wave = __builtin_amdgcn_readfirstlane(tid >> 6), m = lane & 15, q = lane >> 4;
    bf16* X = wsp<bf16>(c, WS_X); const float* MOD = wsp<float>(c, WS_MOD); bf16* H = wsp<bf16>(c, WS_H); (void)H;
    LAS float* SS = (LAS float*)(lds + NR_SS); LAS float* PL = (LAS float*)(lds + NR_PL); LAS float* LG = (LAS float*)(lds + NR_LG);
    bf16x8_t Bh[4][2], Bl[4][2];
    if (MODE == 1) {
#pragma unroll
        for (int i = 0; i < 4; ++i)
#pragma unroll
            for (int nt = 0; nt < 2; ++nt) { const size_t o = ((size_t)l * NE + 16 * nt + m) * D + 128 * wave + 32 * i + 8 * q;
                Bh[i][nt] = *(const bf16x8_t*)(wsp<bf16>(c, WS_WRH) + o); Bl[i][nt] = *(const bf16x8_t*)(wsp<bf16>(c, WS_WRL) + o); } }
    const int ngrp = (MODE == 2 ? NTL : nrows) / 16; int par = 0; const int kb = 128 * wave + 8 * q;
    f32x4_t xa[4], xb[4]; v4u xw[4]; (void)xa; (void)xb; (void)xw;
    v4u sl = (v4u){0u, 0u, 0u, 0u}; f32x4_t wk = (f32x4_t){0.f, 0.f, 0.f, 0.f};
#define NR_LOAD(g_) do { const int row_ = (g_) * 16 + m; \
        if (FROMIN) { const float* xs_ = row_ < NTL ? c.in[I_X] + (size_t)row_ * D : c.in[I_CTX] + (size_t)(row_ - NTL) * D; \
            _Pragma("unroll") for (int i = 0; i < 4; ++i) { xa[i] = *(const f32x4_t*)(xs_ + kb + 32 * i); xb[i] = *(const f32x4_t*)(xs_ + kb + 32 * i + 4); } } \
        else { const bf16* xs_ = X + (size_t)row_ * D; \
            _Pragma("unroll") for (int i = 0; i < 4; ++i) xw[i] = *(const v4u*)(xs_ + kb + 32 * i); } \
        } while (0)
    v4u sl1 = (v4u){0u, 0u, 0u, 0u}; f32x4_t wk1 = (f32x4_t){0.f, 0.f, 0.f, 0.f}; v2u og[4][4]; float osc[4][4];
#define NR_SLOAD(g_, slv_, wkv_) do { const int row_ = (g_) * 16 + m; slv_ = *(const v4u*)(wsp<int>(c, WS_ASGS) + (size_t)row_ * TOPK); wkv_ = *(const f32x4_t*)(wsp<float>(c, WS_ASGW) + (size_t)row_ * TOPK); } while (0)
#define NR_OLOAD(slv_) do { const unsigned char* O_ = wsp<unsigned char>(c, WS_OUTS); const float* OSC_ = wsp<float>(c, WS_OUTSC); \
        _Pragma("unroll") for (int i = 0; i < 4; ++i) { _Pragma("unroll") for (int kk = 0; kk < TOPK; ++kk) { og[i][kk] = *(const v2u*)(O_ + (size_t)slv_[kk] * D + kb + 32 * i); osc[i][kk] = OSC_[(size_t)slv_[kk] * 32 + 4 * wave + i]; } } } while (0)
    if (bid < ngrp) { NR_LOAD(bid); if (COMB) { NR_SLOAD(bid, sl, wk); if (bid + G < ngrp) NR_SLOAD(bid + G, sl1, wk1); NR_OLOAD(sl); } }
    for (int grp = bid; grp < ngrp; grp += G, par ^= 1) {
        const int r0 = grp * 16, row = r0 + m, mb = r0 < NTL ? r0 / SEQ : NB;
        float xv[4][8];
#pragma unroll
        for (int i = 0; i < 4; ++i) {
            if (FROMIN) { xv[i][0] = xa[i][0]; xv[i][1] = xa[i][1]; xv[i][2] = xa[i][2]; xv[i][3] = xa[i][3]; xv[i][4] = xb[i][0]; xv[i][5] = xb[i][1]; xv[i][6] = xb[i][2]; xv[i][7] = xb[i][3]; }
            else { const v4u w_ = xw[i]; xv[i][0] = __uint_as_float(w_.x << 16); xv[i][1] = __uint_as_float(w_.x & 0xffff0000u); xv[i][2] = __uint_as_float(w_.y << 16); xv[i][3] = __uint_as_float(w_.y & 0xffff0000u);
                xv[i][4] = __uint_as_float(w_.z << 16); xv[i][5] = __uint_as_float(w_.z & 0xffff0000u); xv[i][6] = __uint_as_float(w_.w << 16); xv[i][7] = __uint_as_float(w_.w & 0xffff0000u); } }
        const f32x4_t wkc = wk;
        if (COMB) {
            const float* g2 = MOD + ((size_t)lc * NMOD + mb) * 6144 + 5 * D + kb;
#pragma unroll
            for (int i = 0; i < 4; ++i) { float f[8]; float ssum = 0.f;
#pragma unroll
                for (int e = 0; e < 8; ++e) f[e] = 0.f;
#pragma unroll
                for (int kk = 0; kk < TOPK; ++kk) { const v2u o = og[i][kk]; const float sc = wkc[kk] * osc[i][kk]; ssum += sc;
                    f[0] += sc * (float)(o.x & 0xffu); f[1] += sc * (float)((o.x >> 8) & 0xffu); f[2] += sc * (float)((o.x >> 16) & 0xffu); f[3] += sc * (float)(o.x >> 24);
                    f[4] += sc * (float)(o.y & 0xffu); f[5] += sc * (float)((o.y >> 8) & 0xffu); f[6] += sc * (float)((o.y >> 16) & 0xffu); f[7] += sc * (float)(o.y >> 24); }
#pragma unroll
                for (int e = 0; e < 8; ++e) f[e] -= 128.0f * ssum;
                const f32x4_t ga = *(const f32x4_t*)(g2 + 32 * i), gb = *(const f32x4_t*)(g2 + 32 * i + 4);
#pragma unroll
                for (int e = 0; e < 4; ++e) { xv[i][e] += ga[e] * f[e]; xv[i][4 + e] += gb[e] * f[4 + e]; }
                if (MODE != 2) { *(v4u*)(X + (size_t)row * D + kb + 32 * i) = (v4u){f2bf_bits(xv[i][0]) | (f2bf_bits(xv[i][1]) << 16), f2bf_bits(xv[i][2]) | (f2bf_bits(xv[i][3]) << 16), f2bf_bits(xv[i][4]) | (f2bf_bits(xv[i][5]) << 16), f2bf_bits(xv[i][6]) | (f2bf_bits(xv[i][7]) << 16)};
#pragma unroll
                    for (int e = 0; e < 8; ++e) xv[i][e] = __uint_as_float(f2bf_bits(xv[i][e]) << 16); } }
        }
        if (grp + G < ngrp) { NR_LOAD(grp + G); if (COMB) { sl = sl1; wk = wk1; NR_OLOAD(sl); if (grp + 2 * G < ngrp) NR_SLOAD(grp + 2 * G, sl1, wk1); } }
        f32x4_t ma[4][2], mh[4][2];
        if (MODE == 0) { const float* ng_ = c.in[MODE == 1 ? I_N2G : I_N1G] + l * D + kb; const float* sh_ = MOD + ((size_t)l * NMOD + mb) * 6144 + (MODE == 1 ? 3 : 0) * D + kb; const float* sc_ = sh_ + D;
#pragma unroll
            for (int i = 0; i < 4; ++i)
#pragma unroll
                for (int hh = 0; hh < 2; ++hh) { const f32x4_t g4 = *(const f32x4_t*)(ng_ + 32 * i + 4 * hh), s4 = *(const f32x4_t*)(sc_ + 32 * i + 4 * hh); mh[i][hh] = *(const f32x4_t*)(sh_ + 32 * i + 4 * hh); ma[i][hh] = g4 * (1.0f + s4); } }
        float ss = 0.f;
#pragma unroll
        for (int i = 0; i < 4; ++i)
#pragma unroll
            for (int e = 0; e < 8; ++e) ss += xv[i][e] * xv[i][e];
        ss += __shfl_xor(ss, 16); ss += __shfl_xor(ss, 32);
        if (q == 0) SS[par * 128 + wave * 16 + m] = ss;
        ML_BAR();
        float tot = 0.f;
#pragma unroll
        for (int w = 0; w < 8; ++w) tot += SS[par * 128 + w * 16 + m];
        const float rs = 1.0f / sqrtf(tot * (1.0f / D) + EPS);
        if (MODE == 2) { const float* fg = c.in[I_FNG] + kb;
#pragma unroll
            for (int i = 0; i < 4; ++i) { const f32x4_t ga = *(const f32x4_t*)(fg + 32 * i), gb = *(const f32x4_t*)(fg + 32 * i + 4);
                *(f32x4_t*)(c.out + (size_t)row * D + kb + 32 * i) = (f32x4_t){xv[i][0] * rs * ga[0], xv[i][1] * rs * ga[1], xv[i][2] * rs * ga[2], xv[i][3] * rs * ga[3]};
                *(f32x4_t*)(c.out + (size_t)row * D + kb + 32 * i + 4) = (f32x4_t){xv[i][4] * rs * gb[0], xv[i][5] * rs * gb[1], xv[i][6] * rs * gb[2], xv[i][7] * rs * gb[3]}; }
            continue; }
        const float* ng = c.in[MODE == 1 ? I_N2G : I_N1G] + l * D + kb; const float* sh = MOD + ((size_t)l * NMOD + mb) * 6144 + (MODE == 1 ? 3 : 0) * D + kb; const float* sc = sh + D; (void)ng; (void)sc;
        if (MODE == 0) {
            float amax = 0.f;
#pragma unroll
            for (int i = 0; i < 4; ++i)
#pragma unroll
                for (int hh = 0; hh < 2; ++hh) {
#pragma unroll
                    for (int e = 0; e < 4; ++e) { const float hv = xv[i][4 * hh + e] * rs * ma[i][hh][e] + mh[i][hh][e]; xv[i][4 * hh + e] = hv; amax = fmaxf(amax, fabsf(hv)); } }
            amax = fmaxf(amax, __shfl_xor(amax, 16)); amax = fmaxf(amax, __shfl_xor(amax, 32));
            LAS float* MX = (LAS float*)(lds + 20480);
            if (q == 0) MX[par * 128 + wave * 16 + m] = amax;
            ML_BAR();
            float rmax = 0.f;
#pragma unroll
            for (int w = 0; w < 8; ++w) rmax = fmaxf(rmax, MX[par * 128 + w * 16 + m]);
            const float qs = rmax > 0.f ? rmax * (1.0f / 127.0f) : 1.0f, qi = 1.0f / qs;
            if (wave == 0 && q == 0) wsp<float>(c, WS_HS)[row] = qs;
            signed char* HQ = wsp<signed char>(c, WS_H);
#pragma unroll
            for (int i = 0; i < 4; ++i) { unsigned pk[2];
#pragma unroll
                for (int w2 = 0; w2 < 2; ++w2) { unsigned v = 0u;
#pragma unroll
                    for (int e = 0; e < 4; ++e) { const int qq = (int)__builtin_rintf(xv[i][4 * w2 + e] * qi); v |= ((unsigned)qq & 0xffu) << (8 * e); }
                    pk[w2] = v; }
                *(v2u*)(HQ + (size_t)row * D + kb + 32 * i) = (v2u){pk[0], pk[1]}; }
            continue; }
        f32x4_t accL[2] = {(f32x4_t){0.f, 0.f, 0.f, 0.f}, (f32x4_t){0.f, 0.f, 0.f, 0.f}}; float amax1 = 0.f;
#pragma unroll
        for (int i = 0; i < 4; ++i) { float hv[8];
#pragma unroll
            for (int hh = 0; hh < 2; ++hh) { const f32x4_t g4 = *(const f32x4_t*)(ng + 32 * i + 4 * hh), s4 = *(const f32x4_t*)(sc + 32 * i + 4 * hh), h4 = *(const f32x4_t*)(sh + 32 * i + 4 * hh);
#pragma unroll
                for (int e = 0; e < 4; ++e) { hv[4 * hh + e] = xv[i][4 * hh + e] * rs * g4[e] * (1.0f + s4[e]) + h4[e]; xv[i][4 * hh + e] = hv[4 * hh + e]; amax1 = fmaxf(amax1, fabsf(hv[4 * hh + e])); } }
            unsigned hb[8];
#pragma unroll
            for (int e = 0; e < 8; ++e) hb[e] = f2bf_bits(hv[e]);
            const v4u hp = (v4u){hb[0] | (hb[1] << 16), hb[2] | (hb[3] << 16), hb[4] | (hb[5] << 16), hb[6] | (hb[7] << 16)};
            { unsigned lb[8];
#pragma unroll
                for (int e = 0; e < 8; ++e) lb[e] = f2bf_bits(hv[e] - __uint_as_float(hb[e] << 16));
                const v4u lp = (v4u){lb[0] | (lb[1] << 16), lb[2] | (lb[3] << 16), lb[4] | (lb[5] << 16), lb[6] | (lb[7] << 16)};
                const bf16x8_t Ah = __builtin_bit_cast(bf16x8_t, hp), Al = __builtin_bit_cast(bf16x8_t, lp);
#pragma unroll
                for (int nt = 0; nt < 2; ++nt) { accL[nt] = __builtin_amdgcn_mfma_f32_16x16x32_bf16(Ah, Bh[i][nt], accL[nt], 0, 0, 0);
                    accL[nt] = __builtin_amdgcn_mfma_f32_16x16x32_bf16(Al, Bh[i][nt], accL[nt], 0, 0, 0); accL[nt] = __builtin_amdgcn_mfma_f32_16x16x32_bf16(Ah, Bl[i][nt], accL[nt], 0, 0, 0); } } }
        { amax1 = fmaxf(amax1, __shfl_xor(amax1, 16)); amax1 = fmaxf(amax1, __shfl_xor(amax1, 32)); LAS float* MX = (LAS float*)(lds + 20480); if (q == 0) MX[par * 128 + wave * 16 + m] = amax1; }
        if (MODE == 1) {
#pragma unroll
            for (int nt = 0; nt < 2; ++nt)
#pragma unroll
                for (int j = 0; j < 4; ++j) PL[(wave * 16 + 4 * q + j) * 32 + 16 * nt + m] = accL[nt][j];
            ML_BAR();
            { const LAS float* MX = (const LAS float*)(lds + 20480); float rmax = 0.f;
#pragma unroll
              for (int w = 0; w < 8; ++w) rmax = fmaxf(rmax, MX[par * 128 + w * 16 + m]);
              const float qs = rmax > 0.f ? rmax * (1.0f / 127.0f) : 1.0f, qi = 1.0f / qs;
              if (wave == 0 && q == 0) wsp<float>(c, WS_HS)[row] = qs;
              signed char* HQ = wsp<signed char>(c, WS_H);
#pragma unroll
              for (int i = 0; i < 4; ++i) { unsigned pk[2];
#pragma unroll
                  for (int w2 = 0; w2 < 2; ++w2) { unsigned v = 0u;
#pragma unroll
                      for (int e = 0; e < 4; ++e) { const int qq = (int)__builtin_rintf(xv[i][4 * w2 + e] * qi); v |= ((unsigned)qq & 0xffu) << (8 * e); }
                      pk[w2] = v; }
                  *(v2u*)(HQ + (size_t)row * D + kb + 32 * i) = (v2u){pk[0], pk[1]}; } }
            { const int rr = tid >> 5, e = tid & 31; float v = c.in[I_RB][l * NE + e];
#pragma unroll
              for (int w = 0; w < 8; ++w) v += PL[(w * 16 + rr) * 32 + e];
              LG[rr * 32 + e] = v; }
            ML_BAR();
            if (tid < 16) { const int r = r0 + tid; float lg[NE];
#pragma unroll
                for (int e = 0; e < NE; ++e) lg[e] = LG[tid * 32 + e];
                int sel[TOPK]; float sv[TOPK]; unsigned taken = 0u;
#pragma unroll
                for (int kk = 0; kk < TOPK; ++kk) { float best = -3.0e38f; int bi = 0;
#pragma unroll
                    for (int e = 0; e < NE; ++e) { if (!((taken >> e) & 1u) && lg[e] > best) { best = lg[e]; bi = e; } }
                    sel[kk] = bi; sv[kk] = best; taken |= 1u << bi; }
                float es[TOPK], sum = 0.f;
#pragma unroll
                for (int kk = 0; kk < TOPK; ++kk) { es[kk] = expf(sv[kk] - sv[0]); sum += es[kk]; }
                int* AE = wsp<int>(c, WS_ASGE); int* AP = wsp<int>(c, WS_ASGP); float* AW = wsp<float>(c, WS_ASGW); unsigned* CNT = wsp<unsigned>(c, WS_CTL) + CW_CNT + l * NE;
#pragma unroll
                for (int kk = 0; kk < TOPK; ++kk) { AE[r * TOPK + kk] = sel[kk]; AW[r * TOPK + kk] = es[kk] / sum; AP[r * TOPK + kk] = atomic_inc(CNT + sel[kk]); } } }
    }
#undef NR_LOAD
#undef NR_SLOAD
#undef NR_OLOAD
    __syncthreads();
}

__device__ __forceinline__ void ml_headout(const Ctx& c, int l, int tid, int G, int bid) {
    const int lane = tid & 63, wave = __builtin_amdgcn_readfirstlane(tid >> 6), sub = lane & 7, hd = lane >> 3;
    const bf16* HFB = wsp<bf16>(c, WS_HFB); const bf16* P = wsp<bf16>(c, WS_P); bf16* MLO = wsp<bf16>(c, WS_MLO);
    for (int it = bid * 8 + wave; it < NT * MLH / 8; it += G * 8) { const int th = it * 8 + hd, r = th >> 2, h = th & 3; const size_t o = (size_t)r * DH + h * MLD + sub * 12;
        float v[12];
#pragma unroll
        for (int i = 0; i < 3; ++i) { const v2u a = *(const v2u*)(HFB + o + 4 * i), b = *(const v2u*)(HFB + (size_t)NT * DH + o + 4 * i);
            v[4 * i] = __uint_as_float(a.x << 16) + __uint_as_float(b.x << 16); v[4 * i + 1] = __uint_as_float(a.x & 0xffff0000u) + __uint_as_float(b.x & 0xffff0000u);
            v[4 * i + 2] = __uint_as_float(a.y << 16) + __uint_as_float(b.y << 16); v[4 * i + 3] = __uint_as_float(a.y & 0xffff0000u) + __uint_as_float(b.y & 0xffff0000u); }
        float ss = 0.f;
#pragma unroll
        for (int e = 0; e < 12; ++e) ss += v[e] * v[e];
        ss += __shfl_xor(ss, 1); ss += __shfl_xor(ss, 2); ss += __shfl_xor(ss, 4);
        const float rs = 1.0f / sqrtf(ss * (1.0f / MLD) + EPS); const float* ng = c.in[I_MLNG] + l * DH + h * MLD + sub * 12;
#pragma unroll
        for (int i = 0; i < 3; ++i) { const f32x4_t g4 = *(const f32x4_t*)(ng + 4 * i); const v2u og = *(const v2u*)(P + (size_t)r * NP + PC_O + h * MLD + sub * 12 + 4 * i);
            const float o0 = __uint_as_float(og.x << 16), o1 = __uint_as_float(og.x & 0xffff0000u), o2 = __uint_as_float(og.y << 16), o3 = __uint_as_float(og.y & 0xffff0000u);
            const float y0 = v[4 * i] * rs * g4[0] * pg8::fsig(o0), y1 = v[4 * i + 1] * rs * g4[1] * pg8::fsig(o1), y2 = v[4 * i + 2] * rs * g4[2] * pg8::fsig(o2), y3 = v[4 * i + 3] * rs * g4[3] * pg8::fsig(o3);
            *(v2u*)(MLO + o + 4 * i) = (v2u){f2bf_bits(y0) | (f2bf_bits(y1) << 16), f2bf_bits(y2) | (f2bf_bits(y3) << 16)}; } }
}
__device__ __forceinline__ void moe_dispatch(const Ctx& c, int l, LAS unsigned char* lds, int tid, int G, int bid, int nrows) {
    LAS int* PS = (LAS int*)lds; const unsigned* CNT = wsp<unsigned>(c, WS_CTL) + CW_CNT + l * NE;
    if (tid < NE) { int run = 0; for (int e = 0; e < tid; ++e) run += ((int)CNT[e] + 255) / 256; PS[tid] = run * 256;
        if (bid == 0) { int* TAB = wsp<int>(c, WS_TAB); const int nb = ((int)CNT[tid] + 255) / 256; for (int j = 0; j < nb; ++j) TAB[64 + run + j] = tid; if (tid == NE - 1) TAB[32] = run + nb; } }
    __syncthreads();
    const int* AE = wsp<int>(c, WS_ASGE); const int* AP = wsp<int>(c, WS_ASGP); int* AS_ = wsp<int>(c, WS_ASGS); int* ST = wsp<int>(c, WS_SLTOK); float* SLS = wsp<float>(c, WS_SLS); const float* HS = wsp<float>(c, WS_HS);
    for (long a = (long)bid * NTHR_ + tid; a < (long)nrows * TOPK; a += (long)G * NTHR_) { const int slot = PS[AE[a]] + AP[a]; AS_[a] = slot; ST[slot] = (int)(a / TOPK); SLS[slot] = HS[a / TOPK]; }
    if (bid == 0) for (int e = 0; e < NE; ++e) { const int cnt = (int)CNT[e], pad = ((cnt + 255) / 256) * 256; for (int i = cnt + tid; i < pad; i += NTHR_) { ST[PS[e] + i] = 0; SLS[PS[e] + i] = 0.f; } }
    __syncthreads();
}

constexpr int NWAVES = 8, NTHR = NWAVES * 64;
constexpr int RING_BYTES = 131072, MISC_OFF = 147200, LDS_BYTES = 147456;

struct Args { Ctx c; };
__global__ void __launch_bounds__(NTHR, 2) fwd_kernel(Args args) {
    extern __shared__ __attribute__((aligned(16))) unsigned char lds_raw[];
    LAS unsigned char* lds = (LAS unsigned char*)lds_raw;
    volatile LAS unsigned* MISC = (volatile LAS unsigned*)(lds + MISC_OFF);
    const int wave0_ = __builtin_amdgcn_readfirstlane((int)threadIdx.x >> 6);
    for (int u = threadIdx.x; u < (LDS_BYTES - MISC_OFF) / 4; u += NTHR) ((LAS unsigned*)(lds + MISC_OFF))[u] = 0u;
    __syncthreads();
    unsigned* ctl = (unsigned*)(args.c.ws + WS_CTL);
    const bool multi = (args.c.ph_hi - args.c.ph_lo) > 1;
    XcdBarrier bar; bar.bar = ctl + CW_BAR; bar.x = 0; bar.st = nullptr;
    if (multi) bar = xcd_barrier_post(ctl + CW_BAR, MISC + 8);
    const int lo = args.c.ph_lo, hi = args.c.ph_hi;
#ifndef PH_MASK
#define PH_MASK 0xFFFFFFFFu
#endif
#define PHEN(j) (((PH_MASK) >> (j)) & 1u)
#define IN(k) (lo <= (k) && (k) < hi)
#define SEAM(k) do { if (IN(k) && IN((k) + 1)) { XcdBarrier bq_ = bar; asm volatile("" : "+s"(bq_.bar)); xcd_barrier(bq_, wave0_ * 64 + (int)__builtin_amdgcn_mbcnt_hi(~0u, __builtin_amdgcn_mbcnt_lo(~0u, 0u))); } } while (0)
#define LOADCTX() Ctx c; { int z_ = 0; asm volatile("" : "+s"(z_)); _Pragma("unroll") for (int i_ = 0; i_ < N_INPUTS; ++i_) c.in[i_] = args.c.in[i_ + z_]; c.out = args.c.out; { size_t zo_ = 0; asm volatile("" : "+s"(zo_)); c.ws = args.c.ws + zo_; } c.ph_lo = 0; c.ph_hi = 0; } int tid = wave0_ * 64 + (int)__builtin_amdgcn_mbcnt_hi(~0u, __builtin_amdgcn_mbcnt_lo(~0u, 0u)); asm volatile("" : "+v"(tid)); int bid = blockIdx.x, G = gridDim.x; asm volatile("" : "+s"(bid), "+s"(G)); const long gstride = (long)G * NTHR; const long gt = (long)bid * NTHR + tid; const int lane = tid & 63, wave = __builtin_amdgcn_readfirstlane(tid >> 6); (void)lane; (void)wave;

    if (PHEN(15) && IN(0)) for (int rep_ = 0; rep_ <= (int)((REP_MASK >> 15) & 1u); ++rep_) { if (rep_) __syncthreads(); LOADCTX();
        ph_pre0(c, gt, gstride); ph_s5tab(c, gt, gstride); ph_wr(c, gt, gstride); ph_zt(c, gt, gstride);
        LAS float* scr = (LAS float*)(lds + wave * 16384);
        const int gw = bid * NWAVES + wave, ngw = G * NWAVES;
        { constexpr int IB = (DH / 64) * (D / 32), IO = (D / 64) * (D / 32), IG = (DH / 64) * (512 / 32), IL = 3 * IB + IO + IG;
          for (int it = gw; it < DEPTH * IL; it += ngw) { const int l = it / IL; int r = it % IL;
              if (r < 3 * IB) { const int br = r / IB; const float* wsrc = br == 0 ? c.in[I_WBHY] : (br == 1 ? c.in[I_WBS5] : c.in[I_WBML]); wconv_item<0>(wsrc + (size_t)l * DH * D, DH, D, D, wsp<bf16>(c, WS_WBR) + ((size_t)l * 3 + br) * D * DH, scr, r % IB, lane, 0); continue; } r -= 3 * IB;
              if (r < IO) { wconv_item<0>(c.in[I_WOUT] + (size_t)l * D * D, D, D, D, wsp<bf16>(c, WS_WOUT) + (size_t)l * D * D, scr, r, lane, 0); continue; } r -= IO;
              wconv_item<3>(c.in[I_GLU] + (size_t)l * DH * DH, DH, DH, 512, wsp<bf16>(c, WS_GLU) + (size_t)l * 512 * DH, scr, r, lane, DH); } }
        wmax_part(c, bid, G, tid); w1max_part(c, 0, 0, bid, G, tid); w1max_part(c, 0, 16, bid, G, tid);
    }
    SEAM(0);
    if (PHEN(16) && IN(1)) for (int rep_ = 0; rep_ <= (int)((REP_MASK >> 16) & 1u); ++rep_) { if (rep_) __syncthreads(); LOADCTX(); modp_fast(c, lds, tid, G, bid); ph_hd1(c, gt, gstride); ph_s5pow(c, gt, gstride); s5gen1_fast(c, tid, G, bid);
        { constexpr int IW = (D / 64) * (NP / 32); LAS float* scr = (LAS float*)(lds + wave * 16384); const int gw = bid * NWAVES + wave, ngw = G * NWAVES;
          for (int it = gw; it < DEPTH * IW; it += ngw) { const int l = it / IW;
              wconv_item_q8<1>(c.in[I_WIN] + (size_t)l * D * NIN, D, NIN, NP, wsp<signed char>(c, WS_WIN) + (size_t)l * NP * D, wsp<float>(c, WS_CTL) + CW_WMX + (size_t)l * NP, scr, it % IW, lane); } } }
    SEAM(1);
    if (PHEN(17) && IN(2)) for (int rep_ = 0; rep_ <= (int)((REP_MASK >> 17) & 1u); ++rep_) { if (rep_) __syncthreads(); LOADCTX(); ph_modf(c, gt, gstride); ph_hd2(c, gt, gstride); ph_s5gen2(c, gt, gstride); }
    SEAM(2);
    if (PHEN(18) && IN(3)) for (int rep_ = 0; rep_ <= (int)((REP_MASK >> 18) & 1u); ++rep_) { if (rep_) __syncthreads(); LOADCTX(); hyf2_mfma(c, tid, G, bid); }
    SEAM(3);
    if (PHEN(18) && IN(4)) for (int rep_ = 0; rep_ <= (int)((REP_MASK >> 18) & 1u); ++rep_) { if (rep_) __syncthreads(); LOADCTX(); rk_build(c, lds, tid, G, bid); }
    SEAM(4);

#define MOE_LTAB() do { const int* tb_ = wsp<int>(c, WS_TAB) + 32; for (int i_ = tid; i_ < 704; i_ += NTHR) ((LAS int*)(lds + 132096))[i_] = tb_[i_]; __syncthreads(); } while (0)
#define LAYER_BODY(l) { \
        const int pb = NPRO + l * NLP; const int MR = (l == DEPTH - 1) ? NTL : NT;     \
        if (PHEN(0) && IN(pb + 0)) { LOADCTX(); if (l == 0) norm_rows<0, false, true>(c, l, 0, lds, tid, G, bid); else norm_rows<0, true>(c, l, l - 1, lds, tid, G, bid); } \
        SEAM(pb + 0); \
        if (PHEN(1) && IN(pb + 1)) for (int rep_ = 0; rep_ <= (int)((REP_MASK >> 1) & 1u); ++rep_) { if (rep_) __syncthreads(); LOADCTX(); \
            const pg8::Gemm g = pg8::make_gemm(wsp<bf16>(c, WS_H), wsp<bf16>(c, WS_WIN) + (size_t)l * NP * D / 2, NT, NP, D / 2); pg8::StaticOrder S; S.init(NT, NP, G, bid);     \
            pg8::EpiStoreQ8 E{wsp<bf16>(c, WS_P), NP, wsp<float>(c, WS_HS), wsp<float>(c, WS_CTL) + CW_WMX + (size_t)l * NP}; \
            pg8::gemm_phase<pg8::EpiStoreQ8, pg8::StaticOrder, true, true, true>(lds, g, S, E, tid); \
            if (G == 256 && bid >= 16) { moe_wconv(c, l, (LAS float*)(lds + wave * 16384), 0, MOE_WS0, (bid - 16) * NWAVES + wave, 240 * NWAVES, lane); __syncthreads(); } \
        } \
        SEAM(pb + 1); \
        if (PHEN(2) && IN(pb + 2)) for (int rep_ = 0; rep_ <= (int)((REP_MASK >> 2) & 1u); ++rep_) { if (rep_) __syncthreads(); \
            { LOADCTX(); hy_prep(c, l, lds, tid, G, bid); } \
            { LOADCTX(); ml_prep(c, l, tid, G, bid); } \
            { LOADCTX(); pg8::Gemm g = pg8::make_gemm(wsp<bf16>(c, WS_P) + PC_S5, wsp<bf16>(c, WS_BT1) + (size_t)l * S5G * 768 * 512, S5RP, 768, 512); \
              g.a_row = S5T * NP * 2; g.a_kstep = 4 * NP * 2; g.a_sub = NP * 2; g.a_grp = S5N * 2; g.a_mode = 1; \
              pg8::S5Order S{3, G, (bid + 152) % G}; pg8::EpiS5a E{wsp<float>(c, WS_YS5), wsp<float>(c, WS_SLOC)}; \
              pg8::gemm_phase<pg8::EpiS5a, pg8::S5Order, true, true>(lds, g, S, E, tid); } \
        } \
        SEAM(pb + 2); \
        if (PHEN(3) && IN(pb + 3)) for (int rep_ = 0; rep_ <= (int)((REP_MASK >> 3) & 1u); ++rep_) { if (rep_) __syncthreads(); \
            for (int r2_ = 0; r2_ <= (int)((REP_MASK >> 21) & 1u); ++r2_) { LOADCTX(); for (int u = bid; u < 256; u += G) ml_chain(c, l, lds, tid, u); } \
            for (int r2_ = 0; r2_ <= (int)((REP_MASK >> 22) & 1u); ++r2_) { LOADCTX(); hy_conv(c, l, lds, tid, G, bid); } \
            { LOADCTX(); if (G == 256 && bid >= 128) { moe_wconv(c, l, (LAS float*)(lds + wave * 16384), MOE_WS0, MOE_WS1, (bid - 128) * NWAVES + wave, 128 * NWAVES, lane); __syncthreads(); } } \
            { LOADCTX(); if (G == 256) { if (bid >= 128) ph_s5cscan(c, l, (long)(bid - 128) * NTHR + tid, 128L * NTHR); } else ph_s5cscan(c, l, gt, gstride); } } \
        SEAM(pb + 3); \
        if (PHEN(4) && IN(pb + 4)) for (int rep_ = 0; rep_ <= (int)((REP_MASK >> 4) & 1u); ++rep_) { if (rep_) __syncthreads(); { LOADCTX(); hy_post(c, lds, tid, G, bid); } \
            { LOADCTX(); pg8::Gemm g = pg8::make_gemm(wsp<bf16>(c, WS_XIN), wsp<bf16>(c, WS_BT2) + (size_t)l * S5G * 512 * 256, S5RP, 512, 256); \
              g.a_grp = S5RP * 256 * 2; \
              pg8::S5Order S{2, G, bid}; pg8::EpiS5b E{wsp<float>(c, WS_YS5), wsp<bf16>(c, WS_G)}; \
              pg8::gemm_phase<pg8::EpiS5b, pg8::S5Order, true, true>(lds, g, S, E, tid); } \
            { LOADCTX(); ml_headout(c, l, tid, G, bid); } } \
        SEAM(pb + 4); \
        if (PHEN(5) && IN(pb + 5)) for (int rep_ = 0; rep_ <= (int)((REP_MASK >> 5) & 1u); ++rep_) { if (rep_) __syncthreads(); \
            { LOADCTX(); const pg8::Gemm g = pg8::make_gemm(wsp<bf16>(c, WS_G), wsp<bf16>(c, WS_GLU) + (size_t)l * 512 * DH, MR, 512, DH); pg8::StaticOrder S; S.init(MR, 512, G, (bid + 192) % G);     \
              pg8::EpiGlu E{wsp<bf16>(c, WS_G), wsp<bf16>(c, WS_S5O)}; \
              pg8::gemm_phase<pg8::EpiGlu, pg8::StaticOrder, true, true>(lds, g, S, E, tid); } \
            { LOADCTX(); pg8::StaticOrder S; S.init(MR, D, G, bid); const bf16* wbr = wsp<bf16>(c, WS_WBR) + (size_t)l * 3 * D * DH; \
              { const pg8::Gemm g = pg8::make_gemm(wsp<bf16>(c, WS_HY), wbr, NT, D, DH); pg8::EpiBr<0> E{wsp<bf16>(c, WS_P), PC_MG, wsp<float>(c, WS_YF), wsp<bf16>(c, WS_YB)}; \
                pg8::gemm_phase<pg8::EpiBr<0>, pg8::StaticOrder, true, true>(lds, g, S, E, tid); } \
              { const pg8::Gemm g = pg8::make_gemm(wsp<bf16>(c, WS_MLO), wbr + (size_t)2 * D * DH, NT, D, DH); pg8::EpiBr<1> E{wsp<bf16>(c, WS_P), PC_MG + 2 * D, wsp<float>(c, WS_YF), wsp<bf16>(c, WS_YB)}; \
                pg8::gemm_phase<pg8::EpiBr<1>, pg8::StaticOrder, true, true>(lds, g, S, E, tid); } } \
        } \
        SEAM(pb + 5); \
        if (PHEN(6) && IN(pb + 6)) for (int rep_ = 0; rep_ <= (int)((REP_MASK >> 6) & 1u); ++rep_) { if (rep_) __syncthreads(); LOADCTX(); \
            pg8::StaticOrder S; S.init(MR, D, G, bid); const bf16* wbr = wsp<bf16>(c, WS_WBR) + (size_t)l * 3 * D * DH; \
            const pg8::Gemm g = pg8::make_gemm(wsp<bf16>(c, WS_S5O), wbr + (size_t)D * DH, NT, D, DH); pg8::EpiBr<2> E{wsp<bf16>(c, WS_P), PC_MG + D, wsp<float>(c, WS_YF), wsp<bf16>(c, WS_YB)}; \
            pg8::gemm_phase<pg8::EpiBr<2>, pg8::StaticOrder, true, true>(lds, g, S, E, tid); \
            if (G == 256 && MR == NT && bid >= 64) { moe_wconv(c, l, (LAS float*)(lds + wave * 16384), MOE_WS1, MOE_WS2, (bid - 64) * NWAVES + wave, 192 * NWAVES, lane); __syncthreads(); } \
        } \
        SEAM(pb + 6); \
        if (PHEN(7) && IN(pb + 7)) { LOADCTX(); \
            const pg8::Gemm g = pg8::make_gemm(wsp<bf16>(c, WS_YB), wsp<bf16>(c, WS_WOUT) + (size_t)l * D * D, NT, D, D); pg8::StaticOrder S; S.init(MR, D, G, bid); \
            pg8::EpiOut<(l) == 0> E{wsp<bf16>(c, WS_X), wsp<float>(c, WS_MOD) + (size_t)l * NMOD * 6144, c.in[I_X], c.in[I_CTX]}; \
            pg8::gemm_phase<pg8::EpiOut<(l) == 0>, pg8::StaticOrder, true, true>(lds, g, S, E, tid); \
            if (G == 256 && MR == NT && bid >= 64) { moe_wconv(c, l, (LAS float*)(lds + wave * 16384), MOE_WS2, MOE_WS3, (bid - 64) * NWAVES + wave, 192 * NWAVES, lane); __syncthreads(); } \
        } \
        SEAM(pb + 7); \
        if (PHEN(8) && IN(pb + 8)) { LOADCTX(); \
            norm_rows<1, false>(c, l, 0, lds, tid, G, bid, MR); \
            LAS float* scr = (LAS float*)(lds + wave * 16384); \
            const int gw = bid * NWAVES + wave, ngw = G * NWAVES; \
            for (int rep_ = 0; rep_ <= (int)((REP_MASK >> 14) & 1u); ++rep_) moe_wconv(c, l, scr, (G == 256 ? (MR == NT ? MOE_WS3 : MOE_WS1) : 0), MOE_WITEMS, gw, ngw, lane); \
        } \
        SEAM(pb + 8); \
        if (PHEN(9) && IN(pb + 9)) for (int rep_ = 0; rep_ <= (int)((REP_MASK >> 9) & 1u); ++rep_) { if (rep_) __syncthreads(); LOADCTX(); moe_dispatch(c, l, lds, tid, G, bid, MR); } \
        SEAM(pb + 9); \
        if (PHEN(10) && IN(pb + 10)) for (int rep_ = 0; rep_ <= (int)((REP_MASK >> 10) & 1u); ++rep_) { if (rep_) __syncthreads(); LOADCTX(); \
            pg8::Gemm g = pg8::make_gemm(wsp<bf16>(c, WS_H), wsp<bf16>(c, WS_W1T), NSLOT, 1024, D / 2); g.a_gather = wsp<int>(c, WS_SLTOK);     MOE_LTAB(); pg8::MoeOrderT<true> S{(const LAS int*)(lds + 132096), 4, G, bid}; \
            pg8::EpiMoe1Q8 E{wsp<bf16>(c, WS_ACT), c.in[I_B1] + (size_t)l * NE * 1024, wsp<float>(c, WS_SLS), wsp<float>(c, WS_CTL) + CW_W1MX + (size_t)l * NE * 1024}; \
            pg8::gemm_phase<pg8::EpiMoe1Q8, pg8::MoeOrderT<true>, true, true, true>(lds, g, S, E, tid); \
            if ((l) < DEPTH - 1) w1max_tail(c, (l) + 1, 0, lds, tid, G, bid); \
        } \
        SEAM(pb + 10); \
        if (PHEN(11) && IN(pb + 11)) for (int rep_ = 0; rep_ <= (int)((REP_MASK >> 13) & 1u); ++rep_) { if (rep_) __syncthreads(); LOADCTX(); \
            const pg8::Gemm g = pg8::make_gemm(wsp<bf16>(c, WS_ACT), wsp<bf16>(c, WS_W2T), NSLOT, D, FF); MOE_LTAB(); pg8::MoeOrderT<false> S{(const LAS int*)(lds + 132096), 4, G, bid}; \
            pg8::EpiMoe2 E{wsp<unsigned char>(c, WS_OUTS), wsp<float>(c, WS_OUTSC), c.in[I_B2] + (size_t)l * NE * D}; \
            pg8::gemm_phase<pg8::EpiMoe2, pg8::MoeOrderT<false>, true, true>(lds, g, S, E, tid); \
            if ((l) < DEPTH - 1) w1max_tail(c, (l) + 1, 16, lds, tid, G, bid); \
        } \
        SEAM(pb + 11); \
    }
    LAYER_BODY(0) LAYER_BODY(1) LAYER_BODY(2) LAYER_BODY(3)
    static_assert(DEPTH == 4, "layer bodies written out four times");
    static_assert(MOE_WS3 == MOE_WITEMS, "conversion shares cover every item");
    if (PHEN(19) && IN(NPHASE - 1)) { LOADCTX(); norm_rows<2, true>(c, 0, DEPTH - 1, lds, tid, G, bid); }
#undef IN
#undef SEAM
}

#ifndef N_LAUNCH_MODE
#define N_LAUNCH_MODE 1
#endif
extern "C" void kernel_launch(void* const* d_in, const int* in_sizes, int n_in, void* d_out, int out_size, void* d_ws, size_t ws_size, hipStream_t stream) {
    static int grid = 0;
    if (grid == 0) {
        if (n_in != N_INPUTS || out_size != NTL * D || ws_size < WS_END) { fprintf(stderr, "kernel_launch: shape/workspace mismatch: n_in %d out %d ws %zu (need %zu)\n", n_in, out_size, ws_size, (size_t)WS_END); grid = -1; return; }
        int dev = 0, cus = 0, per_cu = 0;
        if (hipGetDevice(&dev) != hipSuccess || hipDeviceGetAttribute(&cus, hipDeviceAttributeMultiprocessorCount, dev) != hipSuccess) { grid = -1; return; }
        if (hipFuncSetAttribute((const void*)fwd_kernel, hipFuncAttributeMaxDynamicSharedMemorySize, LDS_BYTES) != hipSuccess) { fprintf(stderr, "kernel_launch: hipFuncSetAttribute failed\n"); grid = -1; return; }
        if (hipOccupancyMaxActiveBlocksPerMultiprocessor(&per_cu, (const void*)fwd_kernel, NTHR, LDS_BYTES) != hipSuccess || per_cu < 1) { fprintf(stderr, "kernel_launch: occupancy query says %d\n", per_cu); }
        (void)hipGetLastError();
        grid = cus;
    }
    if (grid < 0) return;
    if (hipMemsetAsync((char*)d_ws + WS_CTL, 0, CTL_BYTES, stream) != hipSuccess) return;
    Args a; std::memset((void*)&a, 0, sizeof(a));
    for (int i = 0; i < N_INPUTS; ++i) a.c.in[i] = (const float*)d_in[i];
    a.c.out = (float*)d_out; a.c.ws = (unsigned char*)d_ws;
    if (N_LAUNCH_MODE == 1) {
        a.c.ph_lo = 0; a.c.ph_hi = NPHASE;
        hipLaunchKernelGGL(fwd_kernel, dim3(grid), dim3(NTHR), LDS_BYTES, stream, a);
    } else {
        for (int p = 0; p < NPHASE; ++p) { a.c.ph_lo = p; a.c.ph_hi = p + 1; hipLaunchKernelGGL(fwd_kernel, dim3(grid), dim3(NTHR), LDS_BYTES, stream, a); }
    }
}
#endif
```
